# Optimizing an MI355X kernel written in HIP

```python
import math
import jax, jax.numpy as jnp
from jax import lax
import numpy as np

D_MODEL = 2048
BATCH = 4
SEQ = 4096
DEPTH = 2

RMS_EPS = 1e-6
ROPE_THETA = 500000.0
HEAD_DIM = 128
ROT_DIMS = HEAD_DIM // 4
Q_BLOCK = 128

NSA_HEADS = 8
NSA_GROUPS = 2
NSA_HPG = NSA_HEADS // NSA_GROUPS
NSA_CMP_LEN = 32
NSA_CMP_STRIDE = 16
NSA_CMP_HIDDEN = 256
NSA_SEL_BLOCK = 64
NSA_SEL_TOPK = 16
NSA_WINDOW = 512
NSA_SEL_QCHUNK = 32
NSA_WIDTH = NSA_HEADS * HEAD_DIM
NSA_KV = NSA_GROUPS * HEAD_DIM
NSA_COLS = (NSA_WIDTH, NSA_KV, NSA_KV, NSA_KV, NSA_KV, NSA_KV, NSA_KV, 3 * NSA_HEADS)
NSA_IN = NSA_WIDTH + 6 * NSA_KV + 3 * NSA_HEADS

DIFF_HEADS = 4
DIFF_VDIM = 2 * HEAD_DIM
DIFF_WIDTH = DIFF_HEADS * DIFF_VDIM
DIFF_QK = 2 * DIFF_HEADS * HEAD_DIM
DIFF_COLS = (DIFF_QK, DIFF_QK, DIFF_WIDTH)
DIFF_IN = 2 * DIFF_QK + DIFF_WIDTH

RWKV_HEAD = 64
RWKV_WIDTH = 1024
RWKV_HEADS = RWKV_WIDTH // RWKV_HEAD
RWKV_W_LORA = 64
RWKV_A_LORA = 64
RWKV_G_LORA = 160
RWKV_LNX_EPS = 64e-5
RWKV_COLS = (RWKV_WIDTH, RWKV_WIDTH, RWKV_WIDTH, RWKV_W_LORA, RWKV_A_LORA, RWKV_G_LORA)
RWKV_IN = 3 * RWKV_WIDTH + RWKV_W_LORA + RWKV_A_LORA + RWKV_G_LORA

IN_COLS = NSA_IN + DIFF_IN + RWKV_IN
N_BRANCH = 3
BRANCH_WIDTH = 1024
D_FF = 4 * D_MODEL

kernel_name = "hybrid_nsa_diff_rwkv7_gated_block"


def _split(z, sizes):
    offs = np.cumsum(sizes)[:-1].tolist()
    return jnp.split(z, offs, axis=-1)


def rmsnorm(z, g, eps=RMS_EPS):
    z32 = z.astype(jnp.float32)
    y = z32 * lax.rsqrt(jnp.mean(z32 * z32, axis=-1, keepdims=True) + eps)
    return (y * g.astype(jnp.float32)).astype(z.dtype)


def partial_rope(z, pos):
    half = ROT_DIMS // 2
    inv_freq = ROPE_THETA ** (-jnp.arange(half, dtype=jnp.float32) / half)
    ang = pos.astype(jnp.float32)[..., None] * inv_freq
    ang = ang.reshape(pos.shape + (1,) * (z.ndim - pos.ndim - 1) + (half,))
    cos, sin = jnp.cos(ang), jnp.sin(ang)
    zr = z[..., :ROT_DIMS].astype(jnp.float32)
    z1, z2 = zr[..., :half], zr[..., half:]
    rot = jnp.concatenate([z1 * cos - z2 * sin, z2 * cos + z1 * sin], axis=-1)
    return jnp.concatenate([rot.astype(z.dtype), z[..., ROT_DIMS:]], axis=-1)


def masked_softmax(s, mask):
    s = jnp.where(mask, s.astype(jnp.float32), -1e30)
    return jax.nn.softmax(s, axis=-1) * mask


def nsa_mixer(q, kc, vc, ks, vs, kw, vw, gates, pos, cmp_pos, cmp_w1, cmp_w2):
    B, S = q.shape[:2]
    dh = HEAD_DIM
    scale = dh ** -0.5
    t_idx = jnp.arange(S)
    qg = partial_rope(q, pos).reshape(B, S, NSA_GROUPS, NSA_HPG, dh).transpose(0, 2, 3, 1, 4)

    ratio = NSA_CMP_LEN // NSA_CMP_STRIDE
    n_chunk = S // NSA_CMP_STRIDE
    n_c = n_chunk - ratio + 1

    def compress(z, pe, w1, w2):
        ch = z.reshape(B, n_chunk, NSA_CMP_STRIDE, NSA_GROUPS, dh)
        blk = jnp.concatenate([ch[:, i:i + n_c] for i in range(ratio)], axis=2) + pe[None, None, :, None, :]
        flat = blk.transpose(0, 1, 3, 2, 4).reshape(B, n_c, NSA_GROUPS, NSA_CMP_LEN * dh)
        return jax.nn.gelu(flat @ w1) @ w2

    c_start = jnp.arange(n_c) * NSA_CMP_STRIDE
    cmp_end = c_start + NSA_CMP_LEN - 1
    kcmp = partial_rope(compress(kc, cmp_pos[0], cmp_w1[0], cmp_w2[0]), jnp.take(pos, cmp_end, axis=1))
    vcmp = compress(vc, cmp_pos[1], cmp_w1[1], cmp_w2[1])
    s_c = jnp.einsum('bghqd,bcgd->bghqc', qg, kcmp) * scale
    p_c = masked_softmax(s_c, cmp_end[None, :] <= t_idx[:, None])
    o_cmp = jnp.einsum('bghqc,bcgd->bghqd', p_c.astype(vcmp.dtype), vcmp)

    n_sel = S // NSA_SEL_BLOCK
    top = min(NSA_SEL_TOPK, n_sel)
    j_start = jnp.arange(n_sel) * NSA_SEL_BLOCK
    overlap = ((c_start[:, None] <= j_start[None, :] + NSA_SEL_BLOCK - 1)
               & (cmp_end[:, None] >= j_start[None, :])).astype(jnp.float32)
    imp = jnp.einsum('bghqc,cj->bgqj', p_c, overlap)
    jj = jnp.arange(n_sel)[None, :]
    blk_t = (t_idx // NSA_SEL_BLOCK)[:, None]
    forced = (jj == 0) | (jj == blk_t) | (jj == blk_t - 1)
    imp = jnp.where(forced, 1e9, jnp.where(jj > blk_t, -jnp.inf, imp))
    _, sel_idx = lax.top_k(imp, top)

    k_blk = partial_rope(ks, pos).reshape(B, n_sel, NSA_SEL_BLOCK, NSA_GROUPS, dh).transpose(0, 3, 1, 2, 4)
    v_blk = vs.reshape(B, n_sel, NSA_SEL_BLOCK, NSA_GROUPS, dh).transpose(0, 3, 1, 2, 4)
    n_qc = S // NSA_SEL_QCHUNK
    q_ch = jnp.moveaxis(qg.reshape(B, NSA_GROUPS, NSA_HPG, n_qc, NSA_SEL_QCHUNK, dh), 3, 0)
    i_ch = jnp.moveaxis(sel_idx.reshape(B, NSA_GROUPS, n_qc, NSA_SEL_QCHUNK, top), 2, 0)
    t_ch = t_idx.reshape(n_qc, NSA_SEL_QCHUNK)
    gather = jax.vmap(jax.vmap(lambda blk, ix: blk[ix]))

    def sel_chunk(args):
        qc, ic, tc = args
        kg = gather(k_blk, ic)
        vg = gather(v_blk, ic)
        s = jnp.einsum('bghqd,bgqnld->bghqnl', qc, kg) * scale
        kpos = ic[..., None] * NSA_SEL_BLOCK + jnp.arange(NSA_SEL_BLOCK)
        mask = (kpos <= tc[None, None, :, None, None]).reshape(B, NSA_GROUPS, 1, NSA_SEL_QCHUNK, top * NSA_SEL_BLOCK)
        p = masked_softmax(s.reshape(B, NSA_GROUPS, NSA_HPG, NSA_SEL_QCHUNK, top * NSA_SEL_BLOCK), mask)
        p = p.reshape(B, NSA_GROUPS, NSA_HPG, NSA_SEL_QCHUNK, top, NSA_SEL_BLOCK)
        return jnp.einsum('bghqnl,bgqnld->bghqd', p.astype(vg.dtype), vg)

    o_slc = jnp.moveaxis(lax.map(sel_chunk, (q_ch, i_ch, t_ch)), 0, 3).reshape(B, NSA_GROUPS, NSA_HPG, S, dh)

    pad = ((0, 0), (0, 0), (NSA_WINDOW, 0), (0, 0))
    kw_p = jnp.pad(partial_rope(kw, pos).transpose(0, 2, 1, 3), pad)
    vw_p = jnp.pad(vw.transpose(0, 2, 1, 3), pad)
    n_qb = S // Q_BLOCK
    span = Q_BLOCK + NSA_WINDOW
    q_bl = jnp.moveaxis(qg.reshape(B, NSA_GROUPS, NSA_HPG, n_qb, Q_BLOCK, dh), 3, 0)

    def win_block(args):
        qb, i = args
        start = i * Q_BLOCK
        kb = lax.dynamic_slice_in_dim(kw_p, start, span, axis=2)
        vb = lax.dynamic_slice_in_dim(vw_p, start, span, axis=2)
        tq = start + jnp.arange(Q_BLOCK)
        tk = start - NSA_WINDOW + jnp.arange(span)
        dlt = tq[:, None] - tk[None, :]
        mask = (dlt >= 0) & (dlt < NSA_WINDOW) & (tk[None, :] >= 0)
        p = masked_softmax(jnp.einsum('bghqd,bgkd->bghqk', qb, kb) * scale, mask)
        return jnp.einsum('bghqk,bgkd->bghqd', p.astype(vb.dtype), vb)

    o_win = jnp.moveaxis(lax.map(win_block, (q_bl, jnp.arange(n_qb))), 0, 3).reshape(B, NSA_GROUPS, NSA_HPG, S, dh)

    g = jax.nn.sigmoid(gates.astype(jnp.float32)).reshape(B, S, NSA_GROUPS, NSA_HPG, 3).transpose(0, 2, 3, 1, 4)
    o = g[..., 0:1] * o_cmp + g[..., 1:2] * o_slc + g[..., 2:3] * o_win
    return o.transpose(0, 3, 1, 2, 4).reshape(B, S, NSA_WIDTH).astype(q.dtype)


def diff_mixer(q, k, v, pos, lam, subln, layer):
    B, S = q.shape[:2]
    dh = HEAD_DIM
    q = partial_rope(q.reshape(B, S, DIFF_HEADS, 2, dh), pos).transpose(0, 2, 3, 1, 4)
    k = partial_rope(k.reshape(B, S, DIFF_HEADS, 2, dh), pos).transpose(0, 2, 3, 1, 4)
    v = v.reshape(B, S, DIFF_HEADS, DIFF_VDIM).transpose(0, 2, 1, 3)
    lam_init = 0.8 - 0.6 * math.exp(-0.3 * layer)
    l32 = lam.astype(jnp.float32)
    lam_full = jnp.exp(jnp.sum(l32[0] * l32[1])) - jnp.exp(jnp.sum(l32[2] * l32[3])) + lam_init
    scale = dh ** -0.5
    n_qb = S // Q_BLOCK
    q_bl = jnp.moveaxis(q.reshape(B, DIFF_HEADS, 2, n_qb, Q_BLOCK, dh), 3, 0)
    tk = jnp.arange(S)

    def blk(args):
        qb, i = args
        tq = i * Q_BLOCK + jnp.arange(Q_BLOCK)
        p = masked_softmax(jnp.einsum('bhmqd,bhmkd->bhmqk', qb, k) * scale, tk[None, :] <= tq[:, None])
        a = p[:, :, 0] - lam_full * p[:, :, 1]
        return jnp.einsum('bhqk,bhkd->bhqd', a.astype(v.dtype), v)

    o = jnp.moveaxis(lax.map(blk, (q_bl, jnp.arange(n_qb))), 0, 2).reshape(B, DIFF_HEADS, S, DIFF_VDIM)
    o = rmsnorm(o, subln, 1e-5) * (1.0 - lam_init)
    return o.transpose(0, 2, 1, 3).reshape(B, S, DIFF_WIDTH)


def rwkv_mixer(p, mu, w0, w_up, a0, a_up, g_up, k_k, k_a, r_k, lnx_w, lnx_b):
    B, S = p.shape[:2]
    f32 = jnp.float32
    H, N = RWKV_HEADS, RWKV_HEAD
    prev = jnp.pad(p, ((0, 0), (1, 0), (0, 0)))[:, :-1]
    p = p + (prev - p) * mu
    r, k, v, wd, ad, gd = _split(p, RWKV_COLS)
    w = jnp.exp(-math.exp(-0.5) * jax.nn.sigmoid((w0 + jnp.tanh(wd) @ w_up).astype(f32)))
    a = jax.nn.sigmoid((a0 + ad @ a_up).astype(f32))
    g = jax.nn.sigmoid(gd) @ g_up
    r, k, v = r.astype(f32), k.astype(f32), v.astype(f32)
    heads = lambda z: z.reshape(B, S, H, N)
    kk = heads(k * k_k)
    kk = kk / jnp.maximum(jnp.sqrt(jnp.sum(kk * kk, axis=-1, keepdims=True)), 1e-12)
    k = k * (1.0 + (a - 1.0) * k_a)
    xs = tuple(jnp.moveaxis(z, 1, 0) for z in (heads(r), heads(w), heads(k), heads(v), kk, heads(a)))

    def step(state, inp):
        rt, wt, kt, vt, kkt, at = inp
        sa = jnp.einsum('bhvk,bhk->bhv', state, -kkt)
        state = state * wt[:, :, None, :] + sa[..., None] * (kkt * at)[:, :, None, :] + vt[..., None] * kt[:, :, None, :]
        return state, jnp.einsum('bhvk,bhk->bhv', state, rt)

    _, y = lax.scan(step, jnp.zeros((B, H, N, N), f32), xs)
    y = jnp.moveaxis(y, 0, 1)
    mean = jnp.mean(y, axis=-1, keepdims=True)
    var = jnp.mean(jnp.square(y - mean), axis=-1, keepdims=True)
    y = ((y - mean) * lax.rsqrt(var + RWKV_LNX_EPS)).reshape(B, S, RWKV_WIDTH) * lnx_w + lnx_b
    bonus = jnp.sum(heads(r) * heads(k) * r_k, axis=-1, keepdims=True) * heads(v)
    return ((y + bonus.reshape(B, S, RWKV_WIDTH)) * g).astype(p.dtype)


def setup_inputs(seed: int = 0) -> dict:
    key = jax.random.key(seed)
    ks = iter(jax.random.split(key, 32))
    L, D = DEPTH, D_MODEL
    nrm = lambda shape, scale: scale * jax.random.normal(next(ks), shape, jnp.float32)
    gain = lambda shape: 1.0 + 0.05 * jax.random.normal(next(ks), shape, jnp.float32)
    return {
        "x": nrm((BATCH, SEQ, D), 1.0),
        "positions": jnp.broadcast_to(jnp.arange(SEQ, dtype=jnp.int32), (BATCH, SEQ)),
        "norm_pre_mix": gain((L, D)),
        "norm_post_mix": gain((L, D)),
        "norm_pre_mlp": gain((L, D)),
        "norm_post_mlp": gain((L, D)),
        "w_in": nrm((L, D, IN_COLS), D ** -0.5),
        "nsa_cmp_pos": nrm((L, 2, NSA_CMP_LEN, HEAD_DIM), 0.1),
        "nsa_cmp_w1": nrm((L, 2, NSA_CMP_LEN * HEAD_DIM, NSA_CMP_HIDDEN), (NSA_CMP_LEN * HEAD_DIM) ** -0.5),
        "nsa_cmp_w2": nrm((L, 2, NSA_CMP_HIDDEN, HEAD_DIM), NSA_CMP_HIDDEN ** -0.5),
        "diff_lambda": nrm((L, 4, HEAD_DIM), 0.1),
        "diff_subln": gain((L, DIFF_VDIM)),
        "rwkv_mu": jax.random.uniform(next(ks), (L, RWKV_IN), jnp.float32),
        "rwkv_w0": jax.random.uniform(next(ks), (L, RWKV_WIDTH), jnp.float32, -4.0, 2.0),
        "rwkv_w_up": nrm((L, RWKV_W_LORA, RWKV_WIDTH), 0.1),
        "rwkv_a0": nrm((L, RWKV_WIDTH), 0.5),
        "rwkv_a_up": nrm((L, RWKV_A_LORA, RWKV_WIDTH), 0.1),
        "rwkv_g_up": nrm((L, RWKV_G_LORA, RWKV_WIDTH), RWKV_G_LORA ** -0.5),
        "rwkv_k_k": 0.85 + nrm((L, RWKV_WIDTH), 0.05),
        "rwkv_k_a": gain((L, RWKV_WIDTH)),
        "rwkv_r_k": nrm((L, RWKV_HEADS, RWKV_HEAD), 0.1),
        "rwkv_lnx_w": gain((L, RWKV_WIDTH)),
        "rwkv_lnx_b": nrm((L, RWKV_WIDTH), 0.01),
        "w_gate": nrm((L, N_BRANCH, D, D), D ** -0.5),
        "b_gate": nrm((L, N_BRANCH, D), 0.02),
        "w_branch": nrm((L, N_BRANCH, BRANCH_WIDTH, D), BRANCH_WIDTH ** -0.5),
        "w_out": nrm((L, D, D), D ** -0.5),
        "w_up": nrm((L, D, D_FF), D ** -0.5),
        "w_down": nrm((L, D_FF, D), D_FF ** -0.5),
    }


def reference(x, positions, norm_pre_mix, norm_post_mix, norm_pre_mlp, norm_post_mlp, w_in,
              nsa_cmp_pos, nsa_cmp_w1, nsa_cmp_w2, diff_lambda, diff_subln,
              rwkv_mu, rwkv_w0, rwkv_w_up, rwkv_a0, rwkv_a_up, rwkv_g_up, rwkv_k_k, rwkv_k_a, rwkv_r_k,
              rwkv_lnx_w, rwkv_lnx_b, w_gate, b_gate, w_branch, w_out, w_up, w_down):
    B, S, _ = x.shape
    for l in range(DEPTH):
        u = rmsnorm(x, norm_pre_mix[l])
        p_nsa, p_diff, p_rwkv = _split(u @ w_in[l], (NSA_IN, DIFF_IN, RWKV_IN))
        q, kc, vc, ks, vs, kw, vw, ng = _split(p_nsa, NSA_COLS)
        grp = lambda z: z.reshape(B, S, NSA_GROUPS, HEAD_DIM)
        y_nsa = nsa_mixer(q.reshape(B, S, NSA_HEADS, HEAD_DIM), grp(kc), grp(vc), grp(ks), grp(vs), grp(kw), grp(vw),
                          ng, positions, nsa_cmp_pos[l], nsa_cmp_w1[l], nsa_cmp_w2[l])
        dq, dk, dv = _split(p_diff, DIFF_COLS)
        y_diff = diff_mixer(dq, dk, dv, positions, diff_lambda[l], diff_subln[l], l)
        y_rwkv = rwkv_mixer(p_rwkv, rwkv_mu[l], rwkv_w0[l], rwkv_w_up[l], rwkv_a0[l], rwkv_a_up[l], rwkv_g_up[l],
                            rwkv_k_k[l], rwkv_k_a[l], rwkv_r_k[l], rwkv_lnx_w[l], rwkv_lnx_b[l])
        gate = lambda b: jax.nn.sigmoid((u @ w_gate[l, b] + b_gate[l, b]).astype(jnp.float32)).astype(x.dtype)
        merged = (gate(0) * (y_nsa @ w_branch[l, 0])
                  + gate(1) * (y_diff @ w_branch[l, 1])
                  + gate(2) * (y_rwkv @ w_branch[l, 2]))
        x = x + rmsnorm(merged @ w_out[l], norm_post_mix[l])
        m = rmsnorm(x, norm_pre_mlp[l])
        x = x + rmsnorm(jnp.square(jax.nn.relu(m @ w_up[l])) @ w_down[l], norm_post_mlp[l])
    return x
```

```cpp
#include <hip/hip_runtime.h>
#include <hip/hip_cooperative_groups.h>
#include <cstdio>
#include <cstdint>
namespace cg = cooperative_groups;
#define DI __device__ __forceinline__
#define LAS __attribute__((address_space(3)))
namespace pg8 {
#define PG8_LAS __attribute__((address_space(3)))
typedef unsigned short bf16_t;
typedef short bf16x8 __attribute__((ext_vector_type(8)));
typedef float f32x4 __attribute__((ext_vector_type(4)));
typedef unsigned u32x4 __attribute__((ext_vector_type(4)));
constexpr int BM = 256, BK = 64, HALF = 128, HTB = HALF * BK * 2  , STAGE_BYTES = 8 * HTB, NXCD = 8, WGM = 8;

__host__ __device__ __forceinline__ int lds_byte(int r, int c) { const int st = (r >> 4) * 2 + (c >> 5), rr = r & 15, cc = c & 31, ob = rr * 64 + cc * 2; return st * 1024 + (ob ^ (((ob >> 9) & 1) << 5)); }
__host__ __device__ __forceinline__ void stage_rc(int b, int& R, int& C) { const int st = b / 1024, sb = b % 1024, swz = sb ^ (((sb >> 9) & 1) << 5); R = (st >> 1) * 16 + swz / 64; C = (st & 1) * 32 + (swz % 64) / 2; }
__host__ __device__ __forceinline__ int perm32(int rho) { const int n = rho >> 4, i = rho & 15; return 8 * (i >> 2) + 4 * n + (i & 3); }

struct Unit { int pm, pn; };
struct Gemm { const bf16_t* A; const bf16_t* Bt; int M, N, K; };

struct StaticOrder {
    int nM, nN, nwg, G, c;
    __host__ __device__ void init(int M, int N, int G_, int c_) { nM = M / BM; nN = N / BM; nwg = nM * nN; G = G_; c = c_; }
    __host__ __device__ bool next(int i, Unit& u) const {
        const long L = (long)i * G + c; if (L >= nwg) return false;
        int wgid = (int)L; { const int q = nwg / NXCD, r = nwg % NXCD, xcd = wgid % NXCD, off = wgid / NXCD; wgid = (xcd < r ? xcd * (q + 1) : r * (q + 1) + (xcd - r) * q) + off; }
        const int nig = WGM * nN, gid = wgid / nig, fm = gid * WGM, gsz = (nM - fm) < WGM ? (nM - fm) : WGM;
        u.pm = fm + ((wgid % nig) % gsz); u.pn = (wgid % nig) / gsz; return true;
    }
    __device__ __forceinline__ void a_ready(const Unit&) const {}
    __device__ __forceinline__ void done(const Unit&) const {}
};
template <class Epi, class Sched, bool STAMP = false>
__device__ __forceinline__ void gemm_phase(PG8_LAS unsigned char* lds, const Gemm g, const Sched& S, const Epi& E, unsigned long long* stamps) {
    int tid_l = threadIdx.x; asm volatile("" : "+v"(tid_l)); const int tid = tid_l, wid = __builtin_amdgcn_readfirstlane(tid >> 6), lane = tid & 63, wr = wid >> 2, wc = wid & 3, fr = lane & 15, fq = lane >> 4;
    const int K = g.K, nt = K / BK;
    int ts_lo = 0, ts_hi = 0, nts = 0; const unsigned long long rt_entry = STAMP ? (unsigned long long)wall_clock64() : 0ull;
#define PG8_STAMP() do { if (STAMP && wid == 0 && nts < 64) { const unsigned long long _c = (unsigned long long)clock64(); \
        ts_lo = (lane == nts) ? (int)(unsigned)_c : ts_lo; ts_hi = (lane == nts) ? (int)(unsigned)(_c >> 32) : ts_hi; ++nts; } } while (0)
    PG8_STAMP();
    unsigned voffA[2], voffB[2];
#pragma unroll
    for (int i = 0; i < 2; ++i) { int R, C; stage_rc(tid * 16 + i * 8192, R, C); const int Rb = Epi::PERM ? ((R & ~31) + perm32(R & 31)) : R;
        voffA[i] = (unsigned)(R * K + C) * 2u; voffB[i] = (unsigned)(Rb * K + C) * 2u; }
    const size_t kstep = (size_t)(BK * 2);
    const size_t hstep = (size_t)HALF * K * 2;
    const size_t tstep = 2 * hstep;
    const unsigned ldsw = (unsigned)wid * 1024u;
    const int aoff = lds_byte(wr * 64 + fr, fq * 8), boff = lds_byte(wc * 32 + fr, fq * 8);
#define PG8_SA(b, h) (((b) * 2 + (h)) * HTB)
#define PG8_SB(b, h) ((4 + (b) * 2 + (h)) * HTB)
#define PG8_STAGE(bufoff, gbase, voff) do { _Pragma("unroll") for (int _i = 0; _i < 2; ++_i) \
        __builtin_amdgcn_global_load_lds((const unsigned*)((const char*)(gbase) + (voff)[_i]), (PG8_LAS unsigned*)(lds + (bufoff) + ldsw + _i * 8192), 16, 0, 0); } while (0)
#define PG8_LDA(dst, b, h) do { _Pragma("unroll") for (int m = 0; m < 4; ++m) _Pragma("unroll") for (int k = 0; k < 2; ++k) dst[m][k] = *(const PG8_LAS bf16x8*)(lds + PG8_SA(b, h) + aoff + m * 2048 + k * 1024); } while (0)
#define PG8_LDB(dst, b, h) do { _Pragma("unroll") for (int n = 0; n < 2; ++n) _Pragma("unroll") for (int k = 0; k < 2; ++k) dst[n][k] = *(const PG8_LAS bf16x8*)(lds + PG8_SB(b, h) + boff + n * 2048 + k * 1024); } while (0)
#define PG8_MMA(ai, bj, At, Bt) do { __builtin_amdgcn_s_setprio(1); _Pragma("unroll") for (int m = 0; m < 4; ++m) _Pragma("unroll") for (int n = 0; n < 2; ++n) _Pragma("unroll") for (int k = 0; k < 2; ++k) \
        acc[ai][bj][m][n] = __builtin_amdgcn_mfma_f32_16x16x32_bf16(Bt[n][k], At[m][k], acc[ai][bj][m][n], 0, 0, 0); __builtin_amdgcn_s_setprio(0); } while (0)
#define PG8_WAIT_V(n) asm volatile("s_waitcnt vmcnt(" #n ")" ::: "memory")
#define PG8_WAIT_L(n) asm volatile("s_waitcnt lgkmcnt(" #n ")" ::: "memory")
#define PG8_BAR __builtin_amdgcn_s_barrier()
#define PG8_SCHED __builtin_amdgcn_sched_barrier(0)
    Unit cur, nxt; int ui = 0;
    if (!S.next(0, cur)) return;
    f32x4 acc[2][2][4][2];
#pragma unroll
    for (int a = 0; a < 2; ++a)
#pragma unroll
        for (int b = 0; b < 2; ++b)
#pragma unroll
            for (int m = 0; m < 4; ++m)
#pragma unroll
                for (int n = 0; n < 2; ++n) acc[a][b][m][n] = (f32x4){0.f, 0.f, 0.f, 0.f};
    bf16x8 At[4][2], B0[2][2], B1[2][2];
    const char* cA = (const char*)g.A + (size_t)cur.pm * tstep; const char* cB = (const char*)g.Bt + (size_t)cur.pn * tstep;
    S.a_ready(cur);
    PG8_STAGE(PG8_SB(0, 0), cB, voffB); PG8_STAGE(PG8_SA(0, 0), cA, voffA); PG8_STAGE(PG8_SB(0, 1), cB + hstep, voffB); PG8_STAGE(PG8_SA(0, 1), cA + hstep, voffA);
    if (wr == 1) PG8_BAR;
    PG8_WAIT_V(4); PG8_BAR;
    PG8_STAGE(PG8_SB(1, 0), cB + kstep, voffB); PG8_STAGE(PG8_SA(1, 0), cA + kstep, voffA); PG8_STAGE(PG8_SB(1, 1), cB + hstep + kstep, voffB);
    PG8_WAIT_V(6); PG8_BAR;
    PG8_STAMP();
    for (;;) {
        const bool has_next = S.next(ui + 1, nxt);
        const char* nA = has_next ? (const char*)g.A + (size_t)nxt.pm * tstep : cA; const char* nB = has_next ? (const char*)g.Bt + (size_t)nxt.pn * tstep : cB;
        for (int t = 0; t < nt; t += 2) {
            const bool last = (t == nt - 2);
            const char* a1 = cA + (size_t)(t + 1) * kstep;
            const char* a2 = last ? nA : cA + (size_t)(t + 2) * kstep; const char* b2 = last ? nB : cB + (size_t)(t + 2) * kstep;
            const char* a3 = a2 + kstep; const char* b3 = b2 + kstep;
            if (last && has_next) S.a_ready(nxt);
            PG8_LDB(B0, 0, 0); PG8_SCHED; PG8_LDA(At, 0, 0); PG8_STAGE(PG8_SA(1, 1), a1 + hstep, voffA);
            PG8_WAIT_L(8); PG8_BAR; PG8_WAIT_L(0); PG8_MMA(0, 0, At, B0); PG8_BAR; PG8_SCHED;
            PG8_LDB(B1, 0, 1); PG8_STAGE(PG8_SB(0, 0), b2, voffB);
            PG8_BAR; PG8_WAIT_L(0); PG8_MMA(0, 1, At, B1); PG8_BAR;
            PG8_LDA(At, 0, 1); PG8_STAGE(PG8_SA(0, 0), a2, voffA);
            PG8_BAR; PG8_WAIT_L(0); PG8_MMA(1, 0, At, B0); PG8_BAR; PG8_SCHED;
            PG8_STAGE(PG8_SB(0, 1), b2 + hstep, voffB);
            PG8_WAIT_V(6); PG8_BAR; PG8_MMA(1, 1, At, B1); PG8_BAR;
            PG8_LDB(B0, 1, 0); PG8_SCHED; PG8_LDA(At, 1, 0); PG8_STAGE(PG8_SA(0, 1), a2 + hstep, voffA);
            PG8_WAIT_L(8); PG8_BAR; PG8_WAIT_L(0); PG8_MMA(0, 0, At, B0); PG8_BAR; PG8_SCHED;
            PG8_LDB(B1, 1, 1); PG8_STAGE(PG8_SB(1, 0), b3, voffB);
            PG8_BAR; PG8_WAIT_L(0); PG8_MMA(0, 1, At, B1); PG8_BAR;
            PG8_LDA(At, 1, 1); PG8_STAGE(PG8_SA(1, 0), a3, voffA);
            PG8_BAR; PG8_WAIT_L(0); PG8_MMA(1, 0, At, B0); PG8_BAR; PG8_SCHED;
            PG8_STAGE(PG8_SB(1, 1), b3 + hstep, voffB);
            PG8_WAIT_V(6); PG8_BAR; PG8_MMA(1, 1, At, B1); PG8_BAR;
        }
        PG8_STAMP();
        if constexpr (!Epi::AFTER_DRAIN) { E(acc, cur, wr, wc, fr, fq); S.done(cur); }
        PG8_STAMP();
        if (!has_next) break;
#pragma unroll
        for (int a = 0; a < 2; ++a)
#pragma unroll
            for (int b = 0; b < 2; ++b)
#pragma unroll
                for (int m = 0; m < 4; ++m)
#pragma unroll
                    for (int n = 0; n < 2; ++n) acc[a][b][m][n] = (f32x4){0.f, 0.f, 0.f, 0.f};
        cur = nxt; cA = nA; cB = nB; ++ui;
    }
    PG8_WAIT_V(0);
    if (wr == 0) PG8_BAR;
    PG8_BAR;
    if constexpr (Epi::AFTER_DRAIN) { E.fused(acc, cur, wr, wc, fr, fq, lds, wid, lane); S.done(cur); }
    PG8_STAMP();
    if (STAMP && wid == 0) { stamps[lane] = lane < nts ? (((unsigned long long)(unsigned)ts_hi << 32) | (unsigned)ts_lo) : 0ull;
        if (lane == 62) stamps[62] = rt_entry; if (lane == 63) stamps[63] = (unsigned long long)wall_clock64(); }
#undef PG8_STAMP
#undef PG8_SA
#undef PG8_SB
#undef PG8_STAGE
#undef PG8_LDA
#undef PG8_LDB
#undef PG8_MMA
#undef PG8_WAIT_V
#undef PG8_WAIT_L
#undef PG8_BAR
#undef PG8_SCHED
}
}
using pg8::bf16_t; using pg8::bf16x8; using pg8::f32x4; using pg8::Unit; using pg8::Gemm;
typedef short s16x4 __attribute__((ext_vector_type(4)));
typedef float f32x2 __attribute__((ext_vector_type(2)));

constexpr int NB = 4, SEQ = 4096, TT = NB * SEQ, DM = 2048, DFF = 8192;
constexpr int NWIN = 9216;
constexpr int LDPR = 3360;
constexpr int NIN = 29;
constexpr float SC_LOG2E = 0.08838834764831845f * 1.4426950408889634f;

constexpr size_t al4k(size_t x) { return (x + 4095) & ~(size_t)4095; }
constexpr size_t OFF_CTL  = 0;
constexpr size_t OFF_MISC = 65536;
constexpr size_t OFF_ROPE = 1u << 20;
constexpr size_t OFF_WIN  = OFF_ROPE + (size_t)TT * 16 * 8;
constexpr size_t OFF_W1T  = OFF_WIN + (size_t)NWIN * 2048 * 2;
constexpr size_t OFF_W2T  = OFF_W1T + (size_t)512 * 4096 * 2;
constexpr size_t OFF_LORA = OFF_W2T + (size_t)256 * 256 * 2;
constexpr size_t OFF_U    = al4k(OFF_LORA + (size_t)3072 * 384 * 2);
constexpr size_t OFF_QK   = OFF_U + (size_t)TT * 2048 * 2;
constexpr size_t OFF_VT   = OFF_QK + (size_t)TT * 4096 * 2;
constexpr size_t OFF_G    = OFF_VT + (size_t)NB * 1536 * SEQ * 2;
constexpr size_t OFF_PR   = OFF_G + (size_t)TT * 32 * 4;
constexpr size_t OFF_D    = al4k(OFF_PR + (size_t)TT * LDPR * 2);
constexpr size_t DSZ      = (size_t)TT * 1024 * 2;
constexpr size_t OFF_AL   = OFF_D + 6 * DSZ;
constexpr size_t OFF_BON  = OFF_AL + (size_t)TT * 384 * 2;
constexpr size_t OFF_CMPA = OFF_BON + (size_t)TT * 16 * 4;
constexpr size_t OFF_H    = OFF_CMPA + (size_t)4096 * 4096 * 2;
constexpr size_t OFF_KC   = OFF_H + (size_t)4096 * 256 * 2;
constexpr size_t OFF_VCT  = OFF_KC + (size_t)NB * 2 * 256 * 128 * 2;
constexpr size_t OFF_YRAW = OFF_VCT + (size_t)NB * 2 * 128 * 256 * 2;
constexpr size_t WS_END   = OFF_YRAW + (size_t)TT * 1024 * 4;
constexpr size_t OFF_WG   = OFF_QK;
constexpr size_t OFF_WB   = OFF_WG + (size_t)6144 * 2048 * 2;
constexpr size_t OFF_WO   = OFF_WB + (size_t)6144 * 1024 * 2;
constexpr size_t OFF_WUP  = OFF_WO + (size_t)2048 * 2048 * 2;
constexpr size_t OFF_WDN  = OFF_WUP + (size_t)8192 * 2048 * 2;
static_assert(OFF_WDN + (size_t)2048 * 8192 * 2 <= OFF_VT, "W2 must fit in the QK region");
constexpr size_t OFF_Z    = OFF_D;
constexpr size_t OFF_T1A  = OFF_D;
constexpr size_t OFF_HID  = OFF_D;
static_assert(OFF_HID + (size_t)TT * 8192 * 2 <= WS_END, "h must fit");
constexpr size_t OFF_T1B  = OFF_VT;
static_assert(OFF_T1B + (size_t)TT * 2048 * 4 <= OFF_D, "t1b must fit before D");
constexpr size_t OFF_MRG  = OFF_YRAW;
constexpr size_t OFF_SCR  = OFF_PR;
static_assert(OFF_SCR + (size_t)256 * 256 * 256 * 4 <= OFF_D, "scratch must fit");
constexpr int LDS_BYTES = 131072 + 1024;

struct Params { const void* in[NIN]; float* out; unsigned char* ws; int stage; int pad; };

DI bf16_t f2bf(float f) { unsigned u = __float_as_uint(f); u += 0x7fffu + ((u >> 16) & 1u); return (bf16_t)(u >> 16); }
DI float bf2f(bf16_t b) { return __uint_as_float(((unsigned)b) << 16); }
DI unsigned pack2(float lo, float hi) { return (unsigned)f2bf(lo) | ((unsigned)f2bf(hi) << 16); }
DI float sigmoidf_(float x) { return __builtin_amdgcn_rcpf(1.f + __expf(-x)); }
DI float wave_sum(float v) {
#pragma unroll
    for (int o = 32; o > 0; o >>= 1) v += __shfl_xor(v, o);
    return v;
}
DI void unpack8(const uint4& u, float (&f)[8]) {
    f[0] = __uint_as_float(u.x << 16); f[1] = __uint_as_float(u.x & 0xffff0000u);
    f[2] = __uint_as_float(u.y << 16); f[3] = __uint_as_float(u.y & 0xffff0000u);
    f[4] = __uint_as_float(u.z << 16); f[5] = __uint_as_float(u.z & 0xffff0000u);
    f[6] = __uint_as_float(u.w << 16); f[7] = __uint_as_float(u.w & 0xffff0000u);
}
DI uint4 pack8(const float (&f)[8]) { uint4 u; u.x = pack2(f[0], f[1]); u.y = pack2(f[2], f[3]); u.z = pack2(f[4], f[5]); u.w = pack2(f[6], f[7]); return u; }

struct ListOrder {
    int n, G, c, mode;
    DI bool next(int i, Unit& u) const {
        if (mode == 2) {
            const int j = i / 3, b = i - 3 * j, tile = j * G + c; if (tile >= 512) return false;
            u.pm = tile >> 3; u.pn = b * 8 + (tile & 7); return true;
        }
        const int L = i * G + c; if (L >= n) return false;
        if (mode == 0) { u.pm = L; u.pn = L >> 3; }
        else if (mode == 1) { u.pm = L; u.pn = 0; }
        else { const int b = L >> 9, tile = L & 511; u.pm = b * 64 + (tile >> 3); u.pn = b * 8 + (tile & 7); }
        return true;
    }
    DI void a_ready(const Unit&) const {}
    DI void done(const Unit&) const {}
};
struct EpiWin {
    static constexpr bool PERM = false, AFTER_DRAIN = false;
    bf16_t* QK; bf16_t* VT; float* G; bf16_t* PR; const float2* rope;
    DI void operator()(const f32x4 (&acc)[2][2][4][2], const Unit& u, int wr, int wc, int fr, int fq) const {
        const int pn = u.pn;
        const int row0 = u.pm * 256 + wr * 64 + fr;
        const bool isV = (pn == 7) || (pn == 9) || (pn >= 18 && pn <= 21);
        if (isV) {
            const int vbase = (pn == 7) ? 0 : (pn == 9) ? 256 : 512 + (pn - 18) * 256;
#pragma unroll
            for (int ai = 0; ai < 2; ++ai)
#pragma unroll
                for (int m = 0; m < 4; ++m) {
                    const int row = row0 + ai * 128 + m * 16; const int b = row >> 12, s = row & 4095;
#pragma unroll
                    for (int bj = 0; bj < 2; ++bj)
#pragma unroll
                        for (int n = 0; n < 2; ++n) {
                            const int cu = bj * 128 + wc * 32 + n * 16 + fq * 4;
                            bf16_t* dst = VT + ((size_t)(b * 1536 + vbase + cu) * SEQ + s);
#pragma unroll
                            for (int e = 0; e < 4; ++e) dst[(size_t)e * SEQ] = f2bf(acc[ai][bj][m][n][e]);
                        }
                }
        } else if (pn >= 22) {
#pragma unroll
            for (int ai = 0; ai < 2; ++ai)
#pragma unroll
                for (int m = 0; m < 4; ++m) {
                    const int row = row0 + ai * 128 + m * 16;
#pragma unroll
                    for (int bj = 0; bj < 2; ++bj)
#pragma unroll
                        for (int n = 0; n < 2; ++n) {
                            const int cu = bj * 128 + wc * 32 + n * 16 + fq * 4;
                            const f32x4 v = acc[ai][bj][m][n];
                            if (pn < 35 || cu < 32) {
                                const int col = (pn - 22) * 256 + cu;
                                uint2 o; o.x = pack2(v[0], v[1]); o.y = pack2(v[2], v[3]);
                                *(uint2*)(PR + (size_t)row * LDPR + col) = o;
                            } else if (cu < 56) {
                                *(f32x4*)(G + (size_t)row * 32 + (cu - 32)) = v;
                            }
                        }
                }
        } else {
            const int qoff = (pn <= 6) ? 0 : (pn == 8) ? -256 : -512;
            const bool dorope = (wc == 0) && (pn != 4) && (pn != 5);
#pragma unroll
            for (int ai = 0; ai < 2; ++ai)
#pragma unroll
                for (int m = 0; m < 4; ++m) {
                    const int row = row0 + ai * 128 + m * 16;
#pragma unroll
                    for (int bj = 0; bj < 2; ++bj) {
                        f32x4 v0 = acc[ai][bj][m][0], v1 = acc[ai][bj][m][1];
                        if (dorope) {
                            const float2* rp = rope + (size_t)row * 16 + fq * 4;
#pragma unroll
                            for (int e = 0; e < 4; ++e) { const float2 cs = rp[e]; const float a = v0[e], b2 = v1[e]; v0[e] = a * cs.x - b2 * cs.y; v1[e] = b2 * cs.x + a * cs.y; }
                        }
                        const int col = pn * 256 + qoff + bj * 128 + wc * 32 + fq * 4;
                        uint2 o; o.x = pack2(v0[0], v0[1]); o.y = pack2(v0[2], v0[3]);
                        *(uint2*)(QK + (size_t)row * 4096 + col) = o;
                        o.x = pack2(v1[0], v1[1]); o.y = pack2(v1[2], v1[3]);
                        *(uint2*)(QK + (size_t)row * 4096 + col + 16) = o;
                    }
                }
        }
    }
};

typedef _Float16 f16x4 __attribute__((ext_vector_type(4)));
DI float gelu_tanh(float x) { const float t = 0.7978845608028654f * (x + 0.044715f * x * x * x); const float e = __expf(2.f * t); const float th = 1.f - 2.f / (e + 1.f); return 0.5f * x * (1.f + th); }

template <int ACT  > struct EpiBf {
    static constexpr bool PERM = true, AFTER_DRAIN = false;
    bf16_t* O; int ldc; int pm_mod, pn_mod; size_t grp_stride;
    DI void operator()(const f32x4 (&acc)[2][2][4][2], const Unit& u, int wr, int wc, int fr, int fq) const {
        int pm = u.pm, pn = u.pn; bf16_t* base = O;
        if (pm_mod) { base += (size_t)(pm / pm_mod) * grp_stride; pm %= pm_mod; pn %= pn_mod; }
        const int row0 = pm * 256 + wr * 64 + fr, col0 = pn * 256 + wc * 32 + fq * 8;
#pragma unroll
        for (int ai = 0; ai < 2; ++ai)
#pragma unroll
            for (int m = 0; m < 4; ++m) {
                bf16_t* rowp = base + (size_t)(row0 + ai * 128 + m * 16) * ldc + col0;
#pragma unroll
                for (int bj = 0; bj < 2; ++bj) {
                    float f[8];
#pragma unroll
                    for (int e = 0; e < 4; ++e) { f[e] = acc[ai][bj][m][0][e]; f[4 + e] = acc[ai][bj][m][1][e]; }
#pragma unroll
                    for (int e = 0; e < 8; ++e) { if (ACT == 1) f[e] = gelu_tanh(f[e]); else if (ACT == 2) { const float r = fmaxf(f[e], 0.f); f[e] = r * r; } }
                    *(uint4*)(rowp + bj * 128) = pack8(f);
                }
            }
    }
};

template <int KV> struct EpiCmp2 {
    static constexpr bool PERM = false, AFTER_DRAIN = false;
    bf16_t* KC; bf16_t* VCT; const float2* rope;
    DI void operator()(const f32x4 (&acc)[2][2][4][2], const Unit& u, int wr, int wc, int fr, int fq) const {
        constexpr int kv = KV;
        const int row0 = (u.pm & 7) * 256 + wr * 64 + fr;
        if (kv == 0) {
#pragma unroll
            for (int ai = 0; ai < 2; ++ai)
#pragma unroll
                for (int m = 0; m < 4; ++m) {
                    int rr = row0 + ai * 128 + m * 16; asm volatile("" : "+v"(rr)); __builtin_amdgcn_sched_barrier(0); const int b = rr >> 9, c = (rr & 511) >> 1, g = rr & 1;
                    f32x4 v0 = acc[ai][0][m][0], v1 = acc[ai][0][m][1];
                    if (wc == 0) {
                        const int tok = b * SEQ + (c < 255 ? 16 * c + 31 : 0);
                        const float2* rp = rope + (size_t)tok * 16 + fq * 4;
#pragma unroll
                        for (int e = 0; e < 4; ++e) { const float2 cs = rp[e]; const float a = v0[e], b2 = v1[e]; v0[e] = a * cs.x - b2 * cs.y; v1[e] = b2 * cs.x + a * cs.y; }
                    }
                    bf16_t* dst = KC + ((size_t)((b * 2 + g) * 256 + c) * 128 + wc * 32 + fq * 4);
                    uint2 o; o.x = pack2(v0[0], v0[1]); o.y = pack2(v0[2], v0[3]); *(uint2*)dst = o;
                    o.x = pack2(v1[0], v1[1]); o.y = pack2(v1[2], v1[3]); *(uint2*)(dst + 16) = o;
                }
        } else {
#pragma unroll
            for (int ai = 0; ai < 2; ++ai)
#pragma unroll
                for (int m = 0; m < 4; ++m) {
                    int rr = row0 + ai * 128 + m * 16; asm volatile("" : "+v"(rr)); __builtin_amdgcn_sched_barrier(0); const int b = rr >> 9, c = (rr & 511) >> 1, g = rr & 1;
                    bf16_t* dst = VCT + (size_t)((b * 2 + g) * 128 + wc * 32 + fq * 4) * 256 + c;
#pragma unroll
                    for (int n = 0; n < 2; ++n)
#pragma unroll
                        for (int e = 0; e < 4; ++e) dst[(n * 16 + e) * 256] = f2bf(acc[ai][1][m][n][e]);
                }
        }
    }
};

struct EpiMerge {
    static constexpr bool PERM = true, AFTER_DRAIN = false;
    const bf16_t* Z; const float* bias; float* scr; bf16_t* M;
    template <int MODE> DI void run(const f32x4 (&acc)[2][2][4][2], const bf16_t* zp, const float* bp, float* sp, bf16_t* mp) const {
        float* s = sp;
#pragma unroll
        for (int bj = 0; bj < 2; ++bj)
#pragma unroll
            for (int n = 0; n < 2; ++n) {
                const f32x4 bv = *(const f32x4*)(bp + bj * 128 + n * 4);
                const bf16_t* zr = zp + bj * 128 + n * 4; bf16_t* mr = mp + bj * 128 + n * 4;
#pragma unroll
                for (int ai = 0; ai < 2; ++ai)
#pragma unroll
                    for (int m = 0; m < 4; ++m) {
                        asm volatile("" : "+v"(zr), "+v"(mr), "+v"(s));
                        const uint2 zz = *(const uint2*)zr;
                        f32x4 v;
                        v[0] = sigmoidf_(acc[ai][bj][m][n][0] + bv[0]) * __uint_as_float(zz.x << 16);
                        v[1] = sigmoidf_(acc[ai][bj][m][n][1] + bv[1]) * __uint_as_float(zz.x & 0xffff0000u);
                        v[2] = sigmoidf_(acc[ai][bj][m][n][2] + bv[2]) * __uint_as_float(zz.y << 16);
                        v[3] = sigmoidf_(acc[ai][bj][m][n][3] + bv[3]) * __uint_as_float(zz.y & 0xffff0000u);
                        if (MODE > 0) v += *(const f32x4*)s;
                        if (MODE < 2) *(f32x4*)s = v;
                        else { uint2 o; o.x = pack2(v[0], v[1]); o.y = pack2(v[2], v[3]); *(uint2*)mr = o; }
                        s += 2048;
                        const size_t step = (m == 3) ? (size_t)80 * 2048 : (size_t)16 * 2048;
                        zr += step; mr += step;
                    }
            }
    }
    DI void operator()(const f32x4 (&acc)[2][2][4][2], const Unit& u, int wr, int wc, int fr, int fq) const {
        const int b = u.pn >> 3, pn = u.pn & 7;
        const int row0 = u.pm * 256 + wr * 64 + fr, col0 = pn * 256 + wc * 32 + fq * 8;
        float* sp = scr + (size_t)blockIdx.x * 65536 + threadIdx.x * 4;
        const bf16_t* zp = Z + ((size_t)b * TT + row0) * 2048 + col0;
        bf16_t* mp = M + (size_t)row0 * 2048 + col0;
        const float* bp = bias + b * 2048 + col0;
        if (b == 0) run<0>(acc, zp, bp, sp, mp); else if (b == 1) run<1>(acc, zp, bp, sp, mp); else run<2>(acc, zp, bp, sp, mp);
    }
};
struct EpiF32 {
    static constexpr bool PERM = false, AFTER_DRAIN = false;
    float* C; int ldc;
    DI void operator()(const f32x4 (&acc)[2][2][4][2], const Unit& u, int wr, int wc, int fr, int fq) const {
        const int row0 = u.pm * 256 + wr * 64 + fr, col0 = u.pn * 256 + wc * 32 + 4 * fq;
#pragma unroll
        for (int ai = 0; ai < 2; ++ai)
#pragma unroll
            for (int m = 0; m < 4; ++m) { float* rowp = C + (size_t)(row0 + ai * 128 + m * 16) * ldc + col0;
#pragma unroll
                for (int bj = 0; bj < 2; ++bj)
#pragma unroll
                    for (int n = 0; n < 2; ++n) *(f32x4*)(rowp + bj * 128 + n * 16) = acc[ai][bj][m][n]; }
    }
};

template <class CM> DI void cvt_transpose(float* tile, const float* src, size_t ld_src, int K, int Ndst, bf16_t* dst, CM cm, int bid, int nblk) {
    int tid_l = threadIdx.x; asm volatile("" : "+v"(tid_l)); const int tid = tid_l, nkt = K >> 6, ntile = nkt * (Ndst >> 6);
    for (int t = bid; t < ntile; t += nblk) {
        const int k0 = (t % nkt) << 6, n0 = (t / nkt) << 6;
        __syncthreads();
        { const int j = tid & 63, kb = tid >> 6; const int sc = cm(n0 + j);
#pragma unroll
          for (int i = 0; i < 8; ++i) { const int k = kb + 8 * i; tile[k * 65 + j] = (sc >= 0) ? src[(size_t)(k0 + k) * ld_src + sc] : 0.f; } }
        __syncthreads();
        { const int kk = tid & 63, nb = tid >> 6;
#pragma unroll
          for (int i = 0; i < 8; ++i) { const int n = nb + 8 * i; dst[(size_t)(n0 + n) * K + k0 + kk] = f2bf(tile[kk * 65 + n]); } }
    }
}

DI void row_pass(const float* xin, const float* t1, const float* g1, float* xout, const float* g2, bf16_t* nout, int bid, int nblk) {
    int tid_l = threadIdx.x; asm volatile("" : "+v"(tid_l)); const int lane = tid_l & 63, w = tid_l >> 6;
    for (int row = bid * 8 + w; row < TT; row += nblk * 8) {
        f32x4 xv[8], tv[8]; float ss = 0.f;
#pragma unroll
        for (int i = 0; i < 8; ++i) { tv[i] = *(const f32x4*)(t1 + (size_t)row * DM + i * 256 + lane * 4); xv[i] = *(const f32x4*)(xin + (size_t)row * DM + i * 256 + lane * 4);
            ss += tv[i][0] * tv[i][0] + tv[i][1] * tv[i][1] + tv[i][2] * tv[i][2] + tv[i][3] * tv[i][3]; }
        ss = wave_sum(ss); const float rs = rsqrtf(ss * (1.f / DM) + 1e-6f);
        float s2 = 0.f;
#pragma unroll
        for (int i = 0; i < 8; ++i) { const f32x4 gg = *(const f32x4*)(g1 + i * 256 + lane * 4); xv[i] += tv[i] * rs * gg; *(f32x4*)(xout + (size_t)row * DM + i * 256 + lane * 4) = xv[i];
            s2 += xv[i][0] * xv[i][0] + xv[i][1] * xv[i][1] + xv[i][2] * xv[i][2] + xv[i][3] * xv[i][3]; }
        if (nout) {
            s2 = wave_sum(s2); const float r2 = rsqrtf(s2 * (1.f / DM) + 1e-6f);
#pragma unroll
            for (int i = 0; i < 8; ++i) { const f32x4 gg = *(const f32x4*)(g2 + i * 256 + lane * 4); const f32x4 v = xv[i] * r2 * gg; uint2 o; o.x = pack2(v[0], v[1]); o.y = pack2(v[2], v[3]);
                *(uint2*)(nout + (size_t)row * DM + i * 256 + lane * 4) = o; }
        }
    }
}
DI void norm_pass(const float* xin, const float* g, bf16_t* nout, int bid, int nblk) {
    int tid_l = threadIdx.x; asm volatile("" : "+v"(tid_l)); const int lane = tid_l & 63, w = tid_l >> 6;
    for (int row = bid * 8 + w; row < TT; row += nblk * 8) {
        f32x4 xv[8]; float ss = 0.f;
#pragma unroll
        for (int i = 0; i < 8; ++i) { xv[i] = *(const f32x4*)(xin + (size_t)row * DM + i * 256 + lane * 4); ss += xv[i][0] * xv[i][0] + xv[i][1] * xv[i][1] + xv[i][2] * xv[i][2] + xv[i][3] * xv[i][3]; }
        ss = wave_sum(ss); const float rs = rsqrtf(ss * (1.f / DM) + 1e-6f);
#pragma unroll
        for (int i = 0; i < 8; ++i) { const f32x4 gg = *(const f32x4*)(g + i * 256 + lane * 4); const f32x4 v = xv[i] * rs * gg; uint2 o; o.x = pack2(v[0], v[1]); o.y = pack2(v[2], v[3]);
            *(uint2*)(nout + (size_t)row * DM + i * 256 + lane * 4) = o; }
    }
}

DI void rwkv_shift(const bf16_t* PR, const float* mu, bf16_t* Dr, bf16_t* Dk, bf16_t* Dv, bf16_t* AL, int gtid, int gthreads) {
    const int NCH = 432;
    for (size_t idx = gtid; idx < (size_t)TT * NCH; idx += gthreads) {
        const int tok = (int)(idx / NCH), ch = (int)(idx % NCH);
        if (ch >= 420) { *(uint4*)(AL + (size_t)tok * 384 + 288 + (ch - 420) * 8) = make_uint4(0, 0, 0, 0); continue; }
        const int j = ch * 8;
        float p[8], q[8], v[8];
        unpack8(*(const uint4*)(PR + (size_t)tok * LDPR + j), p);
        if ((tok & (SEQ - 1)) != 0) unpack8(*(const uint4*)(PR + (size_t)(tok - 1) * LDPR + j), q);
        else {
#pragma unroll
            for (int e = 0; e < 8; ++e) q[e] = 0.f; }
        const f32x4 m0 = *(const f32x4*)(mu + j), m1 = *(const f32x4*)(mu + j + 4);
#pragma unroll
        for (int e = 0; e < 8; ++e) v[e] = p[e] + (q[e] - p[e]) * (e < 4 ? m0[e] : m1[e - 4]);
        bf16_t* dst;
        if (j < 1024) dst = Dr + (size_t)tok * 1024 + j;
        else if (j < 2048) dst = Dk + (size_t)tok * 1024 + (j - 1024);
        else if (j < 3072) dst = Dv + (size_t)tok * 1024 + (j - 2048);
        else {
            dst = AL + (size_t)tok * 384 + (j - 3072);
            if (j < 3136) {
#pragma unroll
                for (int e = 0; e < 8; ++e) { const float ex = __expf(2.f * v[e]); v[e] = 1.f - 2.f / (ex + 1.f); } }
            else if (j >= 3200) {
#pragma unroll
                for (int e = 0; e < 8; ++e) v[e] = sigmoidf_(v[e]); }
        }
        *(uint4*)dst = pack8(v);
    }
}

DI void build_cmpa(const bf16_t* QK, const float* pe, bf16_t* CMPA, int gtid, int gthreads) {
    for (size_t idx = gtid; idx < (size_t)4096 * 512; idx += gthreads) {
        const int R = (int)(idx >> 9), ch = (int)(idx & 511);
        const int kv = R >> 11, rr = R & 2047, b = rr >> 9, c = (rr & 511) >> 1, g = rr & 1;
        const int i = ch >> 4, d = (ch & 15) * 8;
        uint4 o = make_uint4(0, 0, 0, 0);
        if (c < 255) {
            float v[8]; unpack8(*(const uint4*)(QK + (size_t)(b * SEQ + 16 * c + i) * 4096 + 1024 + kv * 256 + g * 128 + d), v);
            const float* pp = pe + (size_t)kv * 4096 + i * 128 + d;
            const f32x4 p0 = *(const f32x4*)pp, p1 = *(const f32x4*)(pp + 4);
#pragma unroll
            for (int e = 0; e < 4; ++e) { v[e] += p0[e]; v[4 + e] += p1[e]; }
            o = pack8(v);
        }
        *(uint4*)(CMPA + (size_t)R * 4096 + ch * 8) = o;
    }
}

DI void rwkv_prep(const bf16_t* Dr, bf16_t* Dk, bf16_t* Dkk, bf16_t* Dka, const float* k_k, const float* k_a, const float* r_k, float* BON, const float* WRAW, const float* w0, const float* a0, _Float16* Dw, int gtid, int gthreads) {
    for (size_t idx = gtid; idx < (size_t)TT * 128; idx += gthreads) {
        const size_t off = idx * 8; const int col = (int)(off & 1023);
        float k[8], a[8], r[8], kk[8], kp[8], ka[8];
        unpack8(*(const uint4*)(Dk + off), k); unpack8(*(const uint4*)(Dka + off), a); unpack8(*(const uint4*)(Dr + off), r);
        { f16x4 h0, h1; const f32x4 wr0 = *(const f32x4*)(WRAW + off), wr1 = *(const f32x4*)(WRAW + off + 4);
#pragma unroll
          for (int e = 0; e < 4; ++e) { h0[e] = (_Float16)(__expf(-0.6065306597126334f * sigmoidf_(wr0[e] + w0[col + e])) - 1.0f); h1[e] = (_Float16)(__expf(-0.6065306597126334f * sigmoidf_(wr1[e] + w0[col + 4 + e])) - 1.0f); }
          *(f16x4*)(Dw + off) = h0; *(f16x4*)(Dw + off + 4) = h1; }
#pragma unroll
        for (int e = 0; e < 8; ++e) a[e] = sigmoidf_(a[e] + a0[col + e]);
        float ss = 0.f, bs = 0.f;
#pragma unroll
        for (int e = 0; e < 8; ++e) { kk[e] = k[e] * k_k[col + e]; ss += kk[e] * kk[e]; kp[e] = k[e] * (1.f + (a[e] - 1.f) * k_a[col + e]); bs += r[e] * kp[e] * r_k[col + e]; }
        ss += __shfl_xor(ss, 1); ss += __shfl_xor(ss, 2); ss += __shfl_xor(ss, 4);
        bs += __shfl_xor(bs, 1); bs += __shfl_xor(bs, 2); bs += __shfl_xor(bs, 4);
        const float inv = 1.f / fmaxf(sqrtf(ss), 1e-12f);
#pragma unroll
        for (int e = 0; e < 8; ++e) { kk[e] *= inv; ka[e] = kk[e] * a[e]; }
        *(uint4*)(Dk + off) = pack8(kp); *(uint4*)(Dkk + off) = pack8(kk); *(uint4*)(Dka + off) = pack8(ka);
        if ((idx & 7) == 0) BON[idx >> 3] = bs;
    }
}

DI void rwkv_final(const float* YRAW, const bf16_t* Dv, const float* BON, const float* lw, const float* lb, bf16_t* Y3R, int gtid, int gthreads) {
    for (size_t idx = gtid; idx < (size_t)TT * 128; idx += gthreads) {
        const size_t off = idx * 8; const int col = (int)(off & 1023);
        const f32x4 y0 = *(const f32x4*)(YRAW + off), y1 = *(const f32x4*)(YRAW + off + 4);
        float y[8] = {y0[0], y0[1], y0[2], y0[3], y1[0], y1[1], y1[2], y1[3]};
        float s = 0.f;
#pragma unroll
        for (int e = 0; e < 8; ++e) s += y[e];
        s += __shfl_xor(s, 1); s += __shfl_xor(s, 2); s += __shfl_xor(s, 4);
        const float mean = s * (1.f / 64.f);
        float vs = 0.f;
#pragma unroll
        for (int e = 0; e < 8; ++e) { y[e] -= mean; vs += y[e] * y[e]; }
        vs += __shfl_xor(vs, 1); vs += __shfl_xor(vs, 2); vs += __shfl_xor(vs, 4);
        const float rs = rsqrtf(vs * (1.f / 64.f) + 64e-5f);
        float v[8], g[8], o[8]; unpack8(*(const uint4*)(Dv + off), v); unpack8(*(const uint4*)(Y3R + off), g);
        const float bon = BON[idx >> 3];
#pragma unroll
        for (int e = 0; e < 8; ++e) o[e] = (y[e] * rs * lw[col + e] + lb[col + e] + bon * v[e]) * g[e];
        *(uint4*)(Y3R + off) = pack8(o);
    }
}
#define MFMA16(a, b, c) __builtin_amdgcn_mfma_f32_16x16x32_bf16((a), (b), (c), 0, 0, 0)
constexpr int KPITCH = 288, VPITCH = 144, KTILE_B = 64 * KPITCH;

DI void qk_tile(const LAS unsigned char* Kt, const bf16x8 (&qf)[4], f32x4 (&s)[4], int lane) {
    const int key = lane & 15, quad = lane >> 4;
#pragma unroll
    for (int sub = 0; sub < 4; ++sub) {
        f32x4 a = {0.f, 0.f, 0.f, 0.f};
#pragma unroll
        for (int ks = 0; ks < 4; ++ks) {
            const bf16x8 kf = *(const LAS bf16x8*)(Kt + (sub * 16 + key) * KPITCH + ks * 64 + quad * 16);
            a = MFMA16(kf, qf[ks], a);
        }
        s[sub] = a;
    }
}
template <int DVT, class MaskFn> DI void softmax_pv(const LAS unsigned char* Vt, f32x4 (&s)[4], f32x4 (&o)[DVT], float& m, float& l, MaskFn valid, int lane) {
    const int quad = lane >> 4, dv = lane & 15;
    float mx = -INFINITY;
#pragma unroll
    for (int sub = 0; sub < 4; ++sub)
#pragma unroll
        for (int j = 0; j < 4; ++j) { const float v = valid(sub * 16 + quad * 4 + j) ? s[sub][j] * SC_LOG2E : -INFINITY; s[sub][j] = v; mx = fmaxf(mx, v); }
    mx = fmaxf(mx, __shfl_xor(mx, 16)); mx = fmaxf(mx, __shfl_xor(mx, 32));
    const float mn = fmaxf(m, mx);
    const float alpha = __builtin_amdgcn_exp2f(m - mn);
    m = mn;
    float ps = 0.f;
#pragma unroll
    for (int sub = 0; sub < 4; ++sub)
#pragma unroll
        for (int j = 0; j < 4; ++j) { const float p = __builtin_amdgcn_exp2f(s[sub][j] - mn); s[sub][j] = p; ps += p; }
    l = l * alpha + ps;
#pragma unroll
    for (int t = 0; t < DVT; ++t) o[t] *= alpha;
#pragma unroll
    for (int k2 = 0; k2 < 2; ++k2) {
        union { unsigned u[4]; bf16x8 v; } pb;
        pb.u[0] = pack2(s[2 * k2][0], s[2 * k2][1]); pb.u[1] = pack2(s[2 * k2][2], s[2 * k2][3]);
        pb.u[2] = pack2(s[2 * k2 + 1][0], s[2 * k2 + 1][1]); pb.u[3] = pack2(s[2 * k2 + 1][2], s[2 * k2 + 1][3]);
#pragma unroll
        for (int t = 0; t < DVT; ++t) {
            const LAS unsigned char* ap = Vt + (t * 16 + dv) * VPITCH + (k2 * 32 + quad * 4) * 2;
            const s16x4 lo = *(const LAS s16x4*)ap, hi = *(const LAS s16x4*)(ap + 32);
            const bf16x8 vf = __builtin_shufflevector(lo, hi, 0, 1, 2, 3, 4, 5, 6, 7);
            o[t] = MFMA16(vf, pb.v, o[t]);
        }
    }
}
DI void ldk(uint4 (&r)[2], const bf16_t* src, size_t ld, int tid) {
#pragma unroll
    for (int i = 0; i < 2; ++i) { const int c = tid + 512 * i; r[i] = *(const uint4*)(src + (size_t)(c >> 4) * ld + (c & 15) * 8); }
}
DI void stk(LAS unsigned char* Kt, const uint4 (&r)[2], int tid) {
#pragma unroll
    for (int i = 0; i < 2; ++i) { const int c = tid + 512 * i; *(LAS pg8::u32x4*)(Kt + (c >> 4) * KPITCH + (c & 15) * 16) = (pg8::u32x4){r[i].x, r[i].y, r[i].z, r[i].w}; }
}
template <int NCH> DI void ldv(uint4 (&r)[NCH], const bf16_t* src, size_t ld, int tid) {
#pragma unroll
    for (int i = 0; i < NCH; ++i) { const int c = tid + 512 * i; r[i] = *(const uint4*)(src + (size_t)(c >> 3) * ld + (c & 7) * 8); }
}
template <int NCH> DI void stv(LAS unsigned char* Vt, const uint4 (&r)[NCH], int tid) {
#pragma unroll
    for (int i = 0; i < NCH; ++i) { const int c = tid + 512 * i; *(LAS pg8::u32x4*)(Vt + (c >> 3) * VPITCH + (c & 7) * 16) = (pg8::u32x4){r[i].x, r[i].y, r[i].z, r[i].w}; }
}

DI void diff_unit(const bf16_t* QK, const bf16_t* VT, const float* subln, float lam_full, float out_scale, bf16_t* Y, int b, int h, int qt, LAS unsigned char* lds) {
    int tid_l = threadIdx.x; asm volatile("" : "+v"(tid_l)); const int tid = tid_l, lane = tid & 63, w = tid >> 6, mm = w >> 2, quad = lane >> 4;
    const int q0 = qt * 64, t = q0 + (w & 3) * 16 + (lane & 15);
    LAS unsigned char* K0 = lds; LAS unsigned char* Vt = lds + 2 * KTILE_B;
    bf16x8 qf[4];
    { const bf16_t* qp = QK + (size_t)(b * SEQ + t) * 4096 + 2048 + (h * 2 + mm) * 128 + quad * 8;
#pragma unroll
      for (int ks = 0; ks < 4; ++ks) qf[ks] = *(const bf16x8*)(qp + ks * 32); }
    f32x4 o[16];
#pragma unroll
    for (int i = 0; i < 16; ++i) o[i] = (f32x4){0.f, 0.f, 0.f, 0.f};
    float m = -1e30f, l = 0.f;
    const bf16_t* kbase = QK + (size_t)b * SEQ * 4096 + 3072 + h * 256;
    const bf16_t* vbase = VT + (size_t)(b * 1536 + 512 + h * 256) * SEQ;
    uint4 rk0[2], rk1[2], rv[4];
    ldk(rk0, kbase, 4096, tid); ldk(rk1, kbase + 128, 4096, tid); ldv<4>(rv, vbase, SEQ, tid);
    for (int j = 0; j <= qt; ++j) {
        __syncthreads();
        stk(K0, rk0, tid); stk(K0 + KTILE_B, rk1, tid); stv<4>(Vt, rv, tid);
        __syncthreads();
        if (j < qt) { const bf16_t* kp = kbase + (size_t)(j + 1) * 64 * 4096; ldk(rk0, kp, 4096, tid); ldk(rk1, kp + 128, 4096, tid); ldv<4>(rv, vbase + (j + 1) * 64, SEQ, tid); }
        f32x4 s[4];
        qk_tile(K0 + mm * KTILE_B, qf, s, lane);
        const int kb = j * 64;
        softmax_pv<16>(Vt, s, o, m, l, [&](int kidx) { return kb + kidx <= t; }, lane);
    }
    l += __shfl_xor(l, 16); l += __shfl_xor(l, 32);
    const float inv = 1.f / l;
    __syncthreads();
    float* xb = (float*)lds;
    if (mm == 1) {
#pragma unroll
        for (int i = 0; i < 16; ++i) *(f32x4*)(xb + ((size_t)((w & 3) * 16 + (lane & 15)) * 256 + i * 16 + quad * 4)) = o[i] * (inv * lam_full);
    }
    __syncthreads();
    if (mm == 0) {
        float ss = 0.f;
#pragma unroll
        for (int i = 0; i < 16; ++i) { const f32x4 o1 = *(const f32x4*)(xb + ((size_t)((w & 3) * 16 + (lane & 15)) * 256 + i * 16 + quad * 4));
            o[i] = o[i] * inv - o1; ss += o[i][0] * o[i][0] + o[i][1] * o[i][1] + o[i][2] * o[i][2] + o[i][3] * o[i][3]; }
        ss += __shfl_xor(ss, 16); ss += __shfl_xor(ss, 32);
        const float rs = rsqrtf(ss * (1.f / 256.f) + 1e-5f) * out_scale;
        bf16_t* yp = Y + (size_t)(b * SEQ + t) * 1024 + h * 256 + quad * 4;
#pragma unroll
        for (int i = 0; i < 16; ++i) { const f32x4 g = *(const f32x4*)(subln + i * 16 + quad * 4); const f32x4 v = o[i] * rs * g; uint2 pk; pk.x = pack2(v[0], v[1]); pk.y = pack2(v[2], v[3]); *(uint2*)(yp + i * 16) = pk; }
    }
    __syncthreads();
}

DI void nsa_unit(const bf16_t* QK, const bf16_t* VT, const bf16_t* KC, const bf16_t* VCT, const float* G, bf16_t* Y, int b, int g, int qt, LAS unsigned char* lds) {
    int tid_l = threadIdx.x; asm volatile("" : "+v"(tid_l)); const int tid = tid_l, lane = tid & 63, w = tid >> 6, hh = w >> 1, quad = lane >> 4;
    const int q0 = qt * 32, ql = (w & 1) * 16 + (lane & 15), t = q0 + ql;
    LAS unsigned char* Kt = lds; LAS unsigned char* Vt = lds + KTILE_B;
    float* impA = (float*)(lds + 2 * KTILE_B);
    float* impB = impA + 4 * 32 * 64;
    unsigned long long* selm = (unsigned long long*)(impB + 4 * 32 * 64);
    const size_t tok = (size_t)b * SEQ + t;
    bf16x8 qf[4];
    { const bf16_t* qp = QK + tok * 4096 + (g * 4 + hh) * 128 + quad * 8;
#pragma unroll
      for (int ks = 0; ks < 4; ++ks) qf[ks] = *(const bf16x8*)(qp + ks * 32); }
    const float* gp = G + tok * 32 + (g * 4 + hh) * 3;
    const float g0 = sigmoidf_(gp[0]), g1 = sigmoidf_(gp[1]), g2 = sigmoidf_(gp[2]);
    f32x4 out[8];
#pragma unroll
    for (int i = 0; i < 8; ++i) out[i] = (f32x4){0.f, 0.f, 0.f, 0.f};
    for (int i = tid; i < 2 * 4 * 32 * 64; i += 512) impA[i] = 0.f;
    uint4 rk[2], rv[2];
    f32x4 o[8];
    float m, l;
    const int ntc = (q0 >> 10) + 1;
    const bf16_t* kcb = KC + (size_t)(b * 2 + g) * 256 * 128;
    const bf16_t* vcb = VCT + (size_t)(b * 2 + g) * 128 * 256;
#pragma unroll
    for (int i = 0; i < 8; ++i) o[i] = (f32x4){0.f, 0.f, 0.f, 0.f};
    m = -1e30f; l = 0.f;
    ldk(rk, kcb, 128, tid); ldv<2>(rv, vcb, 256, tid);
    for (int j = 0; j < ntc; ++j) {
        __syncthreads();
        stk(Kt, rk, tid); stv<2>(Vt, rv, tid);
        __syncthreads();
        if (j + 1 < ntc) { ldk(rk, kcb + (size_t)(j + 1) * 64 * 128, 128, tid); ldv<2>(rv, vcb + (j + 1) * 64, 256, tid); }
        f32x4 s[4];
        qk_tile(Kt, qf, s, lane);
        const int cb = j * 64;
        softmax_pv<8>(Vt, s, o, m, l, [&](int kidx) { const int c = cb + kidx; return (c <= 254) && (16 * c + 31 <= t); }, lane);
    }
    l += __shfl_xor(l, 16); l += __shfl_xor(l, 32);
    const float invc = (l > 0.f) ? 1.f / l : 0.f;
#pragma unroll
    for (int i = 0; i < 8; ++i) out[i] += o[i] * (invc * g0);
    ldk(rk, kcb, 128, tid);
    for (int j = 0; j < ntc; ++j) {
        __syncthreads();
        stk(Kt, rk, tid);
        __syncthreads();
        if (j + 1 < ntc) ldk(rk, kcb + (size_t)(j + 1) * 64 * 128, 128, tid);
        f32x4 s[4];
        qk_tile(Kt, qf, s, lane);
#pragma unroll
        for (int sub = 0; sub < 4; ++sub) {
            float p[4];
#pragma unroll
            for (int e = 0; e < 4; ++e) { const int c = j * 64 + sub * 16 + quad * 4 + e; const bool ok = (c <= 254) && (16 * c + 31 <= t);
                p[e] = ok ? __builtin_amdgcn_exp2f(s[sub][e] * SC_LOG2E - m) * invc : 0.f; }
            const int jb = j * 16 + sub * 4 + quad;
            impA[(hh * 32 + ql) * 64 + jb] = p[0] + p[1] + p[2] + p[3];
            if (jb + 1 < 64) impB[(hh * 32 + ql) * 64 + jb + 1] = p[3];
        }
    }
    __syncthreads();
#pragma unroll 1
    for (int qi = 0; qi < 4; ++qi) {
        const int qq = w * 4 + qi, tq = q0 + qq, blk = tq >> 6;
        float v = 0.f;
#pragma unroll
        for (int h2 = 0; h2 < 4; ++h2) v += impA[(h2 * 32 + qq) * 64 + lane] + impB[(h2 * 32 + qq) * 64 + lane];
        if (lane == 0 || lane == blk || lane == blk - 1) v = 1e9f; else if (lane > blk) v = -INFINITY;
        int rank = 0;
#pragma unroll 2
        for (int jj = 0; jj < 64; ++jj) { const float o2 = __shfl(v, jj); rank += (o2 > v || (o2 == v && jj < lane)) ? 1 : 0; }
        const unsigned long long msk = __ballot((rank < 16) && (lane <= blk));
        if (lane == 0) selm[qq] = msk;
    }
    __syncthreads();
    unsigned long long un = 0ull;
#pragma unroll 1
    for (int i = 0; i < 32; ++i) un |= selm[i];
    const unsigned long long my = selm[ql];
    {
        const bf16_t* kb = QK + (size_t)b * SEQ * 4096 + 1536 + g * 128;
        const bf16_t* vb = VT + (size_t)(b * 1536 + g * 128) * SEQ;
#pragma unroll
        for (int i = 0; i < 8; ++i) o[i] = (f32x4){0.f, 0.f, 0.f, 0.f};
        m = -1e30f; l = 0.f;
        unsigned long long rem = un;
        int j = __builtin_ctzll(rem); rem &= rem - 1;
        ldk(rk, kb + (size_t)j * 64 * 4096, 4096, tid); ldv<2>(rv, vb + j * 64, SEQ, tid);
        for (;;) {
            __syncthreads();
            stk(Kt, rk, tid); stv<2>(Vt, rv, tid);
            __syncthreads();
            const int jn = rem ? __builtin_ctzll(rem) : -1;
            if (jn >= 0) { rem &= rem - 1; ldk(rk, kb + (size_t)jn * 64 * 4096, 4096, tid); ldv<2>(rv, vb + jn * 64, SEQ, tid); }
            f32x4 s[4];
            qk_tile(Kt, qf, s, lane);
            const bool sel = (my >> j) & 1ull; const int kbs = j * 64;
            softmax_pv<8>(Vt, s, o, m, l, [&](int kidx) { return sel && (kbs + kidx <= t); }, lane);
            if (jn < 0) break;
            j = jn;
        }
        l += __shfl_xor(l, 16); l += __shfl_xor(l, 32);
        const float inv = (l > 0.f) ? 1.f / l : 0.f;
#pragma unroll
        for (int i = 0; i < 8; ++i) out[i] += o[i] * (inv * g1);
    }
    {
        const bf16_t* kb = QK + (size_t)b * SEQ * 4096 + 1792 + g * 128;
        const bf16_t* vb = VT + (size_t)(b * 1536 + 256 + g * 128) * SEQ;
#pragma unroll
        for (int i = 0; i < 8; ++i) o[i] = (f32x4){0.f, 0.f, 0.f, 0.f};
        m = -1e30f; l = 0.f;
        const int jlo = (q0 >= 511) ? ((q0 - 511) >> 6) : 0, jhi = q0 >> 6;
        ldk(rk, kb + (size_t)jlo * 64 * 4096, 4096, tid); ldv<2>(rv, vb + jlo * 64, SEQ, tid);
        for (int j = jlo; j <= jhi; ++j) {
            __syncthreads();
            stk(Kt, rk, tid); stv<2>(Vt, rv, tid);
            __syncthreads();
            if (j < jhi) { ldk(rk, kb + (size_t)(j + 1) * 64 * 4096, 4096, tid); ldv<2>(rv, vb + (j + 1) * 64, SEQ, tid); }
            f32x4 s[4];
            qk_tile(Kt, qf, s, lane);
            const int kbs = j * 64;
            softmax_pv<8>(Vt, s, o, m, l, [&](int kidx) { const int d = t - (kbs + kidx); return d >= 0 && d < 512; }, lane);
        }
        l += __shfl_xor(l, 16); l += __shfl_xor(l, 32);
        const float inv = (l > 0.f) ? 1.f / l : 0.f;
#pragma unroll
        for (int i = 0; i < 8; ++i) out[i] += o[i] * (inv * g2);
    }
    bf16_t* yp = Y + tok * 1024 + (g * 4 + hh) * 128 + quad * 4;
#pragma unroll
    for (int i = 0; i < 8; ++i) { uint2 pk; pk.x = pack2(out[i][0], out[i][1]); pk.y = pack2(out[i][2], out[i][3]); *(uint2*)(yp + i * 16) = pk; }
    __syncthreads();
}
template <int CTRL> DI float dpp_add(float x) { const int y = __builtin_amdgcn_update_dpp(0, __float_as_int(x), CTRL, 0xF, 0xF, true); return x + __int_as_float(y); }
DI float red16(float x) { x = dpp_add<0xB1>(x); x = dpp_add<0x4E>(x); x = dpp_add<0x141>(x); x = dpp_add<0x140>(x); return x; }
constexpr int SCH = 32, SBUF_F = 5 * SCH * 64 + SCH * 32;
DI void scan_unit(const bf16_t* Dr, const bf16_t* Dk, const bf16_t* Dv, const bf16_t* Dkk, const bf16_t* Dka, const _Float16* Dw, float* YRAW, int b, int h, int half, LAS unsigned char* lds) {
    int tid_l = threadIdx.x; asm volatile("" : "+v"(tid_l)); const int tid = tid_l, lane = tid & 63, w = tid >> 6;
    const int rl = w * 4 + (lane >> 4), kq = lane & 15;
    LAS float* buf = (LAS float*)lds;
    const size_t base = (size_t)b * SEQ * 1024 + h * 64;
    const int st_tok = tid >> 4, st_k = (tid & 15) * 4;
    const int sv_tok = (tid >> 3) & 31, sv_r = (tid & 7) * 4;
    uint2 g_r, g_k, g_kk, g_ka, g_w, g_v;
    auto gload = [&](int ck) {
        const size_t o = base + (size_t)(ck * SCH + st_tok) * 1024 + st_k;
        g_r = *(const uint2*)(Dr + o); g_k = *(const uint2*)(Dk + o); g_kk = *(const uint2*)(Dkk + o); g_ka = *(const uint2*)(Dka + o); g_w = *(const uint2*)(Dw + o);
        if (tid < 256) g_v = *(const uint2*)(Dv + base + (size_t)(ck * SCH + sv_tok) * 1024 + half * 32 + sv_r);
    };
    auto cvt4 = [&](const uint2& u) { f32x4 f; f[0] = __uint_as_float(u.x << 16); f[1] = __uint_as_float(u.x & 0xffff0000u); f[2] = __uint_as_float(u.y << 16); f[3] = __uint_as_float(u.y & 0xffff0000u); return f; };
    auto lstore = [&](int bi) {
        LAS float* p = buf + bi * SBUF_F + st_tok * 64 + st_k;
        *(LAS f32x4*)(p) = cvt4(g_r); *(LAS f32x4*)(p + SCH * 64) = cvt4(g_k); *(LAS f32x4*)(p + 2 * SCH * 64) = cvt4(g_kk); *(LAS f32x4*)(p + 3 * SCH * 64) = cvt4(g_ka);
        { union { uint2 u; _Float16 hh[4]; } c; c.u = g_w; f32x4 f; f[0] = 1.f + (float)c.hh[0]; f[1] = 1.f + (float)c.hh[1]; f[2] = 1.f + (float)c.hh[2]; f[3] = 1.f + (float)c.hh[3]; *(LAS f32x4*)(p + 4 * SCH * 64) = f; }
        if (tid < 256) *(LAS f32x4*)(buf + bi * SBUF_F + 5 * SCH * 64 + sv_tok * 32 + sv_r) = cvt4(g_v);
    };
    f32x4 st = {0.f, 0.f, 0.f, 0.f};
    gload(0);
    __syncthreads();
    lstore(0);
    __syncthreads();
    float* yout = YRAW + base + half * 32 + rl;
    for (int ck = 0; ck < SEQ / SCH; ++ck) {
        const int bi = ck & 1;
        if (ck + 1 < SEQ / SCH) gload(ck + 1);
        const LAS float* p = buf + bi * SBUF_F + kq * 4;
        const LAS float* pv = buf + bi * SBUF_F + 5 * SCH * 64 + rl;
#pragma unroll 4
        for (int tt = 0; tt < SCH; ++tt) {
            const f32x4 r4 = *(const LAS f32x4*)(p + tt * 64), k4 = *(const LAS f32x4*)(p + SCH * 64 + tt * 64), kk4 = *(const LAS f32x4*)(p + 2 * SCH * 64 + tt * 64),
                        ka4 = *(const LAS f32x4*)(p + 3 * SCH * 64 + tt * 64), w4 = *(const LAS f32x4*)(p + 4 * SCH * 64 + tt * 64);
            const float vv = pv[tt * 32];
            float dot = st[0] * kk4[0] + st[1] * kk4[1] + st[2] * kk4[2] + st[3] * kk4[3];
            dot = red16(dot);
            const float sa = -dot;
            st = st * w4 + ka4 * sa + k4 * vv;
            float y = st[0] * r4[0] + st[1] * r4[1] + st[2] * r4[2] + st[3] * r4[3];
            y = red16(y);
            if (kq == 0) yout[(size_t)(ck * SCH + tt) * 1024] = y;
        }
        if (ck + 1 < SEQ / SCH) lstore(bi ^ 1);
        __syncthreads();
    }
}
#define PH_BEGIN const Params* PP = &P; unsigned char* ws = P.ws; asm volatile("" : "+s"(ws)); int tid = threadIdx.x; asm volatile("" : "+v"(tid)); int bid = blockIdx.x; asm volatile("" : "+s"(bid)); \
    const int G = gridDim.x; const int gtid = bid * 512 + tid, gthreads = G * 512; (void)gtid; (void)gthreads; (void)ws;
#define WSP(T, off) ((T*)(ws + (off)))
#define INP(i, stride) ((const float*)PP->in[i] + (size_t)L * (stride))
template <int KIND> __global__ void __launch_bounds__(512, 2) fwd_megakernel(Params P) {
    extern __shared__ __attribute__((aligned(16))) unsigned char lds_raw[];
    LAS unsigned char* lds = (LAS unsigned char*)lds_raw;

    float* tile = (float*)lds_raw;

    if (KIND == 0) { PH_BEGIN if (PP->stage == 0) {
      const int* positions = (const int*)PP->in[1]; float2* ROPE = WSP(float2, OFF_ROPE);
      for (int i = gtid; i < TT * 16; i += gthreads) {
        const int tok = i >> 4, f = i & 15;
        const float inv = (float)pow(500000.0, -(double)f / 16.0);
        const float ang = (float)positions[tok] * inv;
        const double a = (double)ang; const double k = rint(a * 0.15915494309189535); const float r = (float)(a - k * 6.283185307179586);
        ROPE[i] = make_float2(__cosf(r), __sinf(r));
      }
      norm_pass((const float*)PP->in[0], (const float*)PP->in[2], WSP(bf16_t, OFF_U), bid, G); } }

#pragma unroll
    for (int L = 0; L < 2; ++L) {
        int stg; stg = P.stage;
        if (KIND == 0 && stg == L) {
        { PH_BEGIN
          const float* cmp_w1 = INP(8, 2 * 4096 * 256); const float* cmp_w2 = INP(9, 2 * 256 * 128);
          cvt_transpose(tile, INP(6, 2048 * 9016), 9016, 2048, NWIN, WSP(bf16_t, OFF_WIN), [](int n) { return n < 2560 ? n : (n < 8992 ? n + 24 : (n < 9016 ? n - 8992 + 2560 : -1)); }, bid, G);
          cvt_transpose(tile, cmp_w1, 256, 4096, 256, WSP(bf16_t, OFF_W1T), [](int n) { return n; }, bid, G);
          cvt_transpose(tile, cmp_w1 + (size_t)4096 * 256, 256, 4096, 256, WSP(bf16_t, OFF_W1T) + (size_t)256 * 4096, [](int n) { return n; }, bid, G);
          bf16_t* W2T = WSP(bf16_t, OFF_W2T);
          for (int i = gtid; i < 256 * 256; i += gthreads) { const int n = i >> 8, k = i & 255; W2T[i] = f2bf(cmp_w2[(size_t)(n >> 7) * 256 * 128 + (size_t)k * 128 + (n & 127)]); }
          const float* w_up_l = INP(14, 64 * 1024); const float* a_up = INP(16, 64 * 1024); const float* g_up = INP(17, 160 * 1024); bf16_t* LORA = WSP(bf16_t, OFF_LORA);
          for (int i = gtid; i < 3072 * 384; i += gthreads) {
            const int n = i / 384, k = i - n * 384, kind = n >> 10, c = n & 1023; float v = 0.f;
            if (kind == 0) { if (k < 64) v = w_up_l[(size_t)k * 1024 + c]; }
            else if (kind == 1) { if (k >= 64 && k < 128) v = a_up[(size_t)(k - 64) * 1024 + c]; }
            else { if (k >= 128 && k < 288) v = g_up[(size_t)(k - 128) * 1024 + c]; }
            LORA[i] = f2bf(v);
          }
          if (gtid == 0) { const float* dlam = INP(10, 512); const float lam_init = 0.8f - 0.6f * expf(-0.3f * (float)L);
            float s01 = 0.f, s23 = 0.f; for (int i = 0; i < 128; ++i) { s01 += dlam[i] * dlam[128 + i]; s23 += dlam[256 + i] * dlam[384 + i]; } WSP(float, OFF_MISC)[L] = expf(s01) - expf(s23) + lam_init; } }
        cg::this_grid().sync();

        { PH_BEGIN
          pg8::StaticOrder S; S.init(TT, NWIN, G, bid); EpiWin E{WSP(bf16_t, OFF_QK), WSP(bf16_t, OFF_VT), WSP(float, OFF_G), WSP(bf16_t, OFF_PR), WSP(const float2, OFF_ROPE)};
          pg8::gemm_phase<EpiWin, pg8::StaticOrder>(lds, Gemm{WSP(bf16_t, OFF_U), WSP(bf16_t, OFF_WIN), TT, NWIN, 2048}, S, E, nullptr); }
        cg::this_grid().sync();

        { PH_BEGIN
          bf16_t* Dr = WSP(bf16_t, OFF_D);
          rwkv_shift(WSP(bf16_t, OFF_PR), INP(12, 3360), Dr, Dr + (size_t)TT * 1024, Dr + (size_t)2 * TT * 1024, WSP(bf16_t, OFF_AL), gtid, gthreads);
          build_cmpa(WSP(bf16_t, OFF_QK), INP(7, 2 * 32 * 128), WSP(bf16_t, OFF_CMPA), gtid, gthreads); }
        cg::this_grid().sync();

        { PH_BEGIN
          ListOrder S{16, G, G - 1 - bid, 0}; EpiBf<1> E{WSP(bf16_t, OFF_H), 256, 16, 1, 0};
          pg8::gemm_phase<EpiBf<1>, ListOrder>(lds, Gemm{WSP(bf16_t, OFF_CMPA), WSP(bf16_t, OFF_W1T), 4096, 512, 4096}, S, E, nullptr); }
        { PH_BEGIN
          int K384 = 384; asm volatile("" : "+s"(K384));
          pg8::StaticOrder S; S.init(TT, 1024, G, bid); EpiF32 E{WSP(float, OFF_YRAW), 1024};
          pg8::gemm_phase<EpiF32, pg8::StaticOrder>(lds, Gemm{WSP(bf16_t, OFF_AL), WSP(bf16_t, OFF_LORA), TT, 1024, K384}, S, E, nullptr); }
        { PH_BEGIN
          int K384 = 384; asm volatile("" : "+s"(K384));
          pg8::StaticOrder S; S.init(TT, 1024, G, bid); EpiBf<0> E{WSP(bf16_t, OFF_D) + (size_t)4 * TT * 1024, 1024, 64, 4, 0};
          pg8::gemm_phase<EpiBf<0>, pg8::StaticOrder>(lds, Gemm{WSP(bf16_t, OFF_AL), WSP(bf16_t, OFF_LORA) + (size_t)1024 * 384, TT, 1024, K384}, S, E, nullptr); }
        { PH_BEGIN
          int K384 = 384; asm volatile("" : "+s"(K384));
          pg8::StaticOrder S; S.init(TT, 1024, G, bid); EpiBf<0> E{WSP(bf16_t, OFF_PR) + (size_t)2 * TT * 1024, 1024, 64, 4, 0};
          pg8::gemm_phase<EpiBf<0>, pg8::StaticOrder>(lds, Gemm{WSP(bf16_t, OFF_AL), WSP(bf16_t, OFF_LORA) + (size_t)2048 * 384, TT, 1024, K384}, S, E, nullptr); }
        cg::this_grid().sync();

        { PH_BEGIN
          ListOrder S{8, G, bid, 1}; EpiCmp2<0> E{WSP(bf16_t, OFF_KC), WSP(bf16_t, OFF_VCT), WSP(const float2, OFF_ROPE)};
          pg8::gemm_phase<EpiCmp2<0>, ListOrder>(lds, Gemm{WSP(bf16_t, OFF_H), WSP(bf16_t, OFF_W2T), 2048, 256, 256}, S, E, nullptr); }
        { PH_BEGIN
          ListOrder S{8, G, G - 1 - bid, 1}; EpiCmp2<1> E{WSP(bf16_t, OFF_KC), WSP(bf16_t, OFF_VCT), WSP(const float2, OFF_ROPE)};
          pg8::gemm_phase<EpiCmp2<1>, ListOrder>(lds, Gemm{WSP(bf16_t, OFF_H) + (size_t)2048 * 256, WSP(bf16_t, OFF_W2T), 2048, 256, 256}, S, E, nullptr); }
        { PH_BEGIN
          bf16_t* Dr = WSP(bf16_t, OFF_D);
          rwkv_prep(Dr, Dr + (size_t)TT * 1024, Dr + (size_t)3 * TT * 1024, Dr + (size_t)4 * TT * 1024, INP(18, 1024), INP(19, 1024), INP(20, 1024), WSP(float, OFF_BON), WSP(float, OFF_YRAW), INP(13, 1024), INP(15, 1024), (_Float16*)(Dr + (size_t)5 * TT * 1024), gtid, gthreads); }
        cg::this_grid().sync();

        }
        if (KIND == 1 && stg == L) {
        {
            LAS int* qslot = (LAS int*)(lds + 131072);
            for (;;) {
                PH_BEGIN
                __syncthreads();
                if (tid == 0) *qslot = (int)atomicAdd(WSP(unsigned, OFF_CTL) + 64 * L, 1u);
                __syncthreads();
                const int u = *qslot;
                if (u >= 128 + 2048) break;
                bf16_t* Dr = WSP(bf16_t, OFF_D); bf16_t* Y3 = WSP(bf16_t, OFF_PR);
                if (u < 128) scan_unit(Dr, Dr + (size_t)TT * 1024, Dr + (size_t)2 * TT * 1024, Dr + (size_t)3 * TT * 1024, Dr + (size_t)4 * TT * 1024, (const _Float16*)(Dr + (size_t)5 * TT * 1024), WSP(float, OFF_YRAW), u >> 5, (u >> 1) & 15, u & 1, lds);
                else {
                    const int v = u - 128, r = v >> 5, k = v & 31;
                    if (k < 16) { const float lam_init = 0.8f - 0.6f * expf(-0.3f * (float)L);
                        diff_unit(WSP(bf16_t, OFF_QK), WSP(bf16_t, OFF_VT), INP(11, 256), WSP(float, OFF_MISC)[L], 1.f - lam_init, Y3 + (size_t)TT * 1024, k >> 2, k & 3, 63 - r, lds); }
                    else { const int k2 = k - 16; nsa_unit(WSP(bf16_t, OFF_QK), WSP(bf16_t, OFF_VT), WSP(bf16_t, OFF_KC), WSP(bf16_t, OFF_VCT), WSP(float, OFF_G), Y3, (k2 & 7) >> 1, k2 & 1, 127 - 2 * r - (k2 >> 3), lds); }
                }
            }
        }

        }
        if (KIND == 0 && stg == L + 1) {
        { PH_BEGIN
          const float* w_gate = INP(23, 3 * 2048 * 2048); const float* w_branch = INP(25, 3 * 1024 * 2048);
#pragma unroll 1
          for (int b3 = 0; b3 < 3; ++b3) {
            cvt_transpose(tile, w_gate + (size_t)b3 * 2048 * 2048, 2048, 2048, 2048, WSP(bf16_t, OFF_WG) + (size_t)b3 * 2048 * 2048, [](int n) { return n; }, bid, G);
            cvt_transpose(tile, w_branch + (size_t)b3 * 1024 * 2048, 2048, 1024, 2048, WSP(bf16_t, OFF_WB) + (size_t)b3 * 2048 * 1024, [](int n) { return n; }, bid, G);
          }
          cvt_transpose(tile, INP(26, 2048 * 2048), 2048, 2048, 2048, WSP(bf16_t, OFF_WO), [](int n) { return n; }, bid, G);
          cvt_transpose(tile, INP(27, 2048 * 8192), 8192, 2048, 8192, WSP(bf16_t, OFF_WUP), [](int n) { return n; }, bid, G);
          cvt_transpose(tile, INP(28, 8192 * 2048), 2048, 8192, 2048, WSP(bf16_t, OFF_WDN), [](int n) { return n; }, bid, G);
          rwkv_final(WSP(float, OFF_YRAW), WSP(bf16_t, OFF_D) + (size_t)2 * TT * 1024, WSP(float, OFF_BON), INP(21, 1024), INP(22, 1024), WSP(bf16_t, OFF_PR) + (size_t)2 * TT * 1024, gtid, gthreads); }
        cg::this_grid().sync();

        { PH_BEGIN
          ListOrder S{1536, G, bid, 3}; EpiBf<0> E{WSP(bf16_t, OFF_Z), 2048, 64, 8, (size_t)TT * 2048};
          pg8::gemm_phase<EpiBf<0>, ListOrder>(lds, Gemm{WSP(bf16_t, OFF_PR), WSP(bf16_t, OFF_WB), 3 * TT, 6144, 1024}, S, E, nullptr); }
        cg::this_grid().sync();
        { PH_BEGIN
          ListOrder S{0, G, bid, 2}; EpiMerge E{WSP(bf16_t, OFF_Z), INP(24, 3 * 2048), WSP(float, OFF_SCR), WSP(bf16_t, OFF_MRG)};
          pg8::gemm_phase<EpiMerge, ListOrder>(lds, Gemm{WSP(bf16_t, OFF_U), WSP(bf16_t, OFF_WG), TT, 6144, 2048}, S, E, nullptr); }
        cg::this_grid().sync();
        { PH_BEGIN
          pg8::StaticOrder S; S.init(TT, 2048, G, bid); EpiF32 E{WSP(float, OFF_T1A), 2048};
          pg8::gemm_phase<EpiF32, pg8::StaticOrder>(lds, Gemm{WSP(bf16_t, OFF_MRG), WSP(bf16_t, OFF_WO), TT, 2048, 2048}, S, E, nullptr); }
        cg::this_grid().sync();
        { PH_BEGIN
          row_pass(L == 0 ? (const float*)PP->in[0] : PP->out, WSP(float, OFF_T1A), INP(3, 2048), PP->out, INP(4, 2048), WSP(bf16_t, OFF_U), bid, G); }
        cg::this_grid().sync();
        { PH_BEGIN
          pg8::StaticOrder S; S.init(TT, DFF, G, bid); EpiBf<2> E{WSP(bf16_t, OFF_HID), DFF, 0, 0, 0};
          pg8::gemm_phase<EpiBf<2>, pg8::StaticOrder>(lds, Gemm{WSP(bf16_t, OFF_U), WSP(bf16_t, OFF_WUP), TT, DFF, 2048}, S, E, nullptr); }
        cg::this_grid().sync();
        { PH_BEGIN
          pg8::StaticOrder S; S.init(TT, 2048, G, bid); EpiF32 E{WSP(float, OFF_T1B), 2048};
          pg8::gemm_phase<EpiF32, pg8::StaticOrder>(lds, Gemm{WSP(bf16_t, OFF_HID), WSP(bf16_t, OFF_WDN), TT, 2048, DFF}, S, E, nullptr); }
        cg::this_grid().sync();
        { PH_BEGIN
          row_pass(PP->out, WSP(float, OFF_T1B), INP(5, 2048), PP->out, (const float*)PP->in[2] + 2048, (L == 0) ? WSP(bf16_t, OFF_U) : (bf16_t*)nullptr, bid, G); }
        cg::this_grid().sync();
        }
    }
}

extern "C" void kernel_launch(void* const* d_in, const int* in_sizes, int n_in, void* d_out, int out_size, void* d_ws, size_t ws_size, hipStream_t stream) {
    static int grid_blocks = 0;
    if (!grid_blocks) {
        int dev = 0, cus = 0, pa = 0, pb = 0;
        (void)hipGetDevice(&dev);
        (void)hipDeviceGetAttribute(&cus, hipDeviceAttributeMultiprocessorCount, dev);
        (void)hipFuncSetAttribute((const void*)fwd_megakernel<0>, hipFuncAttributeMaxDynamicSharedMemorySize, LDS_BYTES);
        (void)hipFuncSetAttribute((const void*)fwd_megakernel<1>, hipFuncAttributeMaxDynamicSharedMemorySize, LDS_BYTES);
        (void)hipOccupancyMaxActiveBlocksPerMultiprocessor(&pa, (const void*)fwd_megakernel<0>, 512, LDS_BYTES);
        (void)hipOccupancyMaxActiveBlocksPerMultiprocessor(&pb, (const void*)fwd_megakernel<1>, 512, LDS_BYTES);
        int per_cu = pa < pb ? pa : pb; if (per_cu < 1) per_cu = 1;
        grid_blocks = cus * per_cu;
        if (ws_size < WS_END) fprintf(stderr, "kernel_launch: workspace too small: %zu < %zu\n", ws_size, (size_t)WS_END);
    }
    (void)hipMemsetAsync((char*)d_ws + OFF_CTL, 0, 4096, stream);
    const int kinds[5] = {0, 1, 0, 1, 0}, stages[5] = {0, 0, 1, 1, 2};
    for (int i = 0; i < 5; ++i) {
        Params p{};
        for (int k = 0; k < NIN; ++k) p.in[k] = d_in[k];
        p.out = (float*)d_out; p.ws = (unsigned char*)d_ws; p.stage = stages[i]; p.pad = 0;
        void* args[] = {&p};
        hipError_t e = hipLaunchCooperativeKernel(kinds[i] == 0 ? (const void*)fwd_megakernel<0> : (const void*)fwd_megakernel<1>, dim3(grid_blocks), dim3(512), args, LDS_BYTES, stream);
        if (e != hipSuccess) fprintf(stderr, "cooperative launch %d failed: %s (grid %d)\n", i, hipGetErrorString(e), grid_blocks);
    }
}
```

```cpp
#include <hip/hip_runtime.h>
#include <hip/hip_cooperative_groups.h>
#include <cstdio>
#include <cstdint>
namespace cg = cooperative_groups;
#define DI __device__ __forceinline__
#define LAS __attribute__((address_space(3)))
#define GAS __attribute__((address_space(1)))
namespace pg8 {
#define PG8_LAS __attribute__((address_space(3)))
typedef unsigned short bf16_t;
typedef short bf16x8 __attribute__((ext_vector_type(8)));
typedef float f32x4 __attribute__((ext_vector_type(4)));
typedef unsigned u32x4 __attribute__((ext_vector_type(4)));
constexpr int BM = 256, BK = 64, HALF = 128, HTB = HALF * BK * 2  , STAGE_BYTES = 8 * HTB, NXCD = 8, WGM = 8;

__host__ __device__ __forceinline__ int lds_byte(int r, int c) { const int st = (r >> 4) * 2 + (c >> 5), rr = r & 15, cc = c & 31, ob = rr * 64 + cc * 2; return st * 1024 + (ob ^ (((ob >> 9) & 1) << 5)); }
__host__ __device__ __forceinline__ void stage_rc(int b, int& R, int& C) { const int st = b / 1024, sb = b % 1024, swz = sb ^ (((sb >> 9) & 1) << 5); R = (st >> 1) * 16 + swz / 64; C = (st & 1) * 32 + (swz % 64) / 2; }
__host__ __device__ __forceinline__ int perm32(int rho) { const int n = rho >> 4, i = rho & 15; return 8 * (i >> 2) + 4 * n + (i & 3); }

struct Unit { int pm, pn; };
struct Gemm { const bf16_t* A; const bf16_t* Bt; int M, N, K; };

struct StaticOrder {
    int nM, nN, nwg, G, c;
    __host__ __device__ void init(int M, int N, int G_, int c_) { nM = M / BM; nN = N / BM; nwg = nM * nN; G = G_; c = c_; }
    __host__ __device__ bool next(int i, Unit& u) const {
        const long L = (long)i * G + c; if (L >= nwg) return false;
        int wgid = (int)L; { const int q = nwg / NXCD, r = nwg % NXCD, xcd = wgid % NXCD, off = wgid / NXCD; wgid = (xcd < r ? xcd * (q + 1) : r * (q + 1) + (xcd - r) * q) + off; }
        const int nig = WGM * nN, gid = wgid / nig, fm = gid * WGM, gsz = (nM - fm) < WGM ? (nM - fm) : WGM;
        u.pm = fm + ((wgid % nig) % gsz); u.pn = (wgid % nig) / gsz; return true;
    }
    __device__ __forceinline__ void a_ready(const Unit&) const {}
    __device__ __forceinline__ void done(const Unit&) const {}
};
template <class Epi, class Sched, bool STAMP = false>
__device__ __forceinline__ void gemm_phase(PG8_LAS unsigned char* lds, const Gemm g, const Sched& S, const Epi& E, unsigned long long* stamps) {
    int tid_l = threadIdx.x; asm volatile("" : "+v"(tid_l)); const int tid = tid_l, wid = __builtin_amdgcn_readfirstlane(tid >> 6), lane = tid & 63, wr = wid >> 2, wc = wid & 3, fr = lane & 15, fq = lane >> 4;
    const int K = g.K, nt = K / BK;
    int ts_lo = 0, ts_hi = 0, nts = 0; const unsigned long long rt_entry = STAMP ? (unsigned long long)wall_clock64() : 0ull;
#define PG8_STAMP() do { if (STAMP && wid == 0 && nts < 64) { const unsigned long long _c = (unsigned long long)clock64(); \
        ts_lo = (lane == nts) ? (int)(unsigned)_c : ts_lo; ts_hi = (lane == nts) ? (int)(unsigned)(_c >> 32) : ts_hi; ++nts; } } while (0)
    PG8_STAMP();
    unsigned voffA[2], voffB[2];
#pragma unroll
    for (int i = 0; i < 2; ++i) { int R, C; stage_rc(tid * 16 + i * 8192, R, C); const int Rb = Epi::PERM ? ((R & ~31) + perm32(R & 31)) : R;
        voffA[i] = (unsigned)(R * K + C) * 2u; voffB[i] = (unsigned)(Rb * K + C) * 2u; }
    const size_t kstep = (size_t)(BK * 2);
    const size_t hstep = (size_t)HALF * K * 2;
    const size_t tstep = 2 * hstep;
    const unsigned ldsw = (unsigned)wid * 1024u;
    const int aoff = lds_byte(wr * 64 + fr, fq * 8), boff = lds_byte(wc * 32 + fr, fq * 8);
#define PG8_SA(b, h) (((b) * 2 + (h)) * HTB)
#define PG8_SB(b, h) ((4 + (b) * 2 + (h)) * HTB)
#define PG8_STAGE(bufoff, gbase, voff) do { _Pragma("unroll") for (int _i = 0; _i < 2; ++_i) \
        __builtin_amdgcn_global_load_lds((const unsigned*)((const char*)(gbase) + (voff)[_i]), (PG8_LAS unsigned*)(lds + (bufoff) + ldsw + _i * 8192), 16, 0, 0); } while (0)
#define PG8_LDA(dst, b, h) do { _Pragma("unroll") for (int m = 0; m < 4; ++m) _Pragma("unroll") for (int k = 0; k < 2; ++k) dst[m][k] = *(const PG8_LAS bf16x8*)(lds + PG8_SA(b, h) + aoff + m * 2048 + k * 1024); } while (0)
#define PG8_LDB(dst, b, h) do { _Pragma("unroll") for (int n = 0; n < 2; ++n) _Pragma("unroll") for (int k = 0; k < 2; ++k) dst[n][k] = *(const PG8_LAS bf16x8*)(lds + PG8_SB(b, h) + boff + n * 2048 + k * 1024); } while (0)
#define PG8_MMA(ai, bj, At, Bt) do { __builtin_amdgcn_s_setprio(1); _Pragma("unroll") for (int m = 0; m < 4; ++m) _Pragma("unroll") for (int n = 0; n < 2; ++n) _Pragma("unroll") for (int k = 0; k < 2; ++k) \
        acc[ai][bj][m][n] = __builtin_amdgcn_mfma_f32_16x16x32_bf16(Bt[n][k], At[m][k], acc[ai][bj][m][n], 0, 0, 0); __builtin_amdgcn_s_setprio(0); } while (0)
#define PG8_WAIT_V(n) asm volatile("s_waitcnt vmcnt(" #n ")" ::: "memory")
#define PG8_WAIT_L(n) asm volatile("s_waitcnt lgkmcnt(" #n ")" ::: "memory")
#define PG8_BAR __builtin_amdgcn_s_barrier()
#define PG8_SCHED __builtin_amdgcn_sched_barrier(0)
    Unit cur, nxt; int ui = 0;
    if (!S.next(0, cur)) return;
    f32x4 acc[2][2][4][2];
#pragma unroll
    for (int a = 0; a < 2; ++a)
#pragma unroll
        for (int b = 0; b < 2; ++b)
#pragma unroll
            for (int m = 0; m < 4; ++m)
#pragma unroll
                for (int n = 0; n < 2; ++n) acc[a][b][m][n] = (f32x4){0.f, 0.f, 0.f, 0.f};
    bf16x8 At[4][2], B0[2][2], B1[2][2];
    const char* cA = (const char*)g.A + (size_t)cur.pm * tstep; const char* cB = (const char*)g.Bt + (size_t)cur.pn * tstep;
    S.a_ready(cur);
    PG8_STAGE(PG8_SB(0, 0), cB, voffB); PG8_STAGE(PG8_SA(0, 0), cA, voffA); PG8_STAGE(PG8_SB(0, 1), cB + hstep, voffB); PG8_STAGE(PG8_SA(0, 1), cA + hstep, voffA);
    if (wr == 1) PG8_BAR;
    PG8_WAIT_V(4); PG8_BAR;
    PG8_STAGE(PG8_SB(1, 0), cB + kstep, voffB); PG8_STAGE(PG8_SA(1, 0), cA + kstep, voffA); PG8_STAGE(PG8_SB(1, 1), cB + hstep + kstep, voffB);
    PG8_WAIT_V(6); PG8_BAR;
    PG8_STAMP();
    for (;;) {
        const bool has_next = S.next(ui + 1, nxt);
        const char* nA = has_next ? (const char*)g.A + (size_t)nxt.pm * tstep : cA; const char* nB = has_next ? (const char*)g.Bt + (size_t)nxt.pn * tstep : cB;
        for (int t = 0; t < nt; t += 2) {
            const bool last = (t == nt - 2);
            const char* a1 = cA + (size_t)(t + 1) * kstep;
            const char* a2 = last ? nA : cA + (size_t)(t + 2) * kstep; const char* b2 = last ? nB : cB + (size_t)(t + 2) * kstep;
            const char* a3 = a2 + kstep; const char* b3 = b2 + kstep;
            if (last && has_next) S.a_ready(nxt);
            PG8_LDB(B0, 0, 0); PG8_SCHED; PG8_LDA(At, 0, 0); PG8_STAGE(PG8_SA(1, 1), a1 + hstep, voffA);
            PG8_WAIT_L(8); PG8_BAR; PG8_WAIT_L(0); PG8_MMA(0, 0, At, B0); PG8_BAR; PG8_SCHED;
            PG8_LDB(B1, 0, 1); PG8_STAGE(PG8_SB(0, 0), b2, voffB);
            PG8_BAR; PG8_WAIT_L(0); PG8_MMA(0, 1, At, B1); PG8_BAR;
            PG8_LDA(At, 0, 1); PG8_STAGE(PG8_SA(0, 0), a2, voffA);
            PG8_BAR; PG8_WAIT_L(0); PG8_MMA(1, 0, At, B0); PG8_BAR; PG8_SCHED;
            PG8_STAGE(PG8_SB(0, 1), b2 + hstep, voffB);
            PG8_WAIT_V(6); PG8_BAR; PG8_MMA(1, 1, At, B1); PG8_BAR;
            PG8_LDB(B0, 1, 0); PG8_SCHED; PG8_LDA(At, 1, 0); PG8_STAGE(PG8_SA(0, 1), a2 + hstep, voffA);
            PG8_WAIT_L(8); PG8_BAR; PG8_WAIT_L(0); PG8_MMA(0, 0, At, B0); PG8_BAR; PG8_SCHED;
            PG8_LDB(B1, 1, 1); PG8_STAGE(PG8_SB(1, 0), b3, voffB);
            PG8_BAR; PG8_WAIT_L(0); PG8_MMA(0, 1, At, B1); PG8_BAR;
            PG8_LDA(At, 1, 1); PG8_STAGE(PG8_SA(1, 0), a3, voffA);
            PG8_BAR; PG8_WAIT_L(0); PG8_MMA(1, 0, At, B0); PG8_BAR; PG8_SCHED;
            PG8_STAGE(PG8_SB(1, 1), b3 + hstep, voffB);
            PG8_WAIT_V(6); PG8_BAR; PG8_MMA(1, 1, At, B1); PG8_BAR;
        }
        PG8_STAMP();
        if constexpr (!Epi::AFTER_DRAIN) { E(acc, cur, wr, wc, fr, fq); S.done(cur); }
        PG8_STAMP();
        if (!has_next) break;
#pragma unroll
        for (int a = 0; a < 2; ++a)
#pragma unroll
            for (int b = 0; b < 2; ++b)
#pragma unroll
                for (int m = 0; m < 4; ++m)
#pragma unroll
                    for (int n = 0; n < 2; ++n) acc[a][b][m][n] = (f32x4){0.f, 0.f, 0.f, 0.f};
        cur = nxt; cA = nA; cB = nB; ++ui;
    }
    PG8_WAIT_V(0);
    if (wr == 0) PG8_BAR;
    PG8_BAR;
    if constexpr (Epi::AFTER_DRAIN) { E.fused(acc, cur, wr, wc, fr, fq, lds, wid, lane); S.done(cur); }
    PG8_STAMP();
    if (STAMP && wid == 0) { stamps[lane] = lane < nts ? (((unsigned long long)(unsigned)ts_hi << 32) | (unsigned)ts_lo) : 0ull;
        if (lane == 62) stamps[62] = rt_entry; if (lane == 63) stamps[63] = (unsigned long long)wall_clock64(); }
#undef PG8_STAMP
#undef PG8_SA
#undef PG8_SB
#undef PG8_STAGE
#undef PG8_LDA
#undef PG8_LDB
#undef PG8_MMA
#undef PG8_WAIT_V
#undef PG8_WAIT_L
#undef PG8_BAR
#undef PG8_SCHED
}
}
using pg8::bf16_t; using pg8::bf16x8; using pg8::f32x4; using pg8::Unit; using pg8::Gemm;
typedef short s16x4 __attribute__((ext_vector_type(4)));
typedef float f32x2 __attribute__((ext_vector_type(2)));

constexpr int NB = 4, SEQ = 4096, TT = NB * SEQ, DM = 2048, DFF = 8192;
constexpr int NWIN = 9216;
constexpr int LDPR = 3360;
constexpr int NIN = 29;
constexpr float SC_LOG2E = 0.08838834764831845f * 1.4426950408889634f;

constexpr size_t al4k(size_t x) { return (x + 4095) & ~(size_t)4095; }
constexpr size_t OFF_CTL  = 0;
constexpr size_t OFF_MISC = 65536;
constexpr size_t OFF_ROPE = 1u << 20;
constexpr size_t OFF_WIN  = OFF_ROPE + (size_t)TT * 16 * 8;
constexpr size_t OFF_W1T  = OFF_WIN + (size_t)NWIN * 2048 * 2;
constexpr size_t OFF_W2T  = OFF_W1T + (size_t)512 * 4096 * 2;
constexpr size_t OFF_LORA = OFF_W2T + (size_t)256 * 256 * 2;
constexpr size_t OFF_U    = al4k(OFF_LORA + (size_t)3072 * 384 * 2);
constexpr size_t OFF_QK   = OFF_U + (size_t)TT * 2048 * 2;
constexpr size_t OFF_VT   = OFF_QK + (size_t)TT * 4096 * 2;
constexpr size_t OFF_G    = OFF_VT + (size_t)NB * 1536 * SEQ * 2;
constexpr size_t OFF_PR   = OFF_G + (size_t)TT * 32 * 4;
constexpr size_t OFF_D    = al4k(OFF_PR + (size_t)TT * LDPR * 2);
constexpr size_t DSZ      = (size_t)TT * 1024 * 2;
constexpr size_t OFF_AL   = OFF_D + 6 * DSZ;
constexpr size_t OFF_BON  = OFF_AL + (size_t)TT * 384 * 2;
constexpr size_t OFF_CMPA = OFF_BON + (size_t)TT * 16 * 4;
constexpr size_t OFF_H    = OFF_CMPA + (size_t)4096 * 4096 * 2;
constexpr size_t OFF_KC   = OFF_H + (size_t)4096 * 256 * 2;
constexpr size_t OFF_VCT  = OFF_KC + (size_t)NB * 2 * 256 * 128 * 2;
constexpr size_t OFF_YRAW = OFF_VCT + (size_t)NB * 2 * 128 * 256 * 2;
constexpr size_t WS_END   = OFF_YRAW + (size_t)TT * 1024 * 4;
constexpr size_t OFF_WG   = OFF_QK;
constexpr size_t OFF_WB   = OFF_WG + (size_t)6144 * 2048 * 2;
constexpr size_t OFF_WO   = OFF_WB + (size_t)6144 * 1024 * 2;
constexpr size_t OFF_WUP  = OFF_WO + (size_t)2048 * 2048 * 2;
constexpr size_t OFF_WDN  = OFF_WUP + (size_t)8192 * 2048 * 2;
static_assert(OFF_WDN + (size_t)2048 * 8192 * 2 <= OFF_VT, "W2 must fit in the QK region");
constexpr size_t OFF_Z    = OFF_D;
constexpr size_t OFF_T1A  = OFF_D;
constexpr size_t OFF_HID  = OFF_D;
static_assert(OFF_HID + (size_t)TT * 8192 * 2 <= WS_END, "h must fit");
constexpr size_t OFF_T1B  = OFF_VT;
static_assert(OFF_T1B + (size_t)TT * 2048 * 4 <= OFF_D, "t1b must fit before D");
constexpr size_t OFF_MRG  = OFF_YRAW;
constexpr size_t OFF_SCR  = OFF_PR;
static_assert(OFF_SCR + (size_t)256 * 256 * 256 * 4 <= OFF_D, "scratch must fit");
constexpr int LDS_CTLW = 156672;
constexpr int LDS_BYTES = LDS_CTLW + 1024;

struct Params { const void* in[NIN]; float* out; unsigned char* ws; int stage; int pad; };

DI bf16_t f2bf(float f) { unsigned u = __float_as_uint(f); u += 0x7fffu + ((u >> 16) & 1u); return (bf16_t)(u >> 16); }
DI float bf2f(bf16_t b) { return __uint_as_float(((unsigned)b) << 16); }
typedef __bf16 bf16v2 __attribute__((ext_vector_type(2)));
DI unsigned pack2(float lo, float hi) { const f32x2 v = {lo, hi}; return __builtin_bit_cast(unsigned, __builtin_convertvector(v, bf16v2)); }
DI float sigmoidf_(float x) { return __builtin_amdgcn_rcpf(1.f + __expf(-x)); }
DI float wave_sum(float v) {
#pragma unroll
    for (int o = 32; o > 0; o >>= 1) v += __shfl_xor(v, o);
    return v;
}
DI void unpack8(const uint4& u, float (&f)[8]) {
    f[0] = __uint_as_float(u.x << 16); f[1] = __uint_as_float(u.x & 0xffff0000u);
    f[2] = __uint_as_float(u.y << 16); f[3] = __uint_as_float(u.y & 0xffff0000u);
    f[4] = __uint_as_float(u.z << 16); f[5] = __uint_as_float(u.z & 0xffff0000u);
    f[6] = __uint_as_float(u.w << 16); f[7] = __uint_as_float(u.w & 0xffff0000u);
}
DI uint4 pack8(const float (&f)[8]) { uint4 u; u.x = pack2(f[0], f[1]); u.y = pack2(f[2], f[3]); u.z = pack2(f[4], f[5]); u.w = pack2(f[6], f[7]); return u; }

struct ListOrder {
    int n, G, c, mode;
    DI bool next(int i, Unit& u) const {
        if (mode == 2) {
            const int j = i / 3, b = i - 3 * j, tile = j * G + c; if (tile >= 512) return false;
            u.pm = tile >> 3; u.pn = b * 8 + (tile & 7); return true;
        }
        const int L = i * G + c; if (L >= n) return false;
        if (mode == 0) { u.pm = L; u.pn = L >> 3; }
        else if (mode == 1) { u.pm = L; u.pn = 0; }
        else { const int b = L >> 9, tile = L & 511; u.pm = b * 64 + (tile >> 3); u.pn = b * 8 + (tile & 7); }
        return true;
    }
    DI void a_ready(const Unit&) const {}
    DI void done(const Unit&) const {}
};
struct EpiWin {
    static constexpr bool PERM = false, AFTER_DRAIN = false;
    bf16_t* QK; bf16_t* VT; float* G; bf16_t* PR; const float2* rope;
    DI void operator()(const f32x4 (&acc)[2][2][4][2], const Unit& u, int wr, int wc, int fr, int fq) const {
        const int pn = u.pn;
        const int row0 = u.pm * 256 + wr * 64 + fr;
        const bool isV = (pn == 7) || (pn == 9) || (pn >= 18 && pn <= 21);
        if (isV) {
            const int vbase = (pn == 7) ? 0 : (pn == 9) ? 256 : 512 + (pn - 18) * 256;
#pragma unroll
            for (int ai = 0; ai < 2; ++ai)
#pragma unroll
                for (int m = 0; m < 4; ++m) {
                    const int row = row0 + ai * 128 + m * 16; const int b = row >> 12, s = row & 4095;
#pragma unroll
                    for (int bj = 0; bj < 2; ++bj)
#pragma unroll
                        for (int n = 0; n < 2; ++n) {
                            const int cu = bj * 128 + wc * 32 + n * 16 + fq * 4;
                            bf16_t* dst = VT + ((size_t)(b * 1536 + vbase + cu) * SEQ + s);
#pragma unroll
                            for (int e = 0; e < 4; ++e) dst[(size_t)e * SEQ] = f2bf(acc[ai][bj][m][n][e]);
                        }
                }
        } else if (pn >= 22) {
#pragma unroll
            for (int ai = 0; ai < 2; ++ai)
#pragma unroll
                for (int m = 0; m < 4; ++m) {
                    const int row = row0 + ai * 128 + m * 16;
#pragma unroll
                    for (int bj = 0; bj < 2; ++bj)
#pragma unroll
                        for (int n = 0; n < 2; ++n) {
                            const int cu = bj * 128 + wc * 32 + n * 16 + fq * 4;
                            const f32x4 v = acc[ai][bj][m][n];
                            if (pn < 35 || cu < 32) {
                                const int col = (pn - 22) * 256 + cu;
                                uint2 o; o.x = pack2(v[0], v[1]); o.y = pack2(v[2], v[3]);
                                *(uint2*)(PR + (size_t)row * LDPR + col) = o;
                            } else if (cu < 56) {
                                *(f32x4*)(G + (size_t)row * 32 + (cu - 32)) = v;
                            }
                        }
                }
        } else {
            const int qoff = (pn <= 6) ? 0 : (pn == 8) ? -256 : -512;
            const bool dorope = (wc == 0) && (pn != 4) && (pn != 5);
#pragma unroll
            for (int ai = 0; ai < 2; ++ai)
#pragma unroll
                for (int m = 0; m < 4; ++m) {
                    const int row = row0 + ai * 128 + m * 16;
#pragma unroll
                    for (int bj = 0; bj < 2; ++bj) {
                        f32x4 v0 = acc[ai][bj][m][0], v1 = acc[ai][bj][m][1];
                        if (dorope) {
                            const float2* rp = rope + (size_t)row * 16 + fq * 4;
#pragma unroll
                            for (int e = 0; e < 4; ++e) { const float2 cs = rp[e]; const float a = v0[e], b2 = v1[e]; v0[e] = a * cs.x - b2 * cs.y; v1[e] = b2 * cs.x + a * cs.y; }
                        }
                        const int col = pn * 256 + qoff + bj * 128 + wc * 32 + fq * 4;
                        uint2 o; o.x = pack2(v0[0], v0[1]); o.y = pack2(v0[2], v0[3]);
                        *(uint2*)(QK + (size_t)row * 4096 + col) = o;
                        o.x = pack2(v1[0], v1[1]); o.y = pack2(v1[2], v1[3]);
                        *(uint2*)(QK + (size_t)row * 4096 + col + 16) = o;
                    }
                }
        }
    }
};

typedef _Float16 f16x4 __attribute__((ext_vector_type(4)));
DI float gelu_tanh(float x) { const float t = 0.7978845608028654f * (x + 0.044715f * x * x * x); const float e = __expf(2.f * t); const float th = 1.f - 2.f / (e + 1.f); return 0.5f * x * (1.f + th); }

template <int ACT  > struct EpiBf {
    static constexpr bool PERM = true, AFTER_DRAIN = false;
    bf16_t* O; int ldc; int pm_mod, pn_mod; size_t grp_stride;
    DI void operator()(const f32x4 (&acc)[2][2][4][2], const Unit& u, int wr, int wc, int fr, int fq) const {
        int pm = u.pm, pn = u.pn; bf16_t* base = O;
        if (pm_mod) { base += (size_t)(pm / pm_mod) * grp_stride; pm %= pm_mod; pn %= pn_mod; }
        const int row0 = pm * 256 + wr * 64 + fr, col0 = pn * 256 + wc * 32 + fq * 8;
#pragma unroll
        for (int ai = 0; ai < 2; ++ai)
#pragma unroll
            for (int m = 0; m < 4; ++m) {
                bf16_t* rowp = base + (size_t)(row0 + ai * 128 + m * 16) * ldc + col0;
#pragma unroll
                for (int bj = 0; bj < 2; ++bj) {
                    float f[8];
#pragma unroll
                    for (int e = 0; e < 4; ++e) { f[e] = acc[ai][bj][m][0][e]; f[4 + e] = acc[ai][bj][m][1][e]; }
#pragma unroll
                    for (int e = 0; e < 8; ++e) { if (ACT == 1) f[e] = gelu_tanh(f[e]); else if (ACT == 2) { const float r = fmaxf(f[e], 0.f); f[e] = r * r; } }
                    *(uint4*)(rowp + bj * 128) = pack8(f);
                }
            }
    }
};

template <int KV> struct EpiCmp2 {
    static constexpr bool PERM = false, AFTER_DRAIN = false;
    bf16_t* KC; bf16_t* VCT; const float2* rope;
    DI void operator()(const f32x4 (&acc)[2][2][4][2], const Unit& u, int wr, int wc, int fr, int fq) const {
        constexpr int kv = KV;
        const int row0 = (u.pm & 7) * 256 + wr * 64 + fr;
        if (kv == 0) {
#pragma unroll
            for (int ai = 0; ai < 2; ++ai)
#pragma unroll
                for (int m = 0; m < 4; ++m) {
                    int rr = row0 + ai * 128 + m * 16; asm volatile("" : "+v"(rr)); __builtin_amdgcn_sched_barrier(0); const int b = rr >> 9, c = (rr & 511) >> 1, g = rr & 1;
                    f32x4 v0 = acc[ai][0][m][0], v1 = acc[ai][0][m][1];
                    if (wc == 0) {
                        const int tok = b * SEQ + (c < 255 ? 16 * c + 31 : 0);
                        const float2* rp = rope + (size_t)tok * 16 + fq * 4;
#pragma unroll
                        for (int e = 0; e < 4; ++e) { const float2 cs = rp[e]; const float a = v0[e], b2 = v1[e]; v0[e] = a * cs.x - b2 * cs.y; v1[e] = b2 * cs.x + a * cs.y; }
                    }
                    bf16_t* dst = KC + ((size_t)((b * 2 + g) * 256 + c) * 128 + wc * 32 + fq * 4);
                    uint2 o; o.x = pack2(v0[0], v0[1]); o.y = pack2(v0[2], v0[3]); *(uint2*)dst = o;
                    o.x = pack2(v1[0], v1[1]); o.y = pack2(v1[2], v1[3]); *(uint2*)(dst + 16) = o;
                }
        } else {
#pragma unroll
            for (int ai = 0; ai < 2; ++ai)
#pragma unroll
                for (int m = 0; m < 4; ++m) {
                    int rr = row0 + ai * 128 + m * 16; asm volatile("" : "+v"(rr)); __builtin_amdgcn_sched_barrier(0); const int b = rr >> 9, c = (rr & 511) >> 1, g = rr & 1;
                    bf16_t* dst = VCT + (size_t)((b * 2 + g) * 128 + wc * 32 + fq * 4) * 256 + c;
#pragma unroll
                    for (int n = 0; n < 2; ++n)
#pragma unroll
                        for (int e = 0; e < 4; ++e) dst[(n * 16 + e) * 256] = f2bf(acc[ai][1][m][n][e]);
                }
        }
    }
};

struct EpiMerge {
    static constexpr bool PERM = true, AFTER_DRAIN = false;
    const bf16_t* Z; const float* bias; float* scr; bf16_t* M;
    template <int MODE> DI void run(const f32x4 (&acc)[2][2][4][2], const bf16_t* zp, const float* bp, float* sp, bf16_t* mp) const {
        GAS float* s = (GAS float*)sp;
#pragma unroll
        for (int bj = 0; bj < 2; ++bj)
#pragma unroll
            for (int n = 0; n < 2; ++n) {
                const f32x4 bv = *(const f32x4*)(bp + bj * 128 + n * 4);
                GAS const bf16_t* zr = (GAS const bf16_t*)(zp + bj * 128 + n * 4); GAS bf16_t* mr = (GAS bf16_t*)(mp + bj * 128 + n * 4);
#pragma unroll
                for (int ai = 0; ai < 2; ++ai)
#pragma unroll
                    for (int m = 0; m < 4; ++m) {
                        asm volatile("" : "+v"(zr), "+v"(mr), "+v"(s));
                        typedef unsigned u32x2 __attribute__((ext_vector_type(2)));
                        const u32x2 zz = *(GAS const u32x2*)zr;
                        f32x4 v;
                        v[0] = sigmoidf_(acc[ai][bj][m][n][0] + bv[0]) * __uint_as_float(zz.x << 16);
                        v[1] = sigmoidf_(acc[ai][bj][m][n][1] + bv[1]) * __uint_as_float(zz.x & 0xffff0000u);
                        v[2] = sigmoidf_(acc[ai][bj][m][n][2] + bv[2]) * __uint_as_float(zz.y << 16);
                        v[3] = sigmoidf_(acc[ai][bj][m][n][3] + bv[3]) * __uint_as_float(zz.y & 0xffff0000u);
                        if (MODE > 0) v += *(GAS const f32x4*)s;
                        if (MODE < 2) *(GAS f32x4*)s = v;
                        else { u32x2 o; o.x = pack2(v[0], v[1]); o.y = pack2(v[2], v[3]); *(GAS u32x2*)mr = o; }
                        s += 2048;
                        const size_t step = (m == 3) ? (size_t)80 * 2048 : (size_t)16 * 2048;
                        zr += step; mr += step;
                    }
            }
    }
    DI void operator()(const f32x4 (&acc)[2][2][4][2], const Unit& u, int wr, int wc, int fr, int fq) const {
        const int b = u.pn >> 3, pn = u.pn & 7;
        const int row0 = u.pm * 256 + wr * 64 + fr, col0 = pn * 256 + wc * 32 + fq * 8;
        float* sp = scr + (size_t)blockIdx.x * 65536 + threadIdx.x * 4;
        const bf16_t* zp = Z + ((size_t)b * TT + row0) * 2048 + col0;
        bf16_t* mp = M + (size_t)row0 * 2048 + col0;
        const float* bp = bias + b * 2048 + col0;
        if (b == 0) run<0>(acc, zp, bp, sp, mp); else if (b == 1) run<1>(acc, zp, bp, sp, mp); else run<2>(acc, zp, bp, sp, mp);
    }
};
struct EpiF32 {
    static constexpr bool PERM = false, AFTER_DRAIN = false;
    float* C; int ldc;
    DI void operator()(const f32x4 (&acc)[2][2][4][2], const Unit& u, int wr, int wc, int fr, int fq) const {
        const int row0 = u.pm * 256 + wr * 64 + fr, col0 = u.pn * 256 + wc * 32 + 4 * fq;
#pragma unroll
        for (int ai = 0; ai < 2; ++ai)
#pragma unroll
            for (int m = 0; m < 4; ++m) { float* rowp = C + (size_t)(row0 + ai * 128 + m * 16) * ldc + col0;
#pragma unroll
                for (int bj = 0; bj < 2; ++bj)
#pragma unroll
                    for (int n = 0; n < 2; ++n) *(f32x4*)(rowp + bj * 128 + n * 16) = acc[ai][bj][m][n]; }
    }
};

template <class CM> DI void cvt_transpose(float* tile, const float* src, size_t ld_src, int K, int Ndst, bf16_t* dst, CM cm, int bid, int nblk) {
    int tid_l = threadIdx.x; asm volatile("" : "+v"(tid_l)); const int tid = tid_l, nkt = K >> 6, ntile = nkt * (Ndst >> 6);
    const int j = tid & 63, kb = tid >> 6;
    float cur[8];
    auto ld = [&](int t) { const int k0 = (t % nkt) << 6, n0 = (t / nkt) << 6; const int sc = cm(n0 + j);
#pragma unroll
        for (int i = 0; i < 8; ++i) cur[i] = (sc >= 0) ? src[(size_t)(k0 + kb + 8 * i) * ld_src + sc] : 0.f; };
    int t = bid;
    if (t < ntile) ld(t);
    for (; t < ntile; t += nblk) {
        const int k0 = (t % nkt) << 6, n0 = (t / nkt) << 6;
        __syncthreads();
#pragma unroll
        for (int i = 0; i < 8; ++i) tile[(kb + 8 * i) * 65 + j] = cur[i];
        __syncthreads();
        if (t + nblk < ntile) ld(t + nblk);
        { const int kk = (tid & 7) * 8, nb = tid >> 3;
          float v[8];
#pragma unroll
          for (int i = 0; i < 8; ++i) v[i] = tile[(kk + i) * 65 + nb];
          *(uint4*)(dst + (size_t)(n0 + nb) * K + k0 + kk) = pack8(v); }
    }
}

DI void row_pass(const float* xin, const bf16_t* t1, const float* g1, float* xout, const float* g2, bf16_t* nout, int bid, int nblk) {
    int tid_l = threadIdx.x; asm volatile("" : "+v"(tid_l)); const int lane = tid_l & 63, w = tid_l >> 6;
    for (int row = bid * 8 + w; row < TT; row += nblk * 8) {
        f32x4 xv[8], tv[8]; float ss = 0.f;
#pragma unroll
        for (int i = 0; i < 8; ++i) { { const uint2 tb = *(const uint2*)(t1 + (size_t)row * DM + i * 256 + lane * 4); tv[i] = (f32x4){__uint_as_float(tb.x << 16), __uint_as_float(tb.x & 0xffff0000u), __uint_as_float(tb.y << 16), __uint_as_float(tb.y & 0xffff0000u)}; } xv[i] = *(const f32x4*)(xin + (size_t)row * DM + i * 256 + lane * 4);
            ss += tv[i][0] * tv[i][0] + tv[i][1] * tv[i][1] + tv[i][2] * tv[i][2] + tv[i][3] * tv[i][3]; }
        ss = wave_sum(ss); const float rs = rsqrtf(ss * (1.f / DM) + 1e-6f);
        float s2 = 0.f;
#pragma unroll
        for (int i = 0; i < 8; ++i) { const f32x4 gg = *(const f32x4*)(g1 + i * 256 + lane * 4); xv[i] += tv[i] * rs * gg; *(f32x4*)(xout + (size_t)row * DM + i * 256 + lane * 4) = xv[i];
            s2 += xv[i][0] * xv[i][0] + xv[i][1] * xv[i][1] + xv[i][2] * xv[i][2] + xv[i][3] * xv[i][3]; }
        if (nout) {
            s2 = wave_sum(s2); const float r2 = rsqrtf(s2 * (1.f / DM) + 1e-6f);
#pragma unroll
            for (int i = 0; i < 8; ++i) { const f32x4 gg = *(const f32x4*)(g2 + i * 256 + lane * 4); const f32x4 v = xv[i] * r2 * gg; uint2 o; o.x = pack2(v[0], v[1]); o.y = pack2(v[2], v[3]);
                *(uint2*)(nout + (size_t)row * DM + i * 256 + lane * 4) = o; }
        }
    }
}
DI void norm_pass(const float* xin, const float* g, bf16_t* nout, int bid, int nblk) {
    int tid_l = threadIdx.x; asm volatile("" : "+v"(tid_l)); const int lane = tid_l & 63, w = tid_l >> 6;
    for (int row = bid * 8 + w; row < TT; row += nblk * 8) {
        f32x4 xv[8]; float ss = 0.f;
#pragma unroll
        for (int i = 0; i < 8; ++i) { xv[i] = *(const f32x4*)(xin + (size_t)row * DM + i * 256 + lane * 4); ss += xv[i][0] * xv[i][0] + xv[i][1] * xv[i][1] + xv[i][2] * xv[i][2] + xv[i][3] * xv[i][3]; }
        ss = wave_sum(ss); const float rs = rsqrtf(ss * (1.f / DM) + 1e-6f);
#pragma unroll
        for (int i = 0; i < 8; ++i) { const f32x4 gg = *(const f32x4*)(g + i * 256 + lane * 4); const f32x4 v = xv[i] * rs * gg; uint2 o; o.x = pack2(v[0], v[1]); o.y = pack2(v[2], v[3]);
            *(uint2*)(nout + (size_t)row * DM + i * 256 + lane * 4) = o; }
    }
}

DI void rwkv_shift(const bf16_t* PR, const float* mu, bf16_t* Dr, bf16_t* Dk, bf16_t* Dv, bf16_t* AL, int gtid, int gthreads) {
    const int NCH = 432;
    for (size_t idx = gtid; idx < (size_t)TT * NCH; idx += gthreads) {
        const int tok = (int)(idx / NCH), ch = (int)(idx % NCH);
        if (ch >= 420) { *(uint4*)(AL + (size_t)tok * 384 + 288 + (ch - 420) * 8) = make_uint4(0, 0, 0, 0); continue; }
        const int j = ch * 8;
        float p[8], q[8], v[8];
        unpack8(*(const uint4*)(PR + (size_t)tok * LDPR + j), p);
        if ((tok & (SEQ - 1)) != 0) unpack8(*(const uint4*)(PR + (size_t)(tok - 1) * LDPR + j), q);
        else {
#pragma unroll
            for (int e = 0; e < 8; ++e) q[e] = 0.f; }
        const f32x4 m0 = *(const f32x4*)(mu + j), m1 = *(const f32x4*)(mu + j + 4);
#pragma unroll
        for (int e = 0; e < 8; ++e) v[e] = p[e] + (q[e] - p[e]) * (e < 4 ? m0[e] : m1[e - 4]);
        bf16_t* dst;
        if (j < 1024) dst = Dr + (size_t)tok * 1024 + j;
        else if (j < 2048) dst = Dk + (size_t)tok * 1024 + (j - 1024);
        else if (j < 3072) dst = Dv + (size_t)tok * 1024 + (j - 2048);
        else {
            dst = AL + (size_t)tok * 384 + (j - 3072);
            if (j < 3136) {
#pragma unroll
                for (int e = 0; e < 8; ++e) { const float ex = __expf(2.f * v[e]); v[e] = 1.f - 2.f / (ex + 1.f); } }
            else if (j >= 3200) {
#pragma unroll
                for (int e = 0; e < 8; ++e) v[e] = sigmoidf_(v[e]); }
        }
        *(uint4*)dst = pack8(v);
    }
}

DI void build_cmpa(const bf16_t* QK, const float* pe, bf16_t* CMPA, int gtid, int gthreads) {
    for (size_t idx = gtid; idx < (size_t)4096 * 512; idx += gthreads) {
        const int R = (int)(idx >> 9), ch = (int)(idx & 511);
        const int kv = R >> 11, rr = R & 2047, b = rr >> 9, c = (rr & 511) >> 1, g = rr & 1;
        const int i = ch >> 4, d = (ch & 15) * 8;
        uint4 o = make_uint4(0, 0, 0, 0);
        if (c < 255) {
            float v[8]; unpack8(*(const uint4*)(QK + (size_t)(b * SEQ + 16 * c + i) * 4096 + 1024 + kv * 256 + g * 128 + d), v);
            const float* pp = pe + (size_t)kv * 4096 + i * 128 + d;
            const f32x4 p0 = *(const f32x4*)pp, p1 = *(const f32x4*)(pp + 4);
#pragma unroll
            for (int e = 0; e < 4; ++e) { v[e] += p0[e]; v[4 + e] += p1[e]; }
            o = pack8(v);
        }
        *(uint4*)(CMPA + (size_t)R * 4096 + ch * 8) = o;
    }
}

DI void rwkv_prep(const bf16_t* Dr, bf16_t* Dk, bf16_t* Dkk, bf16_t* Dka, const float* k_k, const float* k_a, const float* r_k, float* BON, const float* WRAW, const float* w0, const float* a0, _Float16* Dw, int gtid, int gthreads) {
    for (size_t idx = gtid; idx < (size_t)TT * 128; idx += gthreads) {
        const size_t off = idx * 8; const int col = (int)(off & 1023);
        float k[8], a[8], r[8], kk[8], kp[8], ka[8];
        unpack8(*(const uint4*)(Dk + off), k); unpack8(*(const uint4*)(Dka + off), a); unpack8(*(const uint4*)(Dr + off), r);
        { f16x4 h0, h1; const f32x4 wr0 = *(const f32x4*)(WRAW + off), wr1 = *(const f32x4*)(WRAW + off + 4);
#pragma unroll
          for (int e = 0; e < 4; ++e) { h0[e] = (_Float16)(__expf(-0.6065306597126334f * sigmoidf_(wr0[e] + w0[col + e])) - 1.0f); h1[e] = (_Float16)(__expf(-0.6065306597126334f * sigmoidf_(wr1[e] + w0[col + 4 + e])) - 1.0f); }
          *(f16x4*)(Dw + off) = h0; *(f16x4*)(Dw + off + 4) = h1; }
#pragma unroll
        for (int e = 0; e < 8; ++e) a[e] = sigmoidf_(a[e] + a0[col + e]);
        float ss = 0.f, bs = 0.f;
#pragma unroll
        for (int e = 0; e < 8; ++e) { kk[e] = k[e] * k_k[col + e]; ss += kk[e] * kk[e]; kp[e] = k[e] * (1.f + (a[e] - 1.f) * k_a[col + e]); bs += r[e] * kp[e] * r_k[col + e]; }
        ss += __shfl_xor(ss, 1); ss += __shfl_xor(ss, 2); ss += __shfl_xor(ss, 4);
        bs += __shfl_xor(bs, 1); bs += __shfl_xor(bs, 2); bs += __shfl_xor(bs, 4);
        const float inv = 1.f / fmaxf(sqrtf(ss), 1e-12f);
#pragma unroll
        for (int e = 0; e < 8; ++e) { kk[e] *= inv; ka[e] = kk[e] * a[e]; }
        *(uint4*)(Dk + off) = pack8(kp); *(uint4*)(Dkk + off) = pack8(kk); *(uint4*)(Dka + off) = pack8(ka);
        if ((idx & 7) == 0) BON[idx >> 3] = bs;
    }
}

DI void rwkv_final(const float* YRAW, const bf16_t* Dv, const float* BON, const float* lw, const float* lb, bf16_t* Y3R, int gtid, int gthreads) {
    for (size_t idx = gtid; idx < (size_t)TT * 128; idx += gthreads) {
        const size_t off = idx * 8; const int col = (int)(off & 1023);
        const f32x4 y0 = *(const f32x4*)(YRAW + off), y1 = *(const f32x4*)(YRAW + off + 4);
        float y[8] = {y0[0], y0[1], y0[2], y0[3], y1[0], y1[1], y1[2], y1[3]};
        float s = 0.f;
#pragma unroll
        for (int e = 0; e < 8; ++e) s += y[e];
        s += __shfl_xor(s, 1); s += __shfl_xor(s, 2); s += __shfl_xor(s, 4);
        const float mean = s * (1.f / 64.f);
        float vs = 0.f;
#pragma unroll
        for (int e = 0; e < 8; ++e) { y[e] -= mean; vs += y[e] * y[e]; }
        vs += __shfl_xor(vs, 1); vs += __shfl_xor(vs, 2); vs += __shfl_xor(vs, 4);
        const float rs = rsqrtf(vs * (1.f / 64.f) + 64e-5f);
        float v[8], g[8], o[8]; unpack8(*(const uint4*)(Dv + off), v); unpack8(*(const uint4*)(Y3R + off), g);
        const float bon = BON[idx >> 3];
#pragma unroll
        for (int e = 0; e < 8; ++e) o[e] = (y[e] * rs * lw[col + e] + lb[col + e] + bon * v[e]) * g[e];
        *(uint4*)(Y3R + off) = pack8(o);
    }
}

#define MFMA16(a, b, c) __builtin_amdgcn_mfma_f32_16x16x32_bf16((a), (b), (c), 0, 0, 0)
constexpr int KPITCH = 288, VPITCH = 160, KTILE_B = 64 * KPITCH;
constexpr int DSTAGE = 2 * KTILE_B + 256 * VPITCH, NSTAGE = KTILE_B + 128 * VPITCH;

DI void qk_tile(const LAS unsigned char* Kt, const bf16x8 (&qf)[4], f32x4 (&s)[4], int lane) {
    const LAS unsigned char* kp = Kt + (lane & 15) * KPITCH + (lane >> 4) * 16;
    bf16x8 ka[4], kb[4];
#pragma unroll
    for (int ks = 0; ks < 4; ++ks) ka[ks] = *(const LAS bf16x8*)(kp + ks * 64);
#pragma unroll
    for (int sub = 0; sub < 4; ++sub) {
        if (sub < 3) {
#pragma unroll
            for (int ks = 0; ks < 4; ++ks) kb[ks] = *(const LAS bf16x8*)(kp + (sub + 1) * 16 * KPITCH + ks * 64);
        }
        __builtin_amdgcn_sched_barrier(0);
        f32x4 a = {0.f, 0.f, 0.f, 0.f};
#pragma unroll
        for (int ks = 0; ks < 4; ++ks) a = MFMA16(ka[ks], qf[ks], a);
        s[sub] = a;
        __builtin_amdgcn_sched_barrier(0);
        if (sub < 3) {
#pragma unroll
            for (int ks = 0; ks < 4; ++ks) ka[ks] = kb[ks];
        }
    }
}
template <int DVT, bool MASKED, class MaskFn> DI void softmax_pv(const LAS unsigned char* Vt, f32x4 (&s)[4], f32x4 (&o)[DVT], float& m, float& l, MaskFn valid, int lane, bool need_mask = true) {
    const int quad = lane >> 4, dv = lane & 15;
    bf16x8 vpre[4];
    { const LAS unsigned char* vp0 = Vt + dv * VPITCH + quad * 16;
#pragma unroll
      for (int i = 0; i < 4; ++i) vpre[i] = *(const LAS bf16x8*)(vp0 + i * 16 * VPITCH); }
    __builtin_amdgcn_sched_barrier(0);
    if (MASKED && need_mask) {
#pragma unroll
        for (int sub = 0; sub < 4; ++sub)
#pragma unroll
            for (int j = 0; j < 4; ++j) s[sub][j] = valid(sub * 16 + quad * 4 + j) ? s[sub][j] : -INFINITY;
    }
    float mx = fmaxf(fmaxf(s[0][0], s[0][1]), fmaxf(s[0][2], s[0][3]));
#pragma unroll
    for (int sub = 1; sub < 4; ++sub) mx = fmaxf(fmaxf(fmaxf(mx, s[sub][0]), fmaxf(s[sub][1], s[sub][2])), s[sub][3]);
    mx = fmaxf(mx, __shfl_xor(mx, 16)); mx = fmaxf(mx, __shfl_xor(mx, 32));
    const float mn = fmaxf(m, mx * SC_LOG2E);
    if (__any(mn > m)) {
        const float alpha = __builtin_amdgcn_exp2f(m - mn);
        m = mn; l *= alpha;
#pragma unroll
        for (int t = 0; t < DVT; ++t) o[t] *= alpha;
    }
    const float nm = -m;
    float ps = 0.f;
#pragma unroll
    for (int sub = 0; sub < 4; ++sub)
#pragma unroll
        for (int j = 0; j < 4; ++j) { const float p = __builtin_amdgcn_exp2f(__builtin_fmaf(s[sub][j], SC_LOG2E, nm)); s[sub][j] = p; ps += p; }
    l += ps;
#pragma unroll
    for (int k2 = 0; k2 < 2; ++k2) {
        union { unsigned u[4]; bf16x8 v; } pb;
        pb.u[0] = pack2(s[2 * k2][0], s[2 * k2][1]); pb.u[1] = pack2(s[2 * k2][2], s[2 * k2][3]);
        pb.u[2] = pack2(s[2 * k2 + 1][0], s[2 * k2 + 1][1]); pb.u[3] = pack2(s[2 * k2 + 1][2], s[2 * k2 + 1][3]);
        const LAS unsigned char* vp = Vt + dv * VPITCH + (k2 * 32 + quad * 8) * 2;
        bf16x8 va[4], vb[4];
#pragma unroll
        for (int i = 0; i < 4; ++i) va[i] = (k2 == 0) ? vpre[i] : *(const LAS bf16x8*)(vp + i * 16 * VPITCH);
#pragma unroll
        for (int g = 0; g < DVT / 4; ++g) {
            if (g + 1 < DVT / 4) {
#pragma unroll
                for (int i = 0; i < 4; ++i) vb[i] = *(const LAS bf16x8*)(vp + ((g + 1) * 4 + i) * 16 * VPITCH);
            }
            __builtin_amdgcn_sched_barrier(0);
#pragma unroll
            for (int i = 0; i < 4; ++i) o[g * 4 + i] = MFMA16(va[i], pb.v, o[g * 4 + i]);
            __builtin_amdgcn_sched_barrier(0);
            if (g + 1 < DVT / 4) {
#pragma unroll
                for (int i = 0; i < 4; ++i) va[i] = vb[i];
            }
        }
    }
}
DI void ldk(uint4 (&r)[2], const bf16_t* src, size_t ld, int tid) {
#pragma unroll
    for (int i = 0; i < 2; ++i) { const int c = tid + 512 * i; r[i] = *(const uint4*)(src + (size_t)(c >> 4) * ld + (c & 15) * 8); }
}
DI void stk(LAS unsigned char* Kt, const uint4 (&r)[2], int tid) {
#pragma unroll
    for (int i = 0; i < 2; ++i) { const int c = tid + 512 * i; *(LAS pg8::u32x4*)(Kt + (c >> 4) * KPITCH + (c & 15) * 16) = (pg8::u32x4){r[i].x, r[i].y, r[i].z, r[i].w}; }
}
template <int NCH> DI void ldv(uint4 (&r)[NCH], const bf16_t* src, size_t ld, int tid) {
#pragma unroll
    for (int i = 0; i < NCH; ++i) { const int c = tid + 512 * i; r[i] = *(const uint4*)(src + (size_t)(c >> 3) * ld + (c & 7) * 8); }
}
template <int NCH> DI void stv(LAS unsigned char* Vt, const uint4 (&r)[NCH], int tid) {
#pragma unroll
    for (int i = 0; i < NCH; ++i) { const int c = tid + 512 * i; const int ch = c & 7, lc = ch & 3;
        LAS unsigned char* p = Vt + (c >> 3) * VPITCH + ((ch >> 2) * 32 + 16 * (lc & 1) + 4 * (lc >> 1)) * 2;
        typedef unsigned u32x2 __attribute__((ext_vector_type(2)));
        *(LAS u32x2*)p = (u32x2){r[i].x, r[i].y}; *(LAS u32x2*)(p + 16) = (u32x2){r[i].z, r[i].w}; }
}


template <class R, class NextFn, class LoadFn, class StoreFn, class ComputeFn>
DI void tile_pipeline(NextFn next, LoadFn load, StoreFn store, ComputeFn compute) {
    R A, B;
    int tA = next(), tB = (tA >= 0) ? next() : -1;
    if (tA >= 0) load(A, tA);
    if (tB >= 0) load(B, tB);
    __syncthreads();
    if (tA >= 0) store(A, 0);
    __syncthreads();
    while (tA >= 0) {
        const int tC = (tB >= 0) ? next() : -1;
        if (tC >= 0) load(A, tC);
        if (tB >= 0) store(B, 1);
        compute(tA, 0);
        __syncthreads();
        if (tB < 0) break;
        const int tD = (tC >= 0) ? next() : -1;
        if (tD >= 0) load(B, tD);
        if (tC >= 0) store(A, 0);
        compute(tB, 1);
        __syncthreads();
        tA = tC; tB = tD;
    }
}
struct RegsKV { uint4 k[2], v[2]; };
struct RegsK { uint4 k[2]; };
struct RegsD { uint4 k0[2], k1[2], v[4]; };

DI void diff_unit(const bf16_t* QK, const bf16_t* VT, const float* subln, float lam_full, float out_scale, bf16_t* Y, int b, int h, int qt, LAS unsigned char* lds) {
    int tid_l = threadIdx.x; asm volatile("" : "+v"(tid_l)); const int tid = tid_l, lane = tid & 63, w = tid >> 6, mm = w >> 2, quad = lane >> 4;
    const int q0 = qt * 64, t = q0 + (w & 3) * 16 + (lane & 15);
    LAS unsigned char* K0 = lds; LAS unsigned char* Vt = lds + 2 * KTILE_B;
    bf16x8 qf[4];
    { const bf16_t* qp = QK + (size_t)(b * SEQ + t) * 4096 + 2048 + (h * 2 + mm) * 128 + quad * 8;
#pragma unroll
      for (int ks = 0; ks < 4; ++ks) qf[ks] = *(const bf16x8*)(qp + ks * 32); }
    f32x4 o[16];
#pragma unroll
    for (int i = 0; i < 16; ++i) o[i] = (f32x4){0.f, 0.f, 0.f, 0.f};
    float m = -1e30f, l = 0.f;
    const bf16_t* kbase = QK + (size_t)b * SEQ * 4096 + 3072 + h * 256;
    const bf16_t* vbase = VT + (size_t)(b * 1536 + 512 + h * 256) * SEQ;
    { int jn = 0;
      tile_pipeline<RegsD>(
        [&]() { return (jn <= qt) ? jn++ : -1; },
        [&](RegsD& R, int j) { const bf16_t* kp = kbase + (size_t)j * 64 * 4096; ldk(R.k0, kp, 4096, tid); ldk(R.k1, kp + 128, 4096, tid); ldv<4>(R.v, vbase + j * 64, SEQ, tid); },
        [&](RegsD& R, int bf) { stk(K0 + bf * DSTAGE, R.k0, tid); stk(K0 + bf * DSTAGE + KTILE_B, R.k1, tid); stv<4>(Vt + bf * DSTAGE, R.v, tid); },
        [&](int j, int bf) { f32x4 s[4]; qk_tile(K0 + bf * DSTAGE + mm * KTILE_B, qf, s, lane); const int kb = j * 64;
                     softmax_pv<16, true>(Vt + bf * DSTAGE, s, o, m, l, [&](int kidx) { return kb + kidx <= t; }, lane, j == qt); }); }
    l += __shfl_xor(l, 16); l += __shfl_xor(l, 32);
    const float inv = 1.f / l;
    __syncthreads();
    float* xb = (float*)lds;
    if (mm == 1) {
#pragma unroll
        for (int i = 0; i < 16; ++i) *(f32x4*)(xb + ((size_t)((w & 3) * 16 + (lane & 15)) * 256 + i * 16 + quad * 4)) = o[i] * (inv * lam_full);
    }
    __syncthreads();
    if (mm == 0) {
        float ss = 0.f;
#pragma unroll
        for (int i = 0; i < 16; ++i) { const f32x4 o1 = *(const f32x4*)(xb + ((size_t)((w & 3) * 16 + (lane & 15)) * 256 + i * 16 + quad * 4));
            o[i] = o[i] * inv - o1; ss += o[i][0] * o[i][0] + o[i][1] * o[i][1] + o[i][2] * o[i][2] + o[i][3] * o[i][3]; }
        ss += __shfl_xor(ss, 16); ss += __shfl_xor(ss, 32);
        const float rs = rsqrtf(ss * (1.f / 256.f) + 1e-5f) * out_scale;
        bf16_t* yp = Y + (size_t)(b * SEQ + t) * 1024 + h * 256 + quad * 4;
#pragma unroll
        for (int i = 0; i < 16; ++i) { const f32x4 g = *(const f32x4*)(subln + i * 16 + quad * 4); const f32x4 v = o[i] * rs * g; uint2 pk; pk.x = pack2(v[0], v[1]); pk.y = pack2(v[2], v[3]); *(uint2*)(yp + i * 16) = pk; }
    }
    __syncthreads();
}

DI void nsa_unit(const bf16_t* QK, const bf16_t* VT, const bf16_t* KC, const bf16_t* VCT, const float* G, bf16_t* Y, int b, int g, int qt, LAS unsigned char* lds) {
    int tid_l = threadIdx.x; asm volatile("" : "+v"(tid_l)); const int tid = tid_l, lane = tid & 63, w = tid >> 6, hh = w >> 1, quad = lane >> 4;
    const int q0 = qt * 32, ql = (w & 1) * 16 + (lane & 15), t = q0 + ql;
    LAS unsigned char* Kt = lds; LAS unsigned char* Vt = lds + KTILE_B;
    float* impA = (float*)(lds + 2 * NSTAGE);
    float* impB = impA + 4 * 32 * 64;
    unsigned long long* selm = (unsigned long long*)(impB + 4 * 32 * 64);
    const size_t tok = (size_t)b * SEQ + t;
    bf16x8 qf[4];
    { const bf16_t* qp = QK + tok * 4096 + (g * 4 + hh) * 128 + quad * 8;
#pragma unroll
      for (int ks = 0; ks < 4; ++ks) qf[ks] = *(const bf16x8*)(qp + ks * 32); }
    const float* gp = G + tok * 32 + (g * 4 + hh) * 3;
    const float g0 = sigmoidf_(gp[0]), g1 = sigmoidf_(gp[1]), g2 = sigmoidf_(gp[2]);
    f32x4 out[8];
#pragma unroll
    for (int i = 0; i < 8; ++i) out[i] = (f32x4){0.f, 0.f, 0.f, 0.f};
    for (int i = tid; i < 2 * 4 * 32 * 64; i += 512) impA[i] = 0.f;
    f32x4 o[8];
    float m, l;
    const int ntc = (q0 >> 10) + 1;
    const bf16_t* kcb = KC + (size_t)(b * 2 + g) * 256 * 128;
    const bf16_t* vcb = VCT + (size_t)(b * 2 + g) * 128 * 256;
#pragma unroll
    for (int i = 0; i < 8; ++i) o[i] = (f32x4){0.f, 0.f, 0.f, 0.f};
    m = -1e30f; l = 0.f;
    { int jn = 0;
      tile_pipeline<RegsKV>(
        [&]() { return (jn < ntc) ? jn++ : -1; },
        [&](RegsKV& R, int j) { ldk(R.k, kcb + (size_t)j * 64 * 128, 128, tid); ldv<2>(R.v, vcb + j * 64, 256, tid); },
        [&](RegsKV& R, int bf) { stk(Kt + bf * NSTAGE, R.k, tid); stv<2>(Vt + bf * NSTAGE, R.v, tid); },
        [&](int j, int bf) { f32x4 s[4]; qk_tile(Kt + bf * NSTAGE, qf, s, lane); const int cb = j * 64;
                     softmax_pv<8, true>(Vt + bf * NSTAGE, s, o, m, l, [&](int kidx) { const int c = cb + kidx; return (c <= 254) && (16 * c + 31 <= t); }, lane); }); }
    l += __shfl_xor(l, 16); l += __shfl_xor(l, 32);
    const float invc = (l > 0.f) ? 1.f / l : 0.f;
#pragma unroll
    for (int i = 0; i < 8; ++i) out[i] += o[i] * (invc * g0);
    { int jn = 0;
      tile_pipeline<RegsK>(
        [&]() { return (jn < ntc) ? jn++ : -1; },
        [&](RegsK& R, int j) { ldk(R.k, kcb + (size_t)j * 64 * 128, 128, tid); },
        [&](RegsK& R, int bf) { stk(Kt + bf * NSTAGE, R.k, tid); },
        [&](int j, int bf) { f32x4 s[4]; qk_tile(Kt + bf * NSTAGE, qf, s, lane);
#pragma unroll
            for (int sub = 0; sub < 4; ++sub) {
                float p[4];
#pragma unroll
                for (int e = 0; e < 4; ++e) { const int c = j * 64 + sub * 16 + quad * 4 + e; const bool ok = (c <= 254) && (16 * c + 31 <= t);
                    p[e] = ok ? __builtin_amdgcn_exp2f(s[sub][e] * SC_LOG2E - m) * invc : 0.f; }
                const int jb = j * 16 + sub * 4 + quad;
                impA[(hh * 32 + ql) * 64 + jb] = p[0] + p[1] + p[2] + p[3];
                if (jb + 1 < 64) impB[(hh * 32 + ql) * 64 + jb + 1] = p[3];
            } }); }
    __syncthreads();
#pragma unroll 1
    for (int qi = 0; qi < 4; ++qi) {
        const int qq = w * 4 + qi, tq = q0 + qq, blk = tq >> 6;
        float v = 0.f;
#pragma unroll
        for (int h2 = 0; h2 < 4; ++h2) v += impA[(h2 * 32 + qq) * 64 + lane] + impB[(h2 * 32 + qq) * 64 + lane];
        if (lane == 0 || lane == blk || lane == blk - 1) v = 1e9f; else if (lane > blk) v = -INFINITY;
        int rank = 0;
#pragma unroll 2
        for (int jj = 0; jj < 64; ++jj) { const float o2 = __int_as_float(__builtin_amdgcn_readlane(__float_as_int(v), jj)); rank += (o2 > v || (o2 == v && jj < lane)) ? 1 : 0; }
        const unsigned long long msk = __ballot((rank < 16) && (lane <= blk));
        if (lane == 0) selm[qq] = msk;
    }
    __syncthreads();
    unsigned long long un = 0ull;
#pragma unroll 1
    for (int i = 0; i < 32; ++i) un |= selm[i];
    const unsigned long long my = selm[ql];
    {
        const bf16_t* kb = QK + (size_t)b * SEQ * 4096 + 1536 + g * 128;
        const bf16_t* vb = VT + (size_t)(b * 1536 + g * 128) * SEQ;
#pragma unroll
        for (int i = 0; i < 8; ++i) o[i] = (f32x4){0.f, 0.f, 0.f, 0.f};
        m = -1e30f; l = 0.f;
        unsigned long long rem = un;
        tile_pipeline<RegsKV>(
          [&]() { if (!rem) return -1; const int j = __builtin_ctzll(rem); rem &= rem - 1; return j; },
          [&](RegsKV& R, int j) { ldk(R.k, kb + (size_t)j * 64 * 4096, 4096, tid); ldv<2>(R.v, vb + j * 64, SEQ, tid); },
          [&](RegsKV& R, int bf) { stk(Kt + bf * NSTAGE, R.k, tid); stv<2>(Vt + bf * NSTAGE, R.v, tid); },
          [&](int j, int bf) { f32x4 s[4]; qk_tile(Kt + bf * NSTAGE, qf, s, lane); const bool sel = (my >> j) & 1ull; const int kbs = j * 64;
                       softmax_pv<8, true>(Vt + bf * NSTAGE, s, o, m, l, [&](int kidx) { return sel && (kbs + kidx <= t); }, lane, !__all(sel) || (kbs + 63 > q0)); });
        l += __shfl_xor(l, 16); l += __shfl_xor(l, 32);
        const float inv = (l > 0.f) ? 1.f / l : 0.f;
#pragma unroll
        for (int i = 0; i < 8; ++i) out[i] += o[i] * (inv * g1);
    }
    {
        const bf16_t* kb = QK + (size_t)b * SEQ * 4096 + 1792 + g * 128;
        const bf16_t* vb = VT + (size_t)(b * 1536 + 256 + g * 128) * SEQ;
#pragma unroll
        for (int i = 0; i < 8; ++i) o[i] = (f32x4){0.f, 0.f, 0.f, 0.f};
        m = -1e30f; l = 0.f;
        const int jlo = (q0 >= 511) ? ((q0 - 511) >> 6) : 0, jhi = q0 >> 6;
        { int jn = jlo;
          tile_pipeline<RegsKV>(
            [&]() { return (jn <= jhi) ? jn++ : -1; },
            [&](RegsKV& R, int j) { ldk(R.k, kb + (size_t)j * 64 * 4096, 4096, tid); ldv<2>(R.v, vb + j * 64, SEQ, tid); },
            [&](RegsKV& R, int bf) { stk(Kt + bf * NSTAGE, R.k, tid); stv<2>(Vt + bf * NSTAGE, R.v, tid); },
            [&](int j, int bf) { f32x4 s[4]; qk_tile(Kt + bf * NSTAGE, qf, s, lane); const int kbs = j * 64;
                         softmax_pv<8, true>(Vt + bf * NSTAGE, s, o, m, l, [&](int kidx) { return (unsigned)(t - (kbs + kidx)) < 512u; }, lane, (kbs + 63 > q0) || ((q0 + 31) - kbs >= 512)); }); }
        l += __shfl_xor(l, 16); l += __shfl_xor(l, 32);
        const float inv = (l > 0.f) ? 1.f / l : 0.f;
#pragma unroll
        for (int i = 0; i < 8; ++i) out[i] += o[i] * (inv * g2);
    }
    bf16_t* yp = Y + tok * 1024 + (g * 4 + hh) * 128 + quad * 4;
#pragma unroll
    for (int i = 0; i < 8; ++i) { uint2 pk; pk.x = pack2(out[i][0], out[i][1]); pk.y = pack2(out[i][2], out[i][3]); *(uint2*)(yp + i * 16) = pk; }
    __syncthreads();
}
template <int CTRL> DI float dpp_add(float x) { const int y = __builtin_amdgcn_update_dpp(0, __float_as_int(x), CTRL, 0xF, 0xF, true); return x + __int_as_float(y); }
DI float red16(float x) { x = dpp_add<0xB1>(x); x = dpp_add<0x4E>(x); x = dpp_add<0x141>(x); x = dpp_add<0x140>(x); return x; }
constexpr int SCH = 32, SBUF_F = 5 * SCH * 64 + SCH * 32;
DI void scan_unit(const bf16_t* Dr, const bf16_t* Dk, const bf16_t* Dv, const bf16_t* Dkk, const bf16_t* Dka, const _Float16* Dw, float* YRAW, int b, int h, int half, LAS unsigned char* lds) {
    int tid_l = threadIdx.x; asm volatile("" : "+v"(tid_l)); const int tid = tid_l, lane = tid & 63, w = tid >> 6;
    const int rl = w * 4 + (lane >> 4), kq = lane & 15;
    LAS float* buf = (LAS float*)lds;
    const size_t base = (size_t)b * SEQ * 1024 + h * 64;
    const int st_tok = tid >> 4, st_k = (tid & 15) * 4;
    const int sv_tok = (tid >> 3) & 31, sv_r = (tid & 7) * 4;
    uint2 g_r, g_k, g_kk, g_ka, g_w, g_v;
    auto gload = [&](int ck) {
        const size_t o = base + (size_t)(ck * SCH + st_tok) * 1024 + st_k;
        g_r = *(const uint2*)(Dr + o); g_k = *(const uint2*)(Dk + o); g_kk = *(const uint2*)(Dkk + o); g_ka = *(const uint2*)(Dka + o); g_w = *(const uint2*)(Dw + o);
        if (tid < 256) g_v = *(const uint2*)(Dv + base + (size_t)(ck * SCH + sv_tok) * 1024 + half * 32 + sv_r);
    };
    auto cvt4 = [&](const uint2& u) { f32x4 f; f[0] = __uint_as_float(u.x << 16); f[1] = __uint_as_float(u.x & 0xffff0000u); f[2] = __uint_as_float(u.y << 16); f[3] = __uint_as_float(u.y & 0xffff0000u); return f; };
    auto lstore = [&](int bi) {
        LAS float* p = buf + bi * SBUF_F + st_tok * 64 + st_k;
        *(LAS f32x4*)(p) = cvt4(g_r); *(LAS f32x4*)(p + SCH * 64) = cvt4(g_k); *(LAS f32x4*)(p + 2 * SCH * 64) = cvt4(g_kk); *(LAS f32x4*)(p + 3 * SCH * 64) = cvt4(g_ka);
        { union { uint2 u; _Float16 hh[4]; } c; c.u = g_w; f32x4 f; f[0] = 1.f + (float)c.hh[0]; f[1] = 1.f + (float)c.hh[1]; f[2] = 1.f + (float)c.hh[2]; f[3] = 1.f + (float)c.hh[3]; *(LAS f32x4*)(p + 4 * SCH * 64) = f; }
        if (tid < 256) *(LAS f32x4*)(buf + bi * SBUF_F + 5 * SCH * 64 + sv_tok * 32 + sv_r) = cvt4(g_v);
    };
    f32x4 st = {0.f, 0.f, 0.f, 0.f};
    gload(0);
    __syncthreads();
    lstore(0);
    __syncthreads();
    LAS float* ypart = buf + 2 * SBUF_F;
    float* yflush = YRAW + base + half * 32;
    for (int ck = 0; ck < SEQ / SCH; ++ck) {
        const int bi = ck & 1;
        if (ck + 1 < SEQ / SCH) gload(ck + 1);
        const LAS float* p = buf + bi * SBUF_F + kq * 4;
        const LAS float* pv = buf + bi * SBUF_F + 5 * SCH * 64 + rl;
        LAS float* yp = ypart + rl * 16 + kq;
#pragma unroll 4
        for (int tt = 0; tt < SCH; ++tt) {
            const f32x4 r4 = *(const LAS f32x4*)(p + tt * 64), k4 = *(const LAS f32x4*)(p + SCH * 64 + tt * 64), kk4 = *(const LAS f32x4*)(p + 2 * SCH * 64 + tt * 64),
                        ka4 = *(const LAS f32x4*)(p + 3 * SCH * 64 + tt * 64), w4 = *(const LAS f32x4*)(p + 4 * SCH * 64 + tt * 64);
            const float vv = pv[tt * 32];
            float dot = st[0] * kk4[0] + st[1] * kk4[1] + st[2] * kk4[2] + st[3] * kk4[3];
            dot = red16(dot);
            const float sa = -dot;
            st = st * w4 + ka4 * sa + k4 * vv;
            yp[tt * 512] = st[0] * r4[0] + st[1] * r4[1] + st[2] * r4[2] + st[3] * r4[3];
        }
        if (ck + 1 < SEQ / SCH) lstore(bi ^ 1);
        __syncthreads();
        { const int idx = tid * 2, tt = idx >> 5, r = idx & 31;
          const LAS float* ys = ypart + idx * 16;
          f32x4 a = *(const LAS f32x4*)ys + *(const LAS f32x4*)(ys + 4) + *(const LAS f32x4*)(ys + 8) + *(const LAS f32x4*)(ys + 12);
          f32x4 b2 = *(const LAS f32x4*)(ys + 16) + *(const LAS f32x4*)(ys + 20) + *(const LAS f32x4*)(ys + 24) + *(const LAS f32x4*)(ys + 28);
          *(f32x2*)(yflush + (size_t)(ck * SCH + tt) * 1024 + r) = (f32x2){(a[0] + a[1]) + (a[2] + a[3]), (b2[0] + b2[1]) + (b2[2] + b2[3])}; }
        __syncthreads();
    }
}
#define PH_BEGIN const Params* PP = &P; GAS unsigned char* wsg_ = (GAS unsigned char*)P.ws; asm volatile("" : "+s"(wsg_)); unsigned char* ws = (unsigned char*)wsg_; int tid = threadIdx.x; asm volatile("" : "+v"(tid)); int bid = blockIdx.x; asm volatile("" : "+s"(bid)); \
    const int G = gridDim.x; const int gtid = bid * 512 + tid, gthreads = G * 512; (void)gtid; (void)gthreads; (void)ws;
#define WSP(T, off) ((T*)(ws + (off)))
#define INP(i, stride) ((const float*)PP->in[i] + (size_t)L * (stride))
#define XB_TMO      128
#define XB_XCNT(j)  (256  + 64 * (j))
#define XB_XSUB(j)  (1280 + 64 * (j))
#define XB_XGEN(j)  (2304 + 64 * (j))
#define XB_TOP      3328
#define XB_TOPGEN   3392
#define XCD_BAR_WORDS 3456
#define XB_SPIN_CAP (1u << 18)

__device__ __forceinline__ unsigned xb_ld(unsigned* p)              { return __hip_atomic_load(p, __ATOMIC_RELAXED, __HIP_MEMORY_SCOPE_AGENT); }
__device__ __forceinline__ unsigned xb_add(unsigned* p, unsigned v) { return __hip_atomic_fetch_add(p, v, __ATOMIC_RELAXED, __HIP_MEMORY_SCOPE_AGENT); }
__device__ __forceinline__ unsigned xb_xcc_id() { return (unsigned)__builtin_amdgcn_s_getreg((3 << 11) | 20) & 0xFu; }
#define XB_SPIN(cond, bar) do { unsigned _sp = 0; while (cond) { __builtin_amdgcn_s_sleep(1); \
    if ((++_sp & 255u) == 0u) { if (xb_ld(&(bar)[XB_TMO])) break; if (_sp > XB_SPIN_CAP) { atomicAdd(&(bar)[XB_TMO], 1u); break; } } } } while (0)

struct XcdBarrier {
    unsigned* bar; unsigned x;
    volatile LAS unsigned* st;
};

__device__ __forceinline__ XcdBarrier xcd_barrier_post(unsigned* bar, volatile LAS unsigned* st) {
    XcdBarrier b; b.bar = bar; b.x = xb_xcc_id(); b.st = st;
    if (threadIdx.x == 0) (void)xb_add(&bar[XB_XCNT(b.x)], 1u);
    return b;
}
__device__ __forceinline__ void xcd_barrier_complete(unsigned* bar, unsigned x, unsigned& nloc, unsigned& nx) {
    const unsigned G = gridDim.x * gridDim.y * gridDim.z;
    unsigned sum, cnt, mine, sp = 0u;
    for (;;) {
        sum = 0u; cnt = 0u; mine = 0u;
#pragma unroll
        for (unsigned j = 0; j < 16; ++j) { const unsigned c = xb_ld(&bar[XB_XCNT(j)]); sum += c; cnt += (c > 0u) ? 1u : 0u; mine = (j == x) ? c : mine; }
        if (sum == G) break;
        __builtin_amdgcn_s_sleep(1);
        if ((++sp & 255u) == 0u) { if (xb_ld(&bar[XB_TMO])) break; if (sp > XB_SPIN_CAP) { atomicAdd(&bar[XB_TMO], 1u); break; } }
    }
    nloc = mine > 0u ? mine : 1u; nx = cnt > 0u ? cnt : 1u;
}

__device__ __forceinline__ void xcd_barrier(const XcdBarrier& b) {
    asm volatile("s_waitcnt vmcnt(0)" ::: "memory");
    __syncthreads();
    if (threadIdx.x == 0) {
        unsigned* bar = b.bar;
        __builtin_amdgcn_s_waitcnt(0);
        unsigned nloc = b.st[0], nx = b.st[1];
        if (nloc == 0u) { xcd_barrier_complete(bar, b.x, nloc, nx); b.st[0] = nloc; b.st[1] = nx; }
        const unsigned old = xb_add(&bar[XB_XSUB(b.x)], 1u);
        const unsigned gen = old / nloc;
        if (old + 1u == (gen + 1u) * nloc) {
            __builtin_amdgcn_fence(__ATOMIC_RELEASE, "agent");
            asm volatile("s_waitcnt vmcnt(0)" ::: "memory");
            const unsigned og = xb_add(&bar[XB_TOP], 1u);
            const unsigned tg = og / nx;
            if (og + 1u == (tg + 1u) * nx) xb_add(&bar[XB_TOPGEN], 1u);
            else XB_SPIN(xb_ld(&bar[XB_TOPGEN]) == tg, bar);
            __builtin_amdgcn_fence(__ATOMIC_ACQUIRE, "agent");
            xb_add(&bar[XB_XGEN(b.x)], 1u);
            asm volatile("s_waitcnt vmcnt(0)" ::: "memory");
        } else {
            XB_SPIN(xb_ld(&bar[XB_XGEN(b.x)]) == gen, bar);
            __builtin_amdgcn_fence(__ATOMIC_ACQUIRE, "agent");
            asm volatile("s_waitcnt vmcnt(0)" ::: "memory");
        }
    }
    __syncthreads();
}


constexpr size_t OFF_BAR = 8192;
#define GSYNC() do { XcdBarrier xb_; xb_.bar = (unsigned*)(P.ws + OFF_BAR); xb_.x = xb_xcc_id(); xb_.st = (volatile LAS unsigned*)(lds + LDS_CTLW + 64); xcd_barrier(xb_); } while (0)
template <int L> DI void layer_body(const Params& P, LAS unsigned char* lds, float* tile) {
        { PH_BEGIN
          const float* cmp_w1 = INP(8, 2 * 4096 * 256); const float* cmp_w2 = INP(9, 2 * 256 * 128);
          cvt_transpose(tile, INP(6, 2048 * 9016), 9016, 2048, NWIN, WSP(bf16_t, OFF_WIN), [](int n) { return n < 2560 ? n : (n < 8992 ? n + 24 : (n < 9016 ? n - 8992 + 2560 : -1)); }, bid, G);
          cvt_transpose(tile, cmp_w1, 256, 4096, 256, WSP(bf16_t, OFF_W1T), [](int n) { return n; }, bid, G);
          cvt_transpose(tile, cmp_w1 + (size_t)4096 * 256, 256, 4096, 256, WSP(bf16_t, OFF_W1T) + (size_t)256 * 4096, [](int n) { return n; }, bid, G);
          bf16_t* W2T = WSP(bf16_t, OFF_W2T);
          for (int i = gtid; i < 256 * 256; i += gthreads) { const int n = i >> 8, k = i & 255; W2T[i] = f2bf(cmp_w2[(size_t)(n >> 7) * 256 * 128 + (size_t)k * 128 + (n & 127)]); }
          const float* w_up_l = INP(14, 64 * 1024); const float* a_up = INP(16, 64 * 1024); const float* g_up = INP(17, 160 * 1024); bf16_t* LORA = WSP(bf16_t, OFF_LORA);
          for (int i = gtid; i < 3072 * 384; i += gthreads) {
            const int n = i / 384, k = i - n * 384, kind = n >> 10, c = n & 1023; float v = 0.f;
            if (kind == 0) { if (k < 64) v = w_up_l[(size_t)k * 1024 + c]; }
            else if (kind == 1) { if (k >= 64 && k < 128) v = a_up[(size_t)(k - 64) * 1024 + c]; }
            else { if (k >= 128 && k < 288) v = g_up[(size_t)(k - 128) * 1024 + c]; }
            LORA[i] = f2bf(v);
          }
          if (gtid == 0) { const float* dlam = INP(10, 512); const float lam_init = 0.8f - 0.6f * expf(-0.3f * (float)L);
            float s01 = 0.f, s23 = 0.f; for (int i = 0; i < 128; ++i) { s01 += dlam[i] * dlam[128 + i]; s23 += dlam[256 + i] * dlam[384 + i]; } WSP(float, OFF_MISC)[L] = expf(s01) - expf(s23) + lam_init; } }
        if (L == 0) cg::this_grid().sync(); else GSYNC();

        { PH_BEGIN
          pg8::StaticOrder S; S.init(TT, NWIN, G, bid); EpiWin E{WSP(bf16_t, OFF_QK), WSP(bf16_t, OFF_VT), WSP(float, OFF_G), WSP(bf16_t, OFF_PR), WSP(const float2, OFF_ROPE)};
          pg8::gemm_phase<EpiWin, pg8::StaticOrder>(lds, Gemm{WSP(bf16_t, OFF_U), WSP(bf16_t, OFF_WIN), TT, NWIN, 2048}, S, E, nullptr); }
        GSYNC();

        { PH_BEGIN
          bf16_t* Dr = WSP(bf16_t, OFF_D);
          rwkv_shift(WSP(bf16_t, OFF_PR), INP(12, 3360), Dr, Dr + (size_t)TT * 1024, Dr + (size_t)2 * TT * 1024, WSP(bf16_t, OFF_AL), gtid, gthreads);
          build_cmpa(WSP(bf16_t, OFF_QK), INP(7, 2 * 32 * 128), WSP(bf16_t, OFF_CMPA), gtid, gthreads); }
        GSYNC();

        { PH_BEGIN
          ListOrder S{16, G, G - 1 - bid, 0}; EpiBf<1> E{WSP(bf16_t, OFF_H), 256, 16, 1, 0};
          pg8::gemm_phase<EpiBf<1>, ListOrder>(lds, Gemm{WSP(bf16_t, OFF_CMPA), WSP(bf16_t, OFF_W1T), 4096, 512, 4096}, S, E, nullptr); }
        { PH_BEGIN
          int K384 = 384; asm volatile("" : "+s"(K384));
          if (bid < G - 16) {
          pg8::StaticOrder S; S.init(TT, 1024, G - 16, bid); EpiF32 E{WSP(float, OFF_YRAW), 1024};
          pg8::gemm_phase<EpiF32, pg8::StaticOrder>(lds, Gemm{WSP(bf16_t, OFF_AL), WSP(bf16_t, OFF_LORA), TT, 1024, K384}, S, E, nullptr); } }
        { PH_BEGIN
          int K384 = 384; asm volatile("" : "+s"(K384));
          if (bid < G - 16) {
          pg8::StaticOrder S; S.init(TT, 1024, G - 16, bid); EpiBf<0> E{WSP(bf16_t, OFF_D) + (size_t)4 * TT * 1024, 1024, 64, 4, 0};
          pg8::gemm_phase<EpiBf<0>, pg8::StaticOrder>(lds, Gemm{WSP(bf16_t, OFF_AL), WSP(bf16_t, OFF_LORA) + (size_t)1024 * 384, TT, 1024, K384}, S, E, nullptr); } }
        { PH_BEGIN
          int K384 = 384; asm volatile("" : "+s"(K384));
          if (bid < G - 16) {
          pg8::StaticOrder S; S.init(TT, 1024, G - 16, bid); EpiBf<0> E{WSP(bf16_t, OFF_PR) + (size_t)2 * TT * 1024, 1024, 64, 4, 0};
          pg8::gemm_phase<EpiBf<0>, pg8::StaticOrder>(lds, Gemm{WSP(bf16_t, OFF_AL), WSP(bf16_t, OFF_LORA) + (size_t)2048 * 384, TT, 1024, K384}, S, E, nullptr); } }
        GSYNC();

        { PH_BEGIN
          ListOrder S{8, G, bid, 1}; EpiCmp2<0> E{WSP(bf16_t, OFF_KC), WSP(bf16_t, OFF_VCT), WSP(const float2, OFF_ROPE)};
          pg8::gemm_phase<EpiCmp2<0>, ListOrder>(lds, Gemm{WSP(bf16_t, OFF_H), WSP(bf16_t, OFF_W2T), 2048, 256, 256}, S, E, nullptr); }
        { PH_BEGIN
          ListOrder S{8, G, G - 1 - bid, 1}; EpiCmp2<1> E{WSP(bf16_t, OFF_KC), WSP(bf16_t, OFF_VCT), WSP(const float2, OFF_ROPE)};
          pg8::gemm_phase<EpiCmp2<1>, ListOrder>(lds, Gemm{WSP(bf16_t, OFF_H) + (size_t)2048 * 256, WSP(bf16_t, OFF_W2T), 2048, 256, 256}, S, E, nullptr); }
        { PH_BEGIN
          bf16_t* Dr = WSP(bf16_t, OFF_D);
          rwkv_prep(Dr, Dr + (size_t)TT * 1024, Dr + (size_t)3 * TT * 1024, Dr + (size_t)4 * TT * 1024, INP(18, 1024), INP(19, 1024), INP(20, 1024), WSP(float, OFF_BON), WSP(float, OFF_YRAW), INP(13, 1024), INP(15, 1024), (_Float16*)(Dr + (size_t)5 * TT * 1024), gtid, gthreads); }
        GSYNC();

        {
            LAS int* qslot = (LAS int*)(lds + LDS_CTLW);
#ifndef DUP_F
#define DUP_F 1
#endif
            for (int rep = 0; rep < DUP_F; ++rep) { if (rep) GSYNC();
            const int myx = (int)(xb_xcc_id() & 7u);
#pragma unroll 1
            for (int qq = 0; qq < 8; ++qq) {
            const int xq = (myx + qq) & 7;
            for (;;) {
                PH_BEGIN
                __syncthreads();
                if (tid == 0) *qslot = (int)atomicAdd(WSP(unsigned, OFF_CTL) + 64 * L + 16 * rep + xq, 1u);
                __syncthreads();
                const int v = *qslot;
                if (v >= 16 + 256) break;
                bf16_t* Dr = WSP(bf16_t, OFF_D); bf16_t* Y3 = WSP(bf16_t, OFF_PR);
                if (v < 16) { const int u = xq * 16 + v;
                    scan_unit(Dr, Dr + (size_t)TT * 1024, Dr + (size_t)2 * TT * 1024, Dr + (size_t)3 * TT * 1024, Dr + (size_t)4 * TT * 1024, (const _Float16*)(Dr + (size_t)5 * TT * 1024), WSP(float, OFF_YRAW), u >> 5, (u >> 1) & 15, u & 1, lds); }
                else {
                    const int w = v - 16, r = w >> 2, k = w & 3;
                    if (k < 2) { const float lam_init = 0.8f - 0.6f * expf(-0.3f * (float)L); const int idx = 2 * xq + k;
                        diff_unit(WSP(bf16_t, OFF_QK), WSP(bf16_t, OFF_VT), INP(11, 256), WSP(float, OFF_MISC)[L], 1.f - lam_init, Y3 + (size_t)TT * 1024, idx >> 2, idx & 3, 63 - r, lds); }
                    else nsa_unit(WSP(bf16_t, OFF_QK), WSP(bf16_t, OFF_VT), WSP(bf16_t, OFF_KC), WSP(bf16_t, OFF_VCT), WSP(float, OFF_G), Y3, xq >> 1, xq & 1, 127 - 2 * r - (k - 2), lds);
                }
            }
            }
            }
        }
        GSYNC();

        { PH_BEGIN
          const float* w_gate = INP(23, 3 * 2048 * 2048); const float* w_branch = INP(25, 3 * 1024 * 2048);
#pragma unroll 1
          for (int b3 = 0; b3 < 3; ++b3) {
            cvt_transpose(tile, w_gate + (size_t)b3 * 2048 * 2048, 2048, 2048, 2048, WSP(bf16_t, OFF_WG) + (size_t)b3 * 2048 * 2048, [](int n) { return n; }, bid, G);
            cvt_transpose(tile, w_branch + (size_t)b3 * 1024 * 2048, 2048, 1024, 2048, WSP(bf16_t, OFF_WB) + (size_t)b3 * 2048 * 1024, [](int n) { return n; }, bid, G);
          }
          cvt_transpose(tile, INP(26, 2048 * 2048), 2048, 2048, 2048, WSP(bf16_t, OFF_WO), [](int n) { return n; }, bid, G);
          cvt_transpose(tile, INP(27, 2048 * 8192), 8192, 2048, 8192, WSP(bf16_t, OFF_WUP), [](int n) { return n; }, bid, G);
          cvt_transpose(tile, INP(28, 8192 * 2048), 2048, 8192, 2048, WSP(bf16_t, OFF_WDN), [](int n) { return n; }, bid, G);
          rwkv_final(WSP(float, OFF_YRAW), WSP(bf16_t, OFF_D) + (size_t)2 * TT * 1024, WSP(float, OFF_BON), INP(21, 1024), INP(22, 1024), WSP(bf16_t, OFF_PR) + (size_t)2 * TT * 1024, gtid, gthreads); }
        GSYNC();

        { PH_BEGIN
          ListOrder S{1536, G, bid, 3}; EpiBf<0> E{WSP(bf16_t, OFF_Z), 2048, 64, 8, (size_t)TT * 2048};
          pg8::gemm_phase<EpiBf<0>, ListOrder>(lds, Gemm{WSP(bf16_t, OFF_PR), WSP(bf16_t, OFF_WB), 3 * TT, 6144, 1024}, S, E, nullptr); }
        GSYNC();
        { PH_BEGIN
          ListOrder S{0, G, bid, 2}; EpiMerge E{WSP(bf16_t, OFF_Z), INP(24, 3 * 2048), WSP(float, OFF_SCR), WSP(bf16_t, OFF_MRG)};
          pg8::gemm_phase<EpiMerge, ListOrder>(lds, Gemm{WSP(bf16_t, OFF_U), WSP(bf16_t, OFF_WG), TT, 6144, 2048}, S, E, nullptr); }
        GSYNC();
        { PH_BEGIN
          pg8::StaticOrder S; S.init(TT, 2048, G, bid); EpiBf<0> E{WSP(bf16_t, OFF_T1A), 2048, 0, 0, 0};
          pg8::gemm_phase<EpiBf<0>, pg8::StaticOrder>(lds, Gemm{WSP(bf16_t, OFF_MRG), WSP(bf16_t, OFF_WO), TT, 2048, 2048}, S, E, nullptr); }
        GSYNC();
        { PH_BEGIN
          row_pass(L == 0 ? (const float*)PP->in[0] : PP->out, WSP(bf16_t, OFF_T1A), INP(3, 2048), PP->out, INP(4, 2048), WSP(bf16_t, OFF_U), bid, G); }
        GSYNC();
        { PH_BEGIN
          pg8::StaticOrder S; S.init(TT, DFF, G, bid); EpiBf<2> E{WSP(bf16_t, OFF_HID), DFF, 0, 0, 0};
          pg8::gemm_phase<EpiBf<2>, pg8::StaticOrder>(lds, Gemm{WSP(bf16_t, OFF_U), WSP(bf16_t, OFF_WUP), TT, DFF, 2048}, S, E, nullptr); }
        GSYNC();
        { PH_BEGIN
          pg8::StaticOrder S; S.init(TT, 2048, G, bid); EpiBf<0> E{WSP(bf16_t, OFF_T1B), 2048, 0, 0, 0};
          pg8::gemm_phase<EpiBf<0>, pg8::StaticOrder>(lds, Gemm{WSP(bf16_t, OFF_HID), WSP(bf16_t, OFF_WDN), TT, 2048, DFF}, S, E, nullptr); }
        GSYNC();
        { PH_BEGIN
          row_pass(PP->out, WSP(bf16_t, OFF_T1B), INP(5, 2048), PP->out, (const float*)PP->in[2] + 2048, (L == 0) ? WSP(bf16_t, OFF_U) : (bf16_t*)nullptr, bid, G); }
        GSYNC();

}

__global__ void __launch_bounds__(512, 2) fwd_megakernel(Params P) {
    extern __shared__ __attribute__((aligned(16))) unsigned char lds_raw[];
    LAS unsigned char* lds = (LAS unsigned char*)lds_raw;
    float* tile = (float*)lds_raw;
    if (threadIdx.x < 2) ((volatile LAS unsigned*)(lds + LDS_CTLW + 64))[threadIdx.x] = 0u;
    __syncthreads();
    (void)xcd_barrier_post((unsigned*)(P.ws + OFF_BAR), (volatile LAS unsigned*)(lds + LDS_CTLW + 64));
    { PH_BEGIN {
      const int* positions = (const int*)PP->in[1]; float2* ROPE = WSP(float2, OFF_ROPE);
      for (int i = gtid; i < TT * 16; i += gthreads) {
        const int tok = i >> 4, f = i & 15;
        const float inv = (float)pow(500000.0, -(double)f / 16.0);
        const float ang = (float)positions[tok] * inv;
        const double a = (double)ang; const double k = rint(a * 0.15915494309189535); const float r = (float)(a - k * 6.283185307179586);
        ROPE[i] = make_float2(__cosf(r), __sinf(r));
      }
      norm_pass((const float*)PP->in[0], (const float*)PP->in[2], WSP(bf16_t, OFF_U), bid, G); } }

    layer_body<0>(P, lds, tile);
    layer_body<1>(P, lds, tile);
}

extern "C" void kernel_launch(void* const* d_in, const int* in_sizes, int n_in, void* d_out, int out_size, void* d_ws, size_t ws_size, hipStream_t stream) {
    static int grid_blocks = 0;
    if (!grid_blocks) {
        int dev = 0, cus = 0, per_cu = 0;
        (void)hipGetDevice(&dev);
        (void)hipDeviceGetAttribute(&cus, hipDeviceAttributeMultiprocessorCount, dev);
        (void)hipFuncSetAttribute((const void*)fwd_megakernel, hipFuncAttributeMaxDynamicSharedMemorySize, LDS_BYTES);
        (void)hipOccupancyMaxActiveBlocksPerMultiprocessor(&per_cu, (const void*)fwd_megakernel, 512, LDS_BYTES);
        if (per_cu < 1) per_cu = 1;
        grid_blocks = cus * per_cu;
        if (ws_size < WS_END) fprintf(stderr, "kernel_launch: workspace too small: %zu < %zu\n", ws_size, (size_t)WS_END);
    }
    (void)hipMemsetAsync((char*)d_ws + OFF_CTL, 0, 32768, stream);
    Params p{};
    for (int k = 0; k < NIN; ++k) p.in[k] = d_in[k];
    p.out = (float*)d_out; p.ws = (unsigned char*)d_ws; p.stage = 0; p.pad = 0;
    void* args[] = {&p};
    hipError_t e = hipLaunchCooperativeKernel((const void*)fwd_megakernel, dim3(grid_blocks), dim3(512), args, LDS_BYTES, stream);
    if (e != hipSuccess) fprintf(stderr, "cooperative launch failed: %s (grid %d)\n", hipGetErrorString(e), grid_blocks);
}
```

```cpp
#include <hip/hip_runtime.h>
#include <hip/hip_cooperative_groups.h>
#include <cstdio>
#include <cstdint>
namespace cg = cooperative_groups;
#define DI __device__ __forceinline__
#define LAS __attribute__((address_space(3)))
#define GAS __attribute__((address_space(1)))
namespace pg8 {
#define PG8_LAS __attribute__((address_space(3)))
typedef unsigned short bf16_t;
typedef short bf16x8 __attribute__((ext_vector_type(8)));
typedef float f32x4 __attribute__((ext_vector_type(4)));
typedef unsigned u32x4 __attribute__((ext_vector_type(4)));
constexpr int BM = 256, BK = 64, HALF = 128, HTB = HALF * BK * 2  , STAGE_BYTES = 8 * HTB, NXCD = 8, WGM = 8;

__host__ __device__ __forceinline__ int lds_byte(int r, int c) { const int st = (r >> 4) * 2 + (c >> 5), rr = r & 15, cc = c & 31, ob = rr * 64 + cc * 2; return st * 1024 + (ob ^ (((ob >> 9) & 1) << 5)); }
__host__ __device__ __forceinline__ void stage_rc(int b, int& R, int& C) { const int st = b / 1024, sb = b % 1024, swz = sb ^ (((sb >> 9) & 1) << 5); R = (st >> 1) * 16 + swz / 64; C = (st & 1) * 32 + (swz % 64) / 2; }
__host__ __device__ __forceinline__ int perm32(int rho) { const int n = rho >> 4, i = rho & 15; return 8 * (i >> 2) + 4 * n + (i & 3); }

struct Unit { int pm, pn; };
struct Gemm { const bf16_t* A; const bf16_t* Bt; int M, N, K; };

struct StaticOrder {
    int nM, nN, nwg, G, c;
    __host__ __device__ void init(int M, int N, int G_, int c_) { nM = M / BM; nN = N / BM; nwg = nM * nN; G = G_; c = c_; }
    __host__ __device__ bool next(int i, Unit& u) const {
        const long L = (long)i * G + c; if (L >= nwg) return false;
        int wgid = (int)L; { const int q = nwg / NXCD, r = nwg % NXCD, xcd = wgid % NXCD, off = wgid / NXCD; wgid = (xcd < r ? xcd * (q + 1) : r * (q + 1) + (xcd - r) * q) + off; }
        const int nig = WGM * nN, gid = wgid / nig, fm = gid * WGM, gsz = (nM - fm) < WGM ? (nM - fm) : WGM;
        u.pm = fm + ((wgid % nig) % gsz); u.pn = (wgid % nig) / gsz; return true;
    }
    __device__ __forceinline__ void a_ready(const Unit&) const {}
    __device__ __forceinline__ void done(const Unit&) const {}
};
template <class Epi, class Sched, bool STAMP = false>
__device__ __forceinline__ void gemm_phase(PG8_LAS unsigned char* lds, const Gemm g, const Sched& S, const Epi& E, unsigned long long* stamps) {
    int tid_l = threadIdx.x; asm volatile("" : "+v"(tid_l)); const int tid = tid_l, wid = __builtin_amdgcn_readfirstlane(tid >> 6), lane = tid & 63, wr = wid >> 2, wc = wid & 3, fr = lane & 15, fq = lane >> 4;
    const int K = g.K, nt = K / BK;
    int ts_lo = 0, ts_hi = 0, nts = 0; const unsigned long long rt_entry = STAMP ? (unsigned long long)wall_clock64() : 0ull;
#define PG8_STAMP() do { if (STAMP && wid == 0 && nts < 64) { const unsigned long long _c = (unsigned long long)clock64(); \
        ts_lo = (lane == nts) ? (int)(unsigned)_c : ts_lo; ts_hi = (lane == nts) ? (int)(unsigned)(_c >> 32) : ts_hi; ++nts; } } while (0)
    PG8_STAMP();
    unsigned voffA[2], voffB[2];
#pragma unroll
    for (int i = 0; i < 2; ++i) { int R, C; stage_rc(tid * 16 + i * 8192, R, C); const int Rb = Epi::PERM ? ((R & ~31) + perm32(R & 31)) : R;
        voffA[i] = (unsigned)(R * K + C) * 2u; voffB[i] = (unsigned)(Rb * K + C) * 2u; }
    const size_t kstep = (size_t)(BK * 2);
    const size_t hstep = (size_t)HALF * K * 2;
    const size_t tstep = 2 * hstep;
    const unsigned ldsw = (unsigned)wid * 1024u;
    const int aoff = lds_byte(wr * 64 + fr, fq * 8), boff = lds_byte(wc * 32 + fr, fq * 8);
#define PG8_SA(b, h) (((b) * 2 + (h)) * HTB)
#define PG8_SB(b, h) ((4 + (b) * 2 + (h)) * HTB)
#define PG8_STAGE(bufoff, gbase, voff) do { _Pragma("unroll") for (int _i = 0; _i < 2; ++_i) \
        __builtin_amdgcn_global_load_lds((const unsigned*)((const char*)(gbase) + (voff)[_i]), (PG8_LAS unsigned*)(lds + (bufoff) + ldsw + _i * 8192), 16, 0, 0); } while (0)
#define PG8_LDA(dst, b, h) do { _Pragma("unroll") for (int m = 0; m < 4; ++m) _Pragma("unroll") for (int k = 0; k < 2; ++k) dst[m][k] = *(const PG8_LAS bf16x8*)(lds + PG8_SA(b, h) + aoff + m * 2048 + k * 1024); } while (0)
#define PG8_LDB(dst, b, h) do { _Pragma("unroll") for (int n = 0; n < 2; ++n) _Pragma("unroll") for (int k = 0; k < 2; ++k) dst[n][k] = *(const PG8_LAS bf16x8*)(lds + PG8_SB(b, h) + boff + n * 2048 + k * 1024); } while (0)
#define PG8_MMA(ai, bj, At, Bt) do { __builtin_amdgcn_s_setprio(1); _Pragma("unroll") for (int m = 0; m < 4; ++m) _Pragma("unroll") for (int n = 0; n < 2; ++n) _Pragma("unroll") for (int k = 0; k < 2; ++k) \
        acc[ai][bj][m][n] = __builtin_amdgcn_mfma_f32_16x16x32_bf16(Bt[n][k], At[m][k], acc[ai][bj][m][n], 0, 0, 0); __builtin_amdgcn_s_setprio(0); } while (0)
#define PG8_WAIT_V(n) asm volatile("s_waitcnt vmcnt(" #n ")" ::: "memory")
#define PG8_WAIT_L(n) asm volatile("s_waitcnt lgkmcnt(" #n ")" ::: "memory")
#define PG8_BAR __builtin_amdgcn_s_barrier()
#define PG8_SCHED __builtin_amdgcn_sched_barrier(0)
    Unit cur, nxt; int ui = 0;
    if (!S.next(0, cur)) return;
    f32x4 acc[2][2][4][2];
#pragma unroll
    for (int a = 0; a < 2; ++a)
#pragma unroll
        for (int b = 0; b < 2; ++b)
#pragma unroll
            for (int m = 0; m < 4; ++m)
#pragma unroll
                for (int n = 0; n < 2; ++n) acc[a][b][m][n] = (f32x4){0.f, 0.f, 0.f, 0.f};
    bf16x8 At[4][2], B0[2][2], B1[2][2];
    const char* cA = (const char*)g.A + (size_t)cur.pm * tstep; const char* cB = (const char*)g.Bt + (size_t)cur.pn * tstep;
    S.a_ready(cur);
    PG8_STAGE(PG8_SB(0, 0), cB, voffB); PG8_STAGE(PG8_SA(0, 0), cA, voffA); PG8_STAGE(PG8_SB(0, 1), cB + hstep, voffB); PG8_STAGE(PG8_SA(0, 1), cA + hstep, voffA);
    if (wr == 1) PG8_BAR;
    PG8_WAIT_V(4); PG8_BAR;
    PG8_STAGE(PG8_SB(1, 0), cB + kstep, voffB); PG8_STAGE(PG8_SA(1, 0), cA + kstep, voffA); PG8_STAGE(PG8_SB(1, 1), cB + hstep + kstep, voffB);
    PG8_WAIT_V(6); PG8_BAR;
    PG8_STAMP();
    for (;;) {
        const bool has_next = S.next(ui + 1, nxt);
        const char* nA = has_next ? (const char*)g.A + (size_t)nxt.pm * tstep : cA; const char* nB = has_next ? (const char*)g.Bt + (size_t)nxt.pn * tstep : cB;
        for (int t = 0; t < nt; t += 2) {
            const bool last = (t == nt - 2);
            const char* a1 = cA + (size_t)(t + 1) * kstep;
            const char* a2 = last ? nA : cA + (size_t)(t + 2) * kstep; const char* b2 = last ? nB : cB + (size_t)(t + 2) * kstep;
            const char* a3 = a2 + kstep; const char* b3 = b2 + kstep;
            if (last && has_next) S.a_ready(nxt);
            PG8_LDB(B0, 0, 0); PG8_SCHED; PG8_LDA(At, 0, 0); PG8_STAGE(PG8_SA(1, 1), a1 + hstep, voffA);
            PG8_WAIT_L(8); PG8_BAR; PG8_WAIT_L(0); PG8_MMA(0, 0, At, B0); PG8_BAR; PG8_SCHED;
            PG8_LDB(B1, 0, 1); PG8_STAGE(PG8_SB(0, 0), b2, voffB);
            PG8_BAR; PG8_WAIT_L(0); PG8_MMA(0, 1, At, B1); PG8_BAR;
            PG8_LDA(At, 0, 1); PG8_STAGE(PG8_SA(0, 0), a2, voffA);
            PG8_BAR; PG8_WAIT_L(0); PG8_MMA(1, 0, At, B0); PG8_BAR; PG8_SCHED;
            PG8_STAGE(PG8_SB(0, 1), b2 + hstep, voffB);
            PG8_WAIT_V(6); PG8_BAR; PG8_MMA(1, 1, At, B1); PG8_BAR;
            PG8_LDB(B0, 1, 0); PG8_SCHED; PG8_LDA(At, 1, 0); PG8_STAGE(PG8_SA(0, 1), a2 + hstep, voffA);
            PG8_WAIT_L(8); PG8_BAR; PG8_WAIT_L(0); PG8_MMA(0, 0, At, B0); PG8_BAR; PG8_SCHED;
            PG8_LDB(B1, 1, 1); PG8_STAGE(PG8_SB(1, 0), b3, voffB);
            PG8_BAR; PG8_WAIT_L(0); PG8_MMA(0, 1, At, B1); PG8_BAR;
            PG8_LDA(At, 1, 1); PG8_STAGE(PG8_SA(1, 0), a3, voffA);
            PG8_BAR; PG8_WAIT_L(0); PG8_MMA(1, 0, At, B0); PG8_BAR; PG8_SCHED;
            PG8_STAGE(PG8_SB(1, 1), b3 + hstep, voffB);
            PG8_WAIT_V(6); PG8_BAR; PG8_MMA(1, 1, At, B1); PG8_BAR;
        }
        PG8_STAMP();
        if constexpr (!Epi::AFTER_DRAIN) { E(acc, cur, wr, wc, fr, fq); S.done(cur); }
        PG8_STAMP();
        if (!has_next) break;
#pragma unroll
        for (int a = 0; a < 2; ++a)
#pragma unroll
            for (int b = 0; b < 2; ++b)
#pragma unroll
                for (int m = 0; m < 4; ++m)
#pragma unroll
                    for (int n = 0; n < 2; ++n) acc[a][b][m][n] = (f32x4){0.f, 0.f, 0.f, 0.f};
        cur = nxt; cA = nA; cB = nB; ++ui;
    }
    PG8_WAIT_V(0);
    if (wr == 0) PG8_BAR;
    PG8_BAR;
    if constexpr (Epi::AFTER_DRAIN) { E.fused(acc, cur, wr, wc, fr, fq, lds, wid, lane); S.done(cur); }
    PG8_STAMP();
    if (STAMP && wid == 0) { stamps[lane] = lane < nts ? (((unsigned long long)(unsigned)ts_hi << 32) | (unsigned)ts_lo) : 0ull;
        if (lane == 62) stamps[62] = rt_entry; if (lane == 63) stamps[63] = (unsigned long long)wall_clock64(); }
#undef PG8_STAMP
#undef PG8_SA
#undef PG8_SB
#undef PG8_STAGE
#undef PG8_LDA
#undef PG8_LDB
#undef PG8_MMA
#undef PG8_WAIT_V
#undef PG8_WAIT_L
#undef PG8_BAR
#undef PG8_SCHED
}
}
using pg8::bf16_t; using pg8::bf16x8; using pg8::f32x4; using pg8::Unit; using pg8::Gemm;
typedef short s16x4 __attribute__((ext_vector_type(4)));
typedef float f32x2 __attribute__((ext_vector_type(2)));

constexpr int NB = 4, SEQ = 4096, TT = NB * SEQ, DM = 2048, DFF = 8192;
constexpr int NWIN = 9216;
constexpr int LDPR = 3360;
constexpr int NIN = 29;
constexpr float SC_LOG2E = 0.08838834764831845f * 1.4426950408889634f;

constexpr size_t al4k(size_t x) { return (x + 4095) & ~(size_t)4095; }
constexpr size_t OFF_CTL  = 0;
constexpr size_t OFF_MISC = 65536;
constexpr size_t OFF_ROPE = 1u << 20;
constexpr size_t OFF_WIN  = OFF_ROPE + (size_t)TT * 16 * 8;
constexpr size_t OFF_W1T  = OFF_WIN + (size_t)NWIN * 2048 * 2;
constexpr size_t OFF_W2T  = OFF_W1T + (size_t)512 * 4096 * 2;
constexpr size_t OFF_LORA = OFF_W2T + (size_t)256 * 256 * 2;
constexpr size_t OFF_U    = al4k(OFF_LORA + (size_t)3072 * 384 * 2);
constexpr size_t OFF_QK   = OFF_U + (size_t)TT * 2048 * 2;
constexpr size_t OFF_VT   = OFF_QK + (size_t)TT * 4096 * 2;
constexpr size_t OFF_G    = OFF_VT + (size_t)NB * 1536 * SEQ * 2;
constexpr size_t OFF_PR   = OFF_G + (size_t)TT * 32 * 4;
constexpr size_t OFF_D    = al4k(OFF_PR + (size_t)TT * LDPR * 2);
constexpr size_t DSZ      = (size_t)TT * 1024 * 2;
constexpr size_t OFF_AL   = OFF_D + 6 * DSZ;
constexpr size_t OFF_BON  = OFF_AL + (size_t)TT * 384 * 2;
constexpr size_t OFF_CMPA = OFF_BON + (size_t)TT * 16 * 4;
constexpr size_t OFF_H    = OFF_CMPA + (size_t)4096 * 4096 * 2;
constexpr size_t OFF_KC   = OFF_H + (size_t)4096 * 256 * 2;
constexpr size_t OFF_VCT  = OFF_KC + (size_t)NB * 2 * 256 * 128 * 2;
constexpr size_t OFF_YRAW = OFF_VCT + (size_t)NB * 2 * 128 * 256 * 2;
constexpr size_t WS_END   = OFF_YRAW + (size_t)TT * 1024 * 4;
constexpr size_t OFF_WG   = OFF_QK;
constexpr size_t OFF_WB   = OFF_WG + (size_t)6144 * 2048 * 2;
constexpr size_t OFF_WO   = OFF_WB + (size_t)6144 * 1024 * 2;
constexpr size_t OFF_WUP  = OFF_WO + (size_t)2048 * 2048 * 2;
constexpr size_t OFF_WDN  = OFF_WUP + (size_t)8192 * 2048 * 2;
static_assert(OFF_WDN + (size_t)2048 * 8192 * 2 <= OFF_VT, "W2 must fit in the QK region");
constexpr size_t OFF_Z    = OFF_D;
constexpr size_t OFF_T1A  = OFF_D;
constexpr size_t OFF_HID  = OFF_D;
static_assert(OFF_HID + (size_t)TT * 8192 * 2 <= WS_END, "h must fit");
constexpr size_t OFF_T1B  = OFF_VT;
static_assert(OFF_T1B + (size_t)TT * 2048 * 4 <= OFF_D, "t1b must fit before D");
constexpr size_t OFF_MRG  = OFF_YRAW;
constexpr size_t OFF_SCR  = OFF_PR;
static_assert(OFF_SCR + (size_t)256 * 256 * 256 * 4 <= OFF_D, "scratch must fit");
constexpr int LDS_CTLW = 156672;
constexpr int LDS_BYTES = LDS_CTLW + 1024;

struct Params { const void* in[NIN]; float* out; unsigned char* ws; int stage; int pad; };

DI bf16_t f2bf(float f) { unsigned u = __float_as_uint(f); u += 0x7fffu + ((u >> 16) & 1u); return (bf16_t)(u >> 16); }
DI float bf2f(bf16_t b) { return __uint_as_float(((unsigned)b) << 16); }
typedef __bf16 bf16v2 __attribute__((ext_vector_type(2)));
DI unsigned pack2(float lo, float hi) { const f32x2 v = {lo, hi}; return __builtin_bit_cast(unsigned, __builtin_convertvector(v, bf16v2)); }
DI float sigmoidf_(float x) { return __builtin_amdgcn_rcpf(1.f + __expf(-x)); }
DI float wave_sum(float v) {
#pragma unroll
    for (int o = 32; o > 0; o >>= 1) v += __shfl_xor(v, o);
    return v;
}
DI void unpack8(const uint4& u, float (&f)[8]) {
    f[0] = __uint_as_float(u.x << 16); f[1] = __uint_as_float(u.x & 0xffff0000u);
    f[2] = __uint_as_float(u.y << 16); f[3] = __uint_as_float(u.y & 0xffff0000u);
    f[4] = __uint_as_float(u.z << 16); f[5] = __uint_as_float(u.z & 0xffff0000u);
    f[6] = __uint_as_float(u.w << 16); f[7] = __uint_as_float(u.w & 0xffff0000u);
}
DI uint4 pack8(const float (&f)[8]) { uint4 u; u.x = pack2(f[0], f[1]); u.y = pack2(f[2], f[3]); u.z = pack2(f[4], f[5]); u.w = pack2(f[6], f[7]); return u; }

struct ListOrder {
    int n, G, c, mode;
    DI bool next(int i, Unit& u) const {
        if (mode == 2) {
            const int j = i / 3, b = i - 3 * j, tile = j * G + c; if (tile >= 512) return false;
            u.pm = tile >> 3; u.pn = b * 8 + (tile & 7); return true;
        }
        const int L = i * G + c; if (L >= n) return false;
        if (mode == 0) { u.pm = L; u.pn = L >> 3; }
        else if (mode == 1) { u.pm = L; u.pn = 0; }
        else { const int b = L >> 9, tile = L & 511; u.pm = b * 64 + (tile >> 3); u.pn = b * 8 + (tile & 7); }
        return true;
    }
    DI void a_ready(const Unit&) const {}
    DI void done(const Unit&) const {}
};
struct EpiWin {
    static constexpr bool PERM = true, AFTER_DRAIN = false;
    bf16_t* QK; bf16_t* VT; float* G; bf16_t* PR; const float2* rope;
    DI void operator()(const f32x4 (&acc)[2][2][4][2], const Unit& u, int wr, int wc, int fr, int fq) const {
        const int pn = u.pn;
        const int row0 = u.pm * 256 + wr * 64 + fr;
        const bool isV = (pn == 7) || (pn == 9) || (pn >= 18 && pn <= 21);
        if (isV) {
            const int vbase = (pn == 7) ? 0 : (pn == 9) ? 256 : 512 + (pn - 18) * 256;
#pragma unroll
            for (int ai = 0; ai < 2; ++ai)
#pragma unroll
                for (int m = 0; m < 4; ++m) {
                    const int row = row0 + ai * 128 + m * 16; const int b = row >> 12, s = row & 4095;
#pragma unroll
                    for (int bj = 0; bj < 2; ++bj) {
                        const int cu = bj * 128 + wc * 32 + fq * 8;
                        bf16_t* dst = VT + ((size_t)(b * 1536 + vbase + cu) * SEQ + s);
#pragma unroll
                        for (int n = 0; n < 2; ++n)
#pragma unroll
                            for (int e = 0; e < 4; ++e) dst[(size_t)(n * 4 + e) * SEQ] = f2bf(acc[ai][bj][m][n][e]);
                    }
                }
        } else if (pn >= 22) {
#pragma unroll
            for (int ai = 0; ai < 2; ++ai)
#pragma unroll
                for (int m = 0; m < 4; ++m) {
                    const int row = row0 + ai * 128 + m * 16;
#pragma unroll
                    for (int bj = 0; bj < 2; ++bj) {
                        const int cu = bj * 128 + wc * 32 + fq * 8;
                        const f32x4 v0 = acc[ai][bj][m][0], v1 = acc[ai][bj][m][1];
                        if (pn < 35 || cu < 32) {
                            const int col = (pn - 22) * 256 + cu;
                            uint4 o; o.x = pack2(v0[0], v0[1]); o.y = pack2(v0[2], v0[3]); o.z = pack2(v1[0], v1[1]); o.w = pack2(v1[2], v1[3]);
                            *(uint4*)(PR + (size_t)row * LDPR + col) = o;
                        } else if (cu < 56) {
                            *(f32x4*)(G + (size_t)row * 32 + (cu - 32)) = v0; *(f32x4*)(G + (size_t)row * 32 + (cu - 32) + 4) = v1;
                        }
                    }
                }
        } else {
            const int qoff = (pn <= 6) ? 0 : (pn == 8) ? -256 : -512;
            const bool dorope = (wc == 0) && (pn != 4) && (pn != 5);
            const bool lowhalf = fq < 2;
#pragma unroll
            for (int ai = 0; ai < 2; ++ai)
#pragma unroll
                for (int m = 0; m < 4; ++m) {
                    const int row = row0 + ai * 128 + m * 16;
#pragma unroll
                    for (int bj = 0; bj < 2; ++bj) {
                        f32x4 v0 = acc[ai][bj][m][0], v1 = acc[ai][bj][m][1];
                        if (dorope) {
                            const float2* rp = rope + (size_t)row * 16 + (fq & 1) * 8;
#pragma unroll
                            for (int e = 0; e < 4; ++e) {
                                const float2 c0 = rp[e], c1 = rp[4 + e];
                                const float p0 = __shfl_xor(v0[e], 32), p1 = __shfl_xor(v1[e], 32);
                                v0[e] = lowhalf ? (v0[e] * c0.x - p0 * c0.y) : (v0[e] * c0.x + p0 * c0.y);
                                v1[e] = lowhalf ? (v1[e] * c1.x - p1 * c1.y) : (v1[e] * c1.x + p1 * c1.y);
                            }
                        }
                        const int col = pn * 256 + qoff + bj * 128 + wc * 32 + fq * 8;
                        uint4 o; o.x = pack2(v0[0], v0[1]); o.y = pack2(v0[2], v0[3]); o.z = pack2(v1[0], v1[1]); o.w = pack2(v1[2], v1[3]);
                        *(uint4*)(QK + (size_t)row * 4096 + col) = o;
                    }
                }
        }
    }
};

typedef _Float16 f16x4 __attribute__((ext_vector_type(4)));
DI float gelu_tanh(float x) { const float t = 0.7978845608028654f * (x + 0.044715f * x * x * x); const float e = __expf(2.f * t); const float th = 1.f - 2.f / (e + 1.f); return 0.5f * x * (1.f + th); }

template <int ACT  > struct EpiBf {
    static constexpr bool PERM = true, AFTER_DRAIN = false;
    bf16_t* O; int ldc; int pm_mod, pn_mod; size_t grp_stride;
    DI void operator()(const f32x4 (&acc)[2][2][4][2], const Unit& u, int wr, int wc, int fr, int fq) const {
        int pm = u.pm, pn = u.pn; bf16_t* base = O;
        if (pm_mod) { base += (size_t)(pm / pm_mod) * grp_stride; pm %= pm_mod; pn %= pn_mod; }
        const int row0 = pm * 256 + wr * 64 + fr, col0 = pn * 256 + wc * 32 + fq * 8;
#pragma unroll
        for (int ai = 0; ai < 2; ++ai)
#pragma unroll
            for (int m = 0; m < 4; ++m) {
                bf16_t* rowp = base + (size_t)(row0 + ai * 128 + m * 16) * ldc + col0;
#pragma unroll
                for (int bj = 0; bj < 2; ++bj) {
                    float f[8];
#pragma unroll
                    for (int e = 0; e < 4; ++e) { f[e] = acc[ai][bj][m][0][e]; f[4 + e] = acc[ai][bj][m][1][e]; }
#pragma unroll
                    for (int e = 0; e < 8; ++e) { if (ACT == 1) f[e] = gelu_tanh(f[e]); else if (ACT == 2) { const float r = fmaxf(f[e], 0.f); f[e] = r * r; } }
                    *(uint4*)(rowp + bj * 128) = pack8(f);
                }
            }
    }
};

template <int KV> struct EpiCmp2 {
    static constexpr bool PERM = false, AFTER_DRAIN = false;
    bf16_t* KC; bf16_t* VCT; const float2* rope;
    DI void operator()(const f32x4 (&acc)[2][2][4][2], const Unit& u, int wr, int wc, int fr, int fq) const {
        constexpr int kv = KV;
        const int row0 = (u.pm & 7) * 256 + wr * 64 + fr;
        if (kv == 0) {
#pragma unroll
            for (int ai = 0; ai < 2; ++ai)
#pragma unroll
                for (int m = 0; m < 4; ++m) {
                    int rr = row0 + ai * 128 + m * 16; asm volatile("" : "+v"(rr)); __builtin_amdgcn_sched_barrier(0); const int b = rr >> 9, c = (rr & 511) >> 1, g = rr & 1;
                    f32x4 v0 = acc[ai][0][m][0], v1 = acc[ai][0][m][1];
                    if (wc == 0) {
                        const int tok = b * SEQ + (c < 255 ? 16 * c + 31 : 0);
                        const float2* rp = rope + (size_t)tok * 16 + fq * 4;
#pragma unroll
                        for (int e = 0; e < 4; ++e) { const float2 cs = rp[e]; const float a = v0[e], b2 = v1[e]; v0[e] = a * cs.x - b2 * cs.y; v1[e] = b2 * cs.x + a * cs.y; }
                    }
                    bf16_t* dst = KC + ((size_t)((b * 2 + g) * 256 + c) * 128 + wc * 32 + fq * 4);
                    uint2 o; o.x = pack2(v0[0], v0[1]); o.y = pack2(v0[2], v0[3]); *(uint2*)dst = o;
                    o.x = pack2(v1[0], v1[1]); o.y = pack2(v1[2], v1[3]); *(uint2*)(dst + 16) = o;
                }
        } else {
#pragma unroll
            for (int ai = 0; ai < 2; ++ai)
#pragma unroll
                for (int m = 0; m < 4; ++m) {
                    int rr = row0 + ai * 128 + m * 16; asm volatile("" : "+v"(rr)); __builtin_amdgcn_sched_barrier(0); const int b = rr >> 9, c = (rr & 511) >> 1, g = rr & 1;
                    bf16_t* dst = VCT + (size_t)((b * 2 + g) * 128 + wc * 32 + fq * 4) * 256 + c;
#pragma unroll
                    for (int n = 0; n < 2; ++n)
#pragma unroll
                        for (int e = 0; e < 4; ++e) dst[(n * 16 + e) * 256] = f2bf(acc[ai][1][m][n][e]);
                }
        }
    }
};

struct EpiMerge {
    static constexpr bool PERM = true, AFTER_DRAIN = false;
    const bf16_t* Z; const float* bias; float* scr; bf16_t* M;
    template <int MODE> DI void run(const f32x4 (&acc)[2][2][4][2], const bf16_t* zp, const float* bp, float* sp, bf16_t* mp) const {
        typedef unsigned u32x2 __attribute__((ext_vector_type(2)));
        GAS float* s = (GAS float*)sp;
#pragma unroll
        for (int bj = 0; bj < 2; ++bj)
#pragma unroll
            for (int n = 0; n < 2; ++n) {
                const f32x4 bv = *(const f32x4*)(bp + bj * 128 + n * 4);
#pragma unroll
                for (int ai = 0; ai < 2; ++ai) {
                    GAS const bf16_t* zr = (GAS const bf16_t*)(zp + (size_t)(ai * 128) * 2048 + bj * 128 + n * 4);
                    GAS bf16_t* mr = (GAS bf16_t*)(mp + (size_t)(ai * 128) * 2048 + bj * 128 + n * 4);
                    asm volatile("" : "+v"(zr), "+v"(mr), "+v"(s));
                    u32x2 zz[4]; f32x4 pv[4];
#pragma unroll
                    for (int m = 0; m < 4; ++m) { zz[m] = *(GAS const u32x2*)(zr + (size_t)m * 16 * 2048); if (MODE > 0) pv[m] = *(GAS const f32x4*)(s + m * 2048); }
#pragma unroll
                    for (int m = 0; m < 4; ++m) {
                        f32x4 v;
                        v[0] = sigmoidf_(acc[ai][bj][m][n][0] + bv[0]) * __uint_as_float(zz[m].x << 16);
                        v[1] = sigmoidf_(acc[ai][bj][m][n][1] + bv[1]) * __uint_as_float(zz[m].x & 0xffff0000u);
                        v[2] = sigmoidf_(acc[ai][bj][m][n][2] + bv[2]) * __uint_as_float(zz[m].y << 16);
                        v[3] = sigmoidf_(acc[ai][bj][m][n][3] + bv[3]) * __uint_as_float(zz[m].y & 0xffff0000u);
                        if (MODE > 0) v += pv[m];
                        if (MODE < 2) *(GAS f32x4*)(s + m * 2048) = v;
                        else { u32x2 o; o.x = pack2(v[0], v[1]); o.y = pack2(v[2], v[3]); *(GAS u32x2*)(mr + (size_t)m * 16 * 2048) = o; }
                    }
                    s += 4 * 2048;
                }
            }
    }
    DI void operator()(const f32x4 (&acc)[2][2][4][2], const Unit& u, int wr, int wc, int fr, int fq) const {
        const int b = u.pn >> 3, pn = u.pn & 7;
        const int row0 = u.pm * 256 + wr * 64 + fr, col0 = pn * 256 + wc * 32 + fq * 8;
        float* sp = scr + (size_t)blockIdx.x * 65536 + threadIdx.x * 4;
        const bf16_t* zp = Z + ((size_t)b * TT + row0) * 2048 + col0;
        bf16_t* mp = M + (size_t)row0 * 2048 + col0;
        const float* bp = bias + b * 2048 + col0;
        if (b == 0) run<0>(acc, zp, bp, sp, mp); else if (b == 1) run<1>(acc, zp, bp, sp, mp); else run<2>(acc, zp, bp, sp, mp);
    }
};
struct EpiF32 {
    static constexpr bool PERM = false, AFTER_DRAIN = false;
    float* C; int ldc;
    DI void operator()(const f32x4 (&acc)[2][2][4][2], const Unit& u, int wr, int wc, int fr, int fq) const {
        const int row0 = u.pm * 256 + wr * 64 + fr, col0 = u.pn * 256 + wc * 32 + 4 * fq;
#pragma unroll
        for (int ai = 0; ai < 2; ++ai)
#pragma unroll
            for (int m = 0; m < 4; ++m) { float* rowp = C + (size_t)(row0 + ai * 128 + m * 16) * ldc + col0;
#pragma unroll
                for (int bj = 0; bj < 2; ++bj)
#pragma unroll
                    for (int n = 0; n < 2; ++n) *(f32x4*)(rowp + bj * 128 + n * 16) = acc[ai][bj][m][n]; }
    }
};

template <class CM> DI void cvt_transpose(float* tile, const float* src, size_t ld_src, int K, int Ndst, bf16_t* dst, CM cm, int bid, int nblk) {
    int tid_l = threadIdx.x; asm volatile("" : "+v"(tid_l)); const int tid = tid_l, nkt = K >> 6, ntile = nkt * (Ndst >> 6);
    const int j = tid & 63, kb = tid >> 6;
    float cur[8];
    auto ld = [&](int t) { const int k0 = (t % nkt) << 6, n0 = (t / nkt) << 6; const int sc = cm(n0 + j);
#pragma unroll
        for (int i = 0; i < 8; ++i) cur[i] = (sc >= 0) ? src[(size_t)(k0 + kb + 8 * i) * ld_src + sc] : 0.f; };
    int t = bid;
    if (t < ntile) ld(t);
    for (; t < ntile; t += nblk) {
        const int k0 = (t % nkt) << 6, n0 = (t / nkt) << 6;
        __syncthreads();
#pragma unroll
        for (int i = 0; i < 8; ++i) tile[(kb + 8 * i) * 65 + j] = cur[i];
        __syncthreads();
        if (t + nblk < ntile) ld(t + nblk);
        { const int kk = (tid & 7) * 8, nb = tid >> 3;
          float v[8];
#pragma unroll
          for (int i = 0; i < 8; ++i) v[i] = tile[(kk + i) * 65 + nb];
          *(uint4*)(dst + (size_t)(n0 + nb) * K + k0 + kk) = pack8(v); }
    }
}

DI void row_pass(const float* xin, const bf16_t* t1, const float* g1, float* xout, const float* g2, bf16_t* nout, int bid, int nblk) {
    int tid_l = threadIdx.x; asm volatile("" : "+v"(tid_l)); const int lane = tid_l & 63, w = tid_l >> 6;
    for (int row = bid * 8 + w; row < TT; row += nblk * 8) {
        f32x4 xv[8], tv[8]; float ss = 0.f;
#pragma unroll
        for (int i = 0; i < 8; ++i) { { const uint2 tb = *(const uint2*)(t1 + (size_t)row * DM + i * 256 + lane * 4); tv[i] = (f32x4){__uint_as_float(tb.x << 16), __uint_as_float(tb.x & 0xffff0000u), __uint_as_float(tb.y << 16), __uint_as_float(tb.y & 0xffff0000u)}; } xv[i] = *(const f32x4*)(xin + (size_t)row * DM + i * 256 + lane * 4);
            ss += tv[i][0] * tv[i][0] + tv[i][1] * tv[i][1] + tv[i][2] * tv[i][2] + tv[i][3] * tv[i][3]; }
        ss = wave_sum(ss); const float rs = rsqrtf(ss * (1.f / DM) + 1e-6f);
        float s2 = 0.f;
#pragma unroll
        for (int i = 0; i < 8; ++i) { const f32x4 gg = *(const f32x4*)(g1 + i * 256 + lane * 4); xv[i] += tv[i] * rs * gg; *(f32x4*)(xout + (size_t)row * DM + i * 256 + lane * 4) = xv[i];
            s2 += xv[i][0] * xv[i][0] + xv[i][1] * xv[i][1] + xv[i][2] * xv[i][2] + xv[i][3] * xv[i][3]; }
        if (nout) {
            s2 = wave_sum(s2); const float r2 = rsqrtf(s2 * (1.f / DM) + 1e-6f);
#pragma unroll
            for (int i = 0; i < 8; ++i) { const f32x4 gg = *(const f32x4*)(g2 + i * 256 + lane * 4); const f32x4 v = xv[i] * r2 * gg; uint2 o; o.x = pack2(v[0], v[1]); o.y = pack2(v[2], v[3]);
                *(uint2*)(nout + (size_t)row * DM + i * 256 + lane * 4) = o; }
        }
    }
}
DI void norm_pass(const float* xin, const float* g, bf16_t* nout, int bid, int nblk) {
    int tid_l = threadIdx.x; asm volatile("" : "+v"(tid_l)); const int lane = tid_l & 63, w = tid_l >> 6;
    for (int row = bid * 8 + w; row < TT; row += nblk * 8) {
        f32x4 xv[8]; float ss = 0.f;
#pragma unroll
        for (int i = 0; i < 8; ++i) { xv[i] = *(const f32x4*)(xin + (size_t)row * DM + i * 256 + lane * 4); ss += xv[i][0] * xv[i][0] + xv[i][1] * xv[i][1] + xv[i][2] * xv[i][2] + xv[i][3] * xv[i][3]; }
        ss = wave_sum(ss); const float rs = rsqrtf(ss * (1.f / DM) + 1e-6f);
#pragma unroll
        for (int i = 0; i < 8; ++i) { const f32x4 gg = *(const f32x4*)(g + i * 256 + lane * 4); const f32x4 v = xv[i] * rs * gg; uint2 o; o.x = pack2(v[0], v[1]); o.y = pack2(v[2], v[3]);
            *(uint2*)(nout + (size_t)row * DM + i * 256 + lane * 4) = o; }
    }
}

DI void rwkv_shift(const bf16_t* PR, const float* mu, bf16_t* Dr, bf16_t* Dk, bf16_t* Dv, bf16_t* AL, int gtid, int gthreads) {
    const int NCH = 432;
    for (size_t idx = gtid; idx < (size_t)TT * NCH; idx += gthreads) {
        const int tok = (int)(idx / NCH), ch = (int)(idx % NCH);
        if (ch >= 420) { *(uint4*)(AL + (size_t)tok * 384 + 288 + (ch - 420) * 8) = make_uint4(0, 0, 0, 0); continue; }
        const int j = ch * 8;
        float p[8], q[8], v[8];
        unpack8(*(const uint4*)(PR + (size_t)tok * LDPR + j), p);
        if ((tok & (SEQ - 1)) != 0) unpack8(*(const uint4*)(PR + (size_t)(tok - 1) * LDPR + j), q);
        else {
#pragma unroll
            for (int e = 0; e < 8; ++e) q[e] = 0.f; }
        const f32x4 m0 = *(const f32x4*)(mu + j), m1 = *(const f32x4*)(mu + j + 4);
#pragma unroll
        for (int e = 0; e < 8; ++e) v[e] = p[e] + (q[e] - p[e]) * (e < 4 ? m0[e] : m1[e - 4]);
        bf16_t* dst;
        if (j < 1024) dst = Dr + (size_t)tok * 1024 + j;
        else if (j < 2048) dst = Dk + (size_t)tok * 1024 + (j - 1024);
        else if (j < 3072) dst = Dv + (size_t)tok * 1024 + (j - 2048);
        else {
            dst = AL + (size_t)tok * 384 + (j - 3072);
            if (j < 3136) {
#pragma unroll
                for (int e = 0; e < 8; ++e) { const float ex = __expf(2.f * v[e]); v[e] = 1.f - 2.f / (ex + 1.f); } }
            else if (j >= 3200) {
#pragma unroll
                for (int e = 0; e < 8; ++e) v[e] = sigmoidf_(v[e]); }
        }
        *(uint4*)dst = pack8(v);
    }
}

DI void build_cmpa(const bf16_t* QK, const float* pe, bf16_t* CMPA, int gtid, int gthreads) {
    for (size_t idx = gtid; idx < (size_t)4096 * 512; idx += gthreads) {
        const int R = (int)(idx >> 9), ch = (int)(idx & 511);
        const int kv = R >> 11, rr = R & 2047, b = rr >> 9, c = (rr & 511) >> 1, g = rr & 1;
        const int i = ch >> 4, d = (ch & 15) * 8;
        uint4 o = make_uint4(0, 0, 0, 0);
        if (c < 255) {
            float v[8]; unpack8(*(const uint4*)(QK + (size_t)(b * SEQ + 16 * c + i) * 4096 + 1024 + kv * 256 + g * 128 + d), v);
            const float* pp = pe + (size_t)kv * 4096 + i * 128 + d;
            const f32x4 p0 = *(const f32x4*)pp, p1 = *(const f32x4*)(pp + 4);
#pragma unroll
            for (int e = 0; e < 4; ++e) { v[e] += p0[e]; v[4 + e] += p1[e]; }
            o = pack8(v);
        }
        *(uint4*)(CMPA + (size_t)R * 4096 + ch * 8) = o;
    }
}

DI void rwkv_prep(const bf16_t* Dr, bf16_t* Dk, bf16_t* Dkk, bf16_t* Dka, const float* k_k, const float* k_a, const float* r_k, float* BON, const float* WRAW, const float* w0, const float* a0, _Float16* Dw, int gtid, int gthreads) {
    for (size_t idx = gtid; idx < (size_t)TT * 128; idx += gthreads) {
        const size_t off = idx * 8; const int col = (int)(off & 1023);
        float k[8], a[8], r[8], kk[8], kp[8], ka[8];
        unpack8(*(const uint4*)(Dk + off), k); unpack8(*(const uint4*)(Dka + off), a); unpack8(*(const uint4*)(Dr + off), r);
        { f16x4 h0, h1; const f32x4 wr0 = *(const f32x4*)(WRAW + off), wr1 = *(const f32x4*)(WRAW + off + 4);
#pragma unroll
          for (int e = 0; e < 4; ++e) { h0[e] = (_Float16)(__expf(-0.6065306597126334f * sigmoidf_(wr0[e] + w0[col + e])) - 1.0f); h1[e] = (_Float16)(__expf(-0.6065306597126334f * sigmoidf_(wr1[e] + w0[col + 4 + e])) - 1.0f); }
          *(f16x4*)(Dw + off) = h0; *(f16x4*)(Dw + off + 4) = h1; }
#pragma unroll
        for (int e = 0; e < 8; ++e) a[e] = sigmoidf_(a[e] + a0[col + e]);
        float ss = 0.f, bs = 0.f;
#pragma unroll
        for (int e = 0; e < 8; ++e) { kk[e] = k[e] * k_k[col + e]; ss += kk[e] * kk[e]; kp[e] = k[e] * (1.f + (a[e] - 1.f) * k_a[col + e]); bs += r[e] * kp[e] * r_k[col + e]; }
        ss += __shfl_xor(ss, 1); ss += __shfl_xor(ss, 2); ss += __shfl_xor(ss, 4);
        bs += __shfl_xor(bs, 1); bs += __shfl_xor(bs, 2); bs += __shfl_xor(bs, 4);
        const float inv = 1.f / fmaxf(sqrtf(ss), 1e-12f);
#pragma unroll
        for (int e = 0; e < 8; ++e) { kk[e] *= inv; ka[e] = kk[e] * a[e]; }
        *(uint4*)(Dk + off) = pack8(kp); *(uint4*)(Dkk + off) = pack8(kk); *(uint4*)(Dka + off) = pack8(ka);
        if ((idx & 7) == 0) BON[idx >> 3] = bs;
    }
}

DI void rwkv_final(const float* YRAW, const bf16_t* Dv, const float* BON, const float* lw, const float* lb, bf16_t* Y3R, int gtid, int gthreads) {
    for (size_t idx = gtid; idx < (size_t)TT * 128; idx += gthreads) {
        const size_t off = idx * 8; const int col = (int)(off & 1023);
        const f32x4 y0 = *(const f32x4*)(YRAW + off), y1 = *(const f32x4*)(YRAW + off + 4);
        float y[8] = {y0[0], y0[1], y0[2], y0[3], y1[0], y1[1], y1[2], y1[3]};
        float s = 0.f;
#pragma unroll
        for (int e = 0; e < 8; ++e) s += y[e];
        s += __shfl_xor(s, 1); s += __shfl_xor(s, 2); s += __shfl_xor(s, 4);
        const float mean = s * (1.f / 64.f);
        float vs = 0.f;
#pragma unroll
        for (int e = 0; e < 8; ++e) { y[e] -= mean; vs += y[e] * y[e]; }
        vs += __shfl_xor(vs, 1); vs += __shfl_xor(vs, 2); vs += __shfl_xor(vs, 4);
        const float rs = rsqrtf(vs * (1.f / 64.f) + 64e-5f);
        float v[8], g[8], o[8]; unpack8(*(const uint4*)(Dv + off), v); unpack8(*(const uint4*)(Y3R + off), g);
        const float bon = BON[idx >> 3];
#pragma unroll
        for (int e = 0; e < 8; ++e) o[e] = (y[e] * rs * lw[col + e] + lb[col + e] + bon * v[e]) * g[e];
        *(uint4*)(Y3R + off) = pack8(o);
    }
}

#define MFMA16(a, b, c) __builtin_amdgcn_mfma_f32_16x16x32_bf16((a), (b), (c), 0, 0, 0)
constexpr int KPITCH = 288, VPITCH = 160, KTILE_B = 64 * KPITCH;
constexpr int DSTAGE = 2 * KTILE_B + 256 * VPITCH, NSTAGE = KTILE_B + 128 * VPITCH;

typedef unsigned u32x2_t __attribute__((ext_vector_type(2)));
DI float xrow_max(float x) {
    u32x2_t r = __builtin_amdgcn_permlane16_swap(__float_as_uint(x), __float_as_uint(x), false, false);
    x = fmaxf(__uint_as_float(r[0]), __uint_as_float(r[1]));
    r = __builtin_amdgcn_permlane32_swap(__float_as_uint(x), __float_as_uint(x), false, false);
    return fmaxf(__uint_as_float(r[0]), __uint_as_float(r[1]));
}
DI float xrow_sum(float x) {
    u32x2_t r = __builtin_amdgcn_permlane16_swap(__float_as_uint(x), __float_as_uint(x), false, false);
    x = __uint_as_float(r[0]) + __uint_as_float(r[1]);
    r = __builtin_amdgcn_permlane32_swap(__float_as_uint(x), __float_as_uint(x), false, false);
    return __uint_as_float(r[0]) + __uint_as_float(r[1]);
}
DI void qk_tile(const LAS unsigned char* Kt, const bf16x8 (&qf)[4], f32x4 (&s)[4], int lane) {
    const LAS unsigned char* kp = Kt + (lane & 15) * KPITCH + (lane >> 4) * 16;
    bf16x8 ka[4], kb[4];
#pragma unroll
    for (int ks = 0; ks < 4; ++ks) ka[ks] = *(const LAS bf16x8*)(kp + ks * 64);
#pragma unroll
    for (int sub = 0; sub < 4; ++sub) {
        if (sub < 3) {
#pragma unroll
            for (int ks = 0; ks < 4; ++ks) kb[ks] = *(const LAS bf16x8*)(kp + (sub + 1) * 16 * KPITCH + ks * 64);
        }
        __builtin_amdgcn_sched_barrier(0);
        f32x4 a = {0.f, 0.f, 0.f, 0.f};
#pragma unroll
        for (int ks = 0; ks < 4; ++ks) a = MFMA16(ka[ks], qf[ks], a);
        s[sub] = a;
        __builtin_amdgcn_sched_barrier(0);
        if (sub < 3) {
#pragma unroll
            for (int ks = 0; ks < 4; ++ks) ka[ks] = kb[ks];
        }
    }
}
template <int DVT, bool MASKED, class MaskFn> DI void softmax_pv(const LAS unsigned char* Vt, f32x4 (&s)[4], f32x4 (&o)[DVT], float& m, float& l, MaskFn valid, int lane, bool need_mask = true) {
    const int quad = lane >> 4, dv = lane & 15;
    bf16x8 vpre[4];
    { const LAS unsigned char* vp0 = Vt + dv * VPITCH + quad * 16;
#pragma unroll
      for (int i = 0; i < 4; ++i) vpre[i] = *(const LAS bf16x8*)(vp0 + i * 16 * VPITCH); }
    __builtin_amdgcn_sched_barrier(0);
    if (MASKED && need_mask) {
#pragma unroll
        for (int sub = 0; sub < 4; ++sub)
#pragma unroll
            for (int j = 0; j < 4; ++j) s[sub][j] = valid(sub * 16 + quad * 4 + j) ? s[sub][j] : -INFINITY;
    }
    float mx = fmaxf(fmaxf(s[0][0], s[0][1]), fmaxf(s[0][2], s[0][3]));
#pragma unroll
    for (int sub = 1; sub < 4; ++sub) mx = fmaxf(fmaxf(fmaxf(mx, s[sub][0]), fmaxf(s[sub][1], s[sub][2])), s[sub][3]);
    mx = fmaxf(mx, __shfl_xor(mx, 16)); mx = fmaxf(mx, __shfl_xor(mx, 32));
    const float mn = fmaxf(m, mx * SC_LOG2E);
    if (__any(mn > m)) {
        const float alpha = __builtin_amdgcn_exp2f(m - mn);
        m = mn; l *= alpha;
#pragma unroll
        for (int t = 0; t < DVT; ++t) o[t] *= alpha;
    }
    const float nm = -m;
    float ps = 0.f;
#pragma unroll
    for (int sub = 0; sub < 4; ++sub)
#pragma unroll
        for (int j = 0; j < 4; ++j) { const float p = __builtin_amdgcn_exp2f(__builtin_fmaf(s[sub][j], SC_LOG2E, nm)); s[sub][j] = p; ps += p; }
    l += ps;
#pragma unroll
    for (int k2 = 0; k2 < 2; ++k2) {
        union { unsigned u[4]; bf16x8 v; } pb;
        pb.u[0] = pack2(s[2 * k2][0], s[2 * k2][1]); pb.u[1] = pack2(s[2 * k2][2], s[2 * k2][3]);
        pb.u[2] = pack2(s[2 * k2 + 1][0], s[2 * k2 + 1][1]); pb.u[3] = pack2(s[2 * k2 + 1][2], s[2 * k2 + 1][3]);
        const LAS unsigned char* vp = Vt + dv * VPITCH + (k2 * 32 + quad * 8) * 2;
        bf16x8 va[4], vb[4];
#pragma unroll
        for (int i = 0; i < 4; ++i) va[i] = (k2 == 0) ? vpre[i] : *(const LAS bf16x8*)(vp + i * 16 * VPITCH);
#pragma unroll
        for (int g = 0; g < DVT / 4; ++g) {
            if (g + 1 < DVT / 4) {
#pragma unroll
                for (int i = 0; i < 4; ++i) vb[i] = *(const LAS bf16x8*)(vp + ((g + 1) * 4 + i) * 16 * VPITCH);
            }
            __builtin_amdgcn_sched_barrier(0);
#pragma unroll
            for (int i = 0; i < 4; ++i) o[g * 4 + i] = MFMA16(va[i], pb.v, o[g * 4 + i]);
            __builtin_amdgcn_sched_barrier(0);
            if (g + 1 < DVT / 4) {
#pragma unroll
                for (int i = 0; i < 4; ++i) va[i] = vb[i];
            }
        }
    }
}
DI void ldk(uint4 (&r)[2], const bf16_t* src, size_t ld, int tid) {
#pragma unroll
    for (int i = 0; i < 2; ++i) { const int c = tid + 512 * i; r[i] = *(const uint4*)(src + (size_t)(c >> 4) * ld + (c & 15) * 8); }
}
DI void stk(LAS unsigned char* Kt, const uint4 (&r)[2], int tid) {
#pragma unroll
    for (int i = 0; i < 2; ++i) { const int c = tid + 512 * i; *(LAS pg8::u32x4*)(Kt + (c >> 4) * KPITCH + (c & 15) * 16) = (pg8::u32x4){r[i].x, r[i].y, r[i].z, r[i].w}; }
}
template <int NCH> DI void ldv(uint4 (&r)[NCH], const bf16_t* src, size_t ld, int tid) {
#pragma unroll
    for (int i = 0; i < NCH; ++i) { const int c = tid + 512 * i; r[i] = *(const uint4*)(src + (size_t)(c >> 3) * ld + (c & 7) * 8); }
}
template <int NCH> DI void stv(LAS unsigned char* Vt, const uint4 (&r)[NCH], int tid) {
#pragma unroll
    for (int i = 0; i < NCH; ++i) { const int c = tid + 512 * i; const int ch = c & 7, lc = ch & 3;
        LAS unsigned char* p = Vt + (c >> 3) * VPITCH + ((ch >> 2) * 32 + 16 * (lc & 1) + 4 * (lc >> 1)) * 2;
        typedef unsigned u32x2 __attribute__((ext_vector_type(2)));
        *(LAS u32x2*)p = (u32x2){r[i].x, r[i].y}; *(LAS u32x2*)(p + 16) = (u32x2){r[i].z, r[i].w}; }
}


template <class R, class NextFn, class LoadFn, class StoreFn, class ComputeFn>
DI void tile_pipeline(NextFn next, LoadFn load, StoreFn store, ComputeFn compute) {
    R A, B;
    int tA = next(), tB = (tA >= 0) ? next() : -1;
    if (tA >= 0) load(A, tA);
    if (tB >= 0) load(B, tB);
    __syncthreads();
    if (tA >= 0) store(A, 0);
    __syncthreads();
    while (tA >= 0) {
        const int tC = (tB >= 0) ? next() : -1;
        if (tC >= 0) load(A, tC);
        if (tB >= 0) store(B, 1);
        compute(tA, 0);
        __syncthreads();
        if (tB < 0) break;
        const int tD = (tC >= 0) ? next() : -1;
        if (tD >= 0) load(B, tD);
        if (tC >= 0) store(A, 0);
        compute(tB, 1);
        __syncthreads();
        tA = tC; tB = tD;
    }
}
struct RegsKV { uint4 k[2], v[2]; };
struct RegsK { uint4 k[2]; };
struct RegsD { uint4 k0[2], k1[2], v[4]; };

DI void diff_unit(const bf16_t* QK, const bf16_t* VT, const float* subln, float lam_full, float out_scale, bf16_t* Y, int b, int h, int qt, LAS unsigned char* lds) {
    int tid_l = threadIdx.x; asm volatile("" : "+v"(tid_l)); const int tid = tid_l, lane = tid & 63, w = tid >> 6, mm = w >> 2, quad = lane >> 4;
    const int q0 = qt * 64, t = q0 + (w & 3) * 16 + (lane & 15);
    LAS unsigned char* K0 = lds; LAS unsigned char* Vt = lds + 2 * KTILE_B;
    bf16x8 qf[4];
    { const bf16_t* qp = QK + (size_t)(b * SEQ + t) * 4096 + 2048 + (h * 2 + mm) * 128 + quad * 8;
#pragma unroll
      for (int ks = 0; ks < 4; ++ks) qf[ks] = *(const bf16x8*)(qp + ks * 32); }
    f32x4 o[16];
#pragma unroll
    for (int i = 0; i < 16; ++i) o[i] = (f32x4){0.f, 0.f, 0.f, 0.f};
    float m = -1e30f, l = 0.f;
    const bf16_t* kbase = QK + (size_t)b * SEQ * 4096 + 3072 + h * 256;
    const bf16_t* vbase = VT + (size_t)(b * 1536 + 512 + h * 256) * SEQ;
    { int jn = 0;
      tile_pipeline<RegsD>(
        [&]() { return (jn <= qt) ? jn++ : -1; },
        [&](RegsD& R, int j) { const bf16_t* kp = kbase + (size_t)j * 64 * 4096; ldk(R.k0, kp, 4096, tid); ldk(R.k1, kp + 128, 4096, tid); ldv<4>(R.v, vbase + j * 64, SEQ, tid); },
        [&](RegsD& R, int bf) { stk(K0 + bf * DSTAGE, R.k0, tid); stk(K0 + bf * DSTAGE + KTILE_B, R.k1, tid); stv<4>(Vt + bf * DSTAGE, R.v, tid); },
        [&](int j, int bf) { f32x4 s[4]; qk_tile(K0 + bf * DSTAGE + mm * KTILE_B, qf, s, lane); const int kb = j * 64;
                     softmax_pv<16, true>(Vt + bf * DSTAGE, s, o, m, l, [&](int kidx) { return kb + kidx <= t; }, lane, j == qt); }); }
    l += __shfl_xor(l, 16); l += __shfl_xor(l, 32);
    const float inv = 1.f / l;
    __syncthreads();
    float* xb = (float*)lds;
    if (mm == 1) {
#pragma unroll
        for (int i = 0; i < 16; ++i) *(f32x4*)(xb + ((size_t)((w & 3) * 16 + (lane & 15)) * 256 + i * 16 + quad * 4)) = o[i] * (inv * lam_full);
    }
    __syncthreads();
    if (mm == 0) {
        float ss = 0.f;
#pragma unroll
        for (int i = 0; i < 16; ++i) { const f32x4 o1 = *(const f32x4*)(xb + ((size_t)((w & 3) * 16 + (lane & 15)) * 256 + i * 16 + quad * 4));
            o[i] = o[i] * inv - o1; ss += o[i][0] * o[i][0] + o[i][1] * o[i][1] + o[i][2] * o[i][2] + o[i][3] * o[i][3]; }
        ss += __shfl_xor(ss, 16); ss += __shfl_xor(ss, 32);
        const float rs = rsqrtf(ss * (1.f / 256.f) + 1e-5f) * out_scale;
        bf16_t* yp = Y + (size_t)(b * SEQ + t) * 1024 + h * 256 + quad * 4;
#pragma unroll
        for (int i = 0; i < 16; ++i) { const f32x4 g = *(const f32x4*)(subln + i * 16 + quad * 4); const f32x4 v = o[i] * rs * g; uint2 pk; pk.x = pack2(v[0], v[1]); pk.y = pack2(v[2], v[3]); *(uint2*)(yp + i * 16) = pk; }
    }
    __syncthreads();
}

DI void nsa_unit(const bf16_t* QK, const bf16_t* VT, const bf16_t* KC, const bf16_t* VCT, const float* G, bf16_t* Y, int b, int g, int qt, LAS unsigned char* lds) {
    int tid_l = threadIdx.x; asm volatile("" : "+v"(tid_l)); const int tid = tid_l, lane = tid & 63, w = tid >> 6, hh = w >> 1, quad = lane >> 4;
    const int q0 = qt * 32, ql = (w & 1) * 16 + (lane & 15), t = q0 + ql;
    LAS unsigned char* Kt = lds; LAS unsigned char* Vt = lds + KTILE_B;
    float* impA = (float*)(lds + 2 * NSTAGE);
    float* impB = impA + 4 * 32 * 64;
    unsigned long long* selm = (unsigned long long*)(impB + 4 * 32 * 64);
    const size_t tok = (size_t)b * SEQ + t;
    bf16x8 qf[4];
    { const bf16_t* qp = QK + tok * 4096 + (g * 4 + hh) * 128 + quad * 8;
#pragma unroll
      for (int ks = 0; ks < 4; ++ks) qf[ks] = *(const bf16x8*)(qp + ks * 32); }
    const float* gp = G + tok * 32 + (g * 4 + hh) * 3;
    const float g0 = sigmoidf_(gp[0]), g1 = sigmoidf_(gp[1]), g2 = sigmoidf_(gp[2]);
    f32x4 out[8];
#pragma unroll
    for (int i = 0; i < 8; ++i) out[i] = (f32x4){0.f, 0.f, 0.f, 0.f};
    for (int i = tid; i < 2 * 4 * 32 * 64; i += 512) impA[i] = 0.f;
    f32x4 o[8];
    float m, l;
    const int ntc = (q0 >> 10) + 1;
    const bf16_t* kcb = KC + (size_t)(b * 2 + g) * 256 * 128;
    const bf16_t* vcb = VCT + (size_t)(b * 2 + g) * 128 * 256;
#pragma unroll
    for (int i = 0; i < 8; ++i) o[i] = (f32x4){0.f, 0.f, 0.f, 0.f};
    m = -1e30f; l = 0.f;
    { int jn = 0;
      tile_pipeline<RegsKV>(
        [&]() { return (jn < ntc) ? jn++ : -1; },
        [&](RegsKV& R, int j) { ldk(R.k, kcb + (size_t)j * 64 * 128, 128, tid); ldv<2>(R.v, vcb + j * 64, 256, tid); },
        [&](RegsKV& R, int bf) { stk(Kt + bf * NSTAGE, R.k, tid); stv<2>(Vt + bf * NSTAGE, R.v, tid); },
        [&](int j, int bf) { f32x4 s[4]; qk_tile(Kt + bf * NSTAGE, qf, s, lane); const int cb = j * 64;
                     softmax_pv<8, true>(Vt + bf * NSTAGE, s, o, m, l, [&](int kidx) { const int c = cb + kidx; return (c <= 254) && (16 * c + 31 <= t); }, lane); }); }
    l += __shfl_xor(l, 16); l += __shfl_xor(l, 32);
    const float invc = (l > 0.f) ? 1.f / l : 0.f;
#pragma unroll
    for (int i = 0; i < 8; ++i) out[i] += o[i] * (invc * g0);
    { int jn = 0;
      tile_pipeline<RegsK>(
        [&]() { return (jn < ntc) ? jn++ : -1; },
        [&](RegsK& R, int j) { ldk(R.k, kcb + (size_t)j * 64 * 128, 128, tid); },
        [&](RegsK& R, int bf) { stk(Kt + bf * NSTAGE, R.k, tid); },
        [&](int j, int bf) { f32x4 s[4]; qk_tile(Kt + bf * NSTAGE, qf, s, lane);
#pragma unroll
            for (int sub = 0; sub < 4; ++sub) {
                float p[4];
#pragma unroll
                for (int e = 0; e < 4; ++e) { const int c = j * 64 + sub * 16 + quad * 4 + e; const bool ok = (c <= 254) && (16 * c + 31 <= t);
                    p[e] = ok ? __builtin_amdgcn_exp2f(s[sub][e] * SC_LOG2E - m) * invc : 0.f; }
                const int jb = j * 16 + sub * 4 + quad;
                impA[(hh * 32 + ql) * 64 + jb] = p[0] + p[1] + p[2] + p[3];
                if (jb + 1 < 64) impB[(hh * 32 + ql) * 64 + jb + 1] = p[3];
            } }); }
    __syncthreads();
#pragma unroll 1
    for (int qi = 0; qi < 4; ++qi) {
        const int qq = w * 4 + qi, tq = q0 + qq, blk = tq >> 6;
        float v = 0.f;
#pragma unroll
        for (int h2 = 0; h2 < 4; ++h2) v += impA[(h2 * 32 + qq) * 64 + lane] + impB[(h2 * 32 + qq) * 64 + lane];
        if (lane == 0 || lane == blk || lane == blk - 1) v = 1e9f; else if (lane > blk) v = -INFINITY;
        int rank = 0;
#pragma unroll 2
        for (int jj = 0; jj < 64; ++jj) { const float o2 = __int_as_float(__builtin_amdgcn_readlane(__float_as_int(v), jj)); rank += (o2 > v || (o2 == v && jj < lane)) ? 1 : 0; }
        const unsigned long long msk = __ballot((rank < 16) && (lane <= blk));
        if (lane == 0) selm[qq] = msk;
    }
    __syncthreads();
    unsigned long long un = 0ull;
#pragma unroll 1
    for (int i = 0; i < 32; ++i) un |= selm[i];
    const unsigned long long my = selm[ql];
    {
        const bf16_t* kb = QK + (size_t)b * SEQ * 4096 + 1536 + g * 128;
        const bf16_t* vb = VT + (size_t)(b * 1536 + g * 128) * SEQ;
#pragma unroll
        for (int i = 0; i < 8; ++i) o[i] = (f32x4){0.f, 0.f, 0.f, 0.f};
        m = -1e30f; l = 0.f;
        unsigned long long rem = un;
        tile_pipeline<RegsKV>(
          [&]() { if (!rem) return -1; const int j = __builtin_ctzll(rem); rem &= rem - 1; return j; },
          [&](RegsKV& R, int j) { ldk(R.k, kb + (size_t)j * 64 * 4096, 4096, tid); ldv<2>(R.v, vb + j * 64, SEQ, tid); },
          [&](RegsKV& R, int bf) { stk(Kt + bf * NSTAGE, R.k, tid); stv<2>(Vt + bf * NSTAGE, R.v, tid); },
          [&](int j, int bf) { f32x4 s[4]; qk_tile(Kt + bf * NSTAGE, qf, s, lane); const bool sel = (my >> j) & 1ull; const int kbs = j * 64;
                       softmax_pv<8, true>(Vt + bf * NSTAGE, s, o, m, l, [&](int kidx) { return sel && (kbs + kidx <= t); }, lane, !__all(sel) || (kbs + 63 > q0)); });
        l += __shfl_xor(l, 16); l += __shfl_xor(l, 32);
        const float inv = (l > 0.f) ? 1.f / l : 0.f;
#pragma unroll
        for (int i = 0; i < 8; ++i) out[i] += o[i] * (inv * g1);
    }
    {
        const bf16_t* kb = QK + (size_t)b * SEQ * 4096 + 1792 + g * 128;
        const bf16_t* vb = VT + (size_t)(b * 1536 + 256 + g * 128) * SEQ;
#pragma unroll
        for (int i = 0; i < 8; ++i) o[i] = (f32x4){0.f, 0.f, 0.f, 0.f};
        m = -1e30f; l = 0.f;
        const int jlo = (q0 >= 511) ? ((q0 - 511) >> 6) : 0, jhi = q0 >> 6;
        { int jn = jlo;
          tile_pipeline<RegsKV>(
            [&]() { return (jn <= jhi) ? jn++ : -1; },
            [&](RegsKV& R, int j) { ldk(R.k, kb + (size_t)j * 64 * 4096, 4096, tid); ldv<2>(R.v, vb + j * 64, SEQ, tid); },
            [&](RegsKV& R, int bf) { stk(Kt + bf * NSTAGE, R.k, tid); stv<2>(Vt + bf * NSTAGE, R.v, tid); },
            [&](int j, int bf) { f32x4 s[4]; qk_tile(Kt + bf * NSTAGE, qf, s, lane); const int kbs = j * 64;
                         softmax_pv<8, true>(Vt + bf * NSTAGE, s, o, m, l, [&](int kidx) { return (unsigned)(t - (kbs + kidx)) < 512u; }, lane, (kbs + 63 > q0) || ((q0 + 31) - kbs >= 512)); }); }
        l += __shfl_xor(l, 16); l += __shfl_xor(l, 32);
        const float inv = (l > 0.f) ? 1.f / l : 0.f;
#pragma unroll
        for (int i = 0; i < 8; ++i) out[i] += o[i] * (inv * g2);
    }
    bf16_t* yp = Y + tok * 1024 + (g * 4 + hh) * 128 + quad * 4;
#pragma unroll
    for (int i = 0; i < 8; ++i) { uint2 pk; pk.x = pack2(out[i][0], out[i][1]); pk.y = pack2(out[i][2], out[i][3]); *(uint2*)(yp + i * 16) = pk; }
    __syncthreads();
}
template <int CTRL> DI float dpp_add(float x) { const int y = __builtin_amdgcn_update_dpp(0, __float_as_int(x), CTRL, 0xF, 0xF, true); return x + __int_as_float(y); }
DI float red16(float x) { x = dpp_add<0xB1>(x); x = dpp_add<0x4E>(x); x = dpp_add<0x141>(x); x = dpp_add<0x140>(x); return x; }
constexpr int SCH = 32, SBUF_F = 5 * SCH * 64 + SCH * 32;
DI void scan_unit(const bf16_t* Dr, const bf16_t* Dk, const bf16_t* Dv, const bf16_t* Dkk, const bf16_t* Dka, const _Float16* Dw, float* YRAW, int b, int h, int half, LAS unsigned char* lds) {
    int tid_l = threadIdx.x; asm volatile("" : "+v"(tid_l)); const int tid = tid_l, lane = tid & 63, w = tid >> 6;
    const int rl = w * 4 + (lane >> 4), kq = lane & 15;
    LAS float* buf = (LAS float*)lds;
    const size_t base = (size_t)b * SEQ * 1024 + h * 64;
    const int st_tok = tid >> 4, st_k = (tid & 15) * 4;
    const int sv_tok = (tid >> 3) & 31, sv_r = (tid & 7) * 4;
    uint2 g_r, g_k, g_kk, g_ka, g_w, g_v;
    auto gload = [&](int ck) {
        const size_t o = base + (size_t)(ck * SCH + st_tok) * 1024 + st_k;
        g_r = *(const uint2*)(Dr + o); g_k = *(const uint2*)(Dk + o); g_kk = *(const uint2*)(Dkk + o); g_ka = *(const uint2*)(Dka + o); g_w = *(const uint2*)(Dw + o);
        if (tid < 256) g_v = *(const uint2*)(Dv + base + (size_t)(ck * SCH + sv_tok) * 1024 + half * 32 + sv_r);
    };
    auto cvt4 = [&](const uint2& u) { f32x4 f; f[0] = __uint_as_float(u.x << 16); f[1] = __uint_as_float(u.x & 0xffff0000u); f[2] = __uint_as_float(u.y << 16); f[3] = __uint_as_float(u.y & 0xffff0000u); return f; };
    auto lstore = [&](int bi) {
        LAS float* p = buf + bi * SBUF_F + st_tok * 64 + st_k;
        *(LAS f32x4*)(p) = cvt4(g_r); *(LAS f32x4*)(p + SCH * 64) = cvt4(g_k); *(LAS f32x4*)(p + 2 * SCH * 64) = cvt4(g_kk); *(LAS f32x4*)(p + 3 * SCH * 64) = cvt4(g_ka);
        { union { uint2 u; _Float16 hh[4]; } c; c.u = g_w; f32x4 f; f[0] = 1.f + (float)c.hh[0]; f[1] = 1.f + (float)c.hh[1]; f[2] = 1.f + (float)c.hh[2]; f[3] = 1.f + (float)c.hh[3]; *(LAS f32x4*)(p + 4 * SCH * 64) = f; }
        if (tid < 256) *(LAS f32x4*)(buf + bi * SBUF_F + 5 * SCH * 64 + sv_tok * 32 + sv_r) = cvt4(g_v);
    };
    f32x4 st = {0.f, 0.f, 0.f, 0.f};
    gload(0);
    __syncthreads();
    lstore(0);
    __syncthreads();
    LAS float* ypart = buf + 2 * SBUF_F;
    float* yflush = YRAW + base + half * 32;
    for (int ck = 0; ck < SEQ / SCH; ++ck) {
        const int bi = ck & 1;
        if (ck + 1 < SEQ / SCH) gload(ck + 1);
        const LAS float* p = buf + bi * SBUF_F + kq * 4;
        const LAS float* pv = buf + bi * SBUF_F + 5 * SCH * 64 + rl;
        LAS float* yp = ypart + rl * 16 + kq;
#pragma unroll 4
        for (int tt = 0; tt < SCH; ++tt) {
            const f32x4 r4 = *(const LAS f32x4*)(p + tt * 64), k4 = *(const LAS f32x4*)(p + SCH * 64 + tt * 64), kk4 = *(const LAS f32x4*)(p + 2 * SCH * 64 + tt * 64),
                        ka4 = *(const LAS f32x4*)(p + 3 * SCH * 64 + tt * 64), w4 = *(const LAS f32x4*)(p + 4 * SCH * 64 + tt * 64);
            const float vv = pv[tt * 32];
            float dot = st[0] * kk4[0] + st[1] * kk4[1] + st[2] * kk4[2] + st[3] * kk4[3];
            dot = red16(dot);
            const float sa = -dot;
            st = st * w4 + ka4 * sa + k4 * vv;
            yp[tt * 512] = st[0] * r4[0] + st[1] * r4[1] + st[2] * r4[2] + st[3] * r4[3];
        }
        if (ck + 1 < SEQ / SCH) lstore(bi ^ 1);
        __syncthreads();
        { const int idx = tid * 2, tt = idx >> 5, r = idx & 31;
          const LAS float* ys = ypart + idx * 16;
          f32x4 a = *(const LAS f32x4*)ys + *(const LAS f32x4*)(ys + 4) + *(const LAS f32x4*)(ys + 8) + *(const LAS f32x4*)(ys + 12);
          f32x4 b2 = *(const LAS f32x4*)(ys + 16) + *(const LAS f32x4*)(ys + 20) + *(const LAS f32x4*)(ys + 24) + *(const LAS f32x4*)(ys + 28);
          *(f32x2*)(yflush + (size_t)(ck * SCH + tt) * 1024 + r) = (f32x2){(a[0] + a[1]) + (a[2] + a[3]), (b2[0] + b2[1]) + (b2[2] + b2[3])}; }
        __syncthreads();
    }
}
#define PH_BEGIN const Params* PP = &P; GAS unsigned char* wsg_ = (GAS unsigned char*)P.ws; asm volatile("" : "+s"(wsg_)); unsigned char* ws = (unsigned char*)wsg_; int tid = threadIdx.x; asm volatile("" : "+v"(tid)); int bid = blockIdx.x; asm volatile("" : "+s"(bid)); \
    const int G = gridDim.x; const int gtid = bid * 512 + tid, gthreads = G * 512; (void)gtid; (void)gthreads; (void)ws;
#define WSP(T, off) ((T*)(ws + (off)))
#define INP(i, stride) ((const float*)PP->in[i] + (size_t)L * (stride))
#define XB_TMO      128
#define XB_XCNT(j)  (256  + 64 * (j))
#define XB_XSUB(j)  (1280 + 64 * (j))
#define XB_XGEN(j)  (2304 + 64 * (j))
#define XB_TOP      3328
#define XB_TOPGEN   3392
#define XCD_BAR_WORDS 3456
#define XB_SPIN_CAP (1u << 18)

__device__ __forceinline__ unsigned xb_ld(unsigned* p)              { return __hip_atomic_load(p, __ATOMIC_RELAXED, __HIP_MEMORY_SCOPE_AGENT); }
__device__ __forceinline__ unsigned xb_add(unsigned* p, unsigned v) { return __hip_atomic_fetch_add(p, v, __ATOMIC_RELAXED, __HIP_MEMORY_SCOPE_AGENT); }
__device__ __forceinline__ unsigned xb_xcc_id() { return (unsigned)__builtin_amdgcn_s_getreg((3 << 11) | 20) & 0xFu; }
#define XB_SPIN(cond, bar) do { unsigned _sp = 0; while (cond) { __builtin_amdgcn_s_sleep(1); \
    if ((++_sp & 255u) == 0u) { if (xb_ld(&(bar)[XB_TMO])) break; if (_sp > XB_SPIN_CAP) { atomicAdd(&(bar)[XB_TMO], 1u); break; } } } } while (0)

struct XcdBarrier {
    unsigned* bar; unsigned x;
    volatile LAS unsigned* st;
};

__device__ __forceinline__ XcdBarrier xcd_barrier_post(unsigned* bar, volatile LAS unsigned* st) {
    XcdBarrier b; b.bar = bar; b.x = xb_xcc_id(); b.st = st;
    if (threadIdx.x == 0) (void)xb_add(&bar[XB_XCNT(b.x)], 1u);
    return b;
}
__device__ __forceinline__ void xcd_barrier_complete(unsigned* bar, unsigned x, unsigned& nloc, unsigned& nx) {
    const unsigned G = gridDim.x * gridDim.y * gridDim.z;
    unsigned sum, cnt, mine, sp = 0u;
    for (;;) {
        sum = 0u; cnt = 0u; mine = 0u;
#pragma unroll
        for (unsigned j = 0; j < 16; ++j) { const unsigned c = xb_ld(&bar[XB_XCNT(j)]); sum += c; cnt += (c > 0u) ? 1u : 0u; mine = (j == x) ? c : mine; }
        if (sum == G) break;
        __builtin_amdgcn_s_sleep(1);
        if ((++sp & 255u) == 0u) { if (xb_ld(&bar[XB_TMO])) break; if (sp > XB_SPIN_CAP) { atomicAdd(&bar[XB_TMO], 1u); break; } }
    }
    nloc = mine > 0u ? mine : 1u; nx = cnt > 0u ? cnt : 1u;
}

__device__ __forceinline__ void xcd_barrier(const XcdBarrier& b) {
    asm volatile("s_waitcnt vmcnt(0)" ::: "memory");
    __syncthreads();
    if (threadIdx.x == 0) {
        unsigned* bar = b.bar;
        __builtin_amdgcn_s_waitcnt(0);
        unsigned nloc = b.st[0], nx = b.st[1];
        if (nloc == 0u) { xcd_barrier_complete(bar, b.x, nloc, nx); b.st[0] = nloc; b.st[1] = nx; }
        const unsigned old = xb_add(&bar[XB_XSUB(b.x)], 1u);
        const unsigned gen = old / nloc;
        if (old + 1u == (gen + 1u) * nloc) {
            __builtin_amdgcn_fence(__ATOMIC_RELEASE, "agent");
            asm volatile("s_waitcnt vmcnt(0)" ::: "memory");
            const unsigned og = xb_add(&bar[XB_TOP], 1u);
            const unsigned tg = og / nx;
            if (og + 1u == (tg + 1u) * nx) xb_add(&bar[XB_TOPGEN], 1u);
            else XB_SPIN(xb_ld(&bar[XB_TOPGEN]) == tg, bar);
            __builtin_amdgcn_fence(__ATOMIC_ACQUIRE, "agent");
            xb_add(&bar[XB_XGEN(b.x)], 1u);
            asm volatile("s_waitcnt vmcnt(0)" ::: "memory");
        } else {
            XB_SPIN(xb_ld(&bar[XB_XGEN(b.x)]) == gen, bar);
            __builtin_amdgcn_fence(__ATOMIC_ACQUIRE, "agent");
            asm volatile("s_waitcnt vmcnt(0)" ::: "memory");
        }
    }
    __syncthreads();
}


constexpr size_t OFF_BAR = 8192;
#define GSYNC() do { XcdBarrier xb_; xb_.bar = (unsigned*)(P.ws + OFF_BAR); xb_.x = xb_xcc_id(); xb_.st = (volatile LAS unsigned*)(lds + LDS_CTLW + 64); xcd_barrier(xb_); } while (0)
template <int L> DI void layer_body(const Params& P, LAS unsigned char* lds, float* tile) {
        { PH_BEGIN
          const float* cmp_w1 = INP(8, 2 * 4096 * 256); const float* cmp_w2 = INP(9, 2 * 256 * 128);
          cvt_transpose(tile, INP(6, 2048 * 9016), 9016, 2048, NWIN, WSP(bf16_t, OFF_WIN), [](int n) { return n < 2560 ? n : (n < 8992 ? n + 24 : (n < 9016 ? n - 8992 + 2560 : -1)); }, bid, G);
          cvt_transpose(tile, cmp_w1, 256, 4096, 256, WSP(bf16_t, OFF_W1T), [](int n) { return n; }, bid, G);
          cvt_transpose(tile, cmp_w1 + (size_t)4096 * 256, 256, 4096, 256, WSP(bf16_t, OFF_W1T) + (size_t)256 * 4096, [](int n) { return n; }, bid, G);
          bf16_t* W2T = WSP(bf16_t, OFF_W2T);
          for (int i = gtid; i < 256 * 256; i += gthreads) { const int n = i >> 8, k = i & 255; W2T[i] = f2bf(cmp_w2[(size_t)(n >> 7) * 256 * 128 + (size_t)k * 128 + (n & 127)]); }
          const float* w_up_l = INP(14, 64 * 1024); const float* a_up = INP(16, 64 * 1024); const float* g_up = INP(17, 160 * 1024); bf16_t* LORA = WSP(bf16_t, OFF_LORA);
          for (int i = gtid; i < 3072 * 384; i += gthreads) {
            const int n = i / 384, k = i - n * 384, kind = n >> 10, c = n & 1023; float v = 0.f;
            if (kind == 0) { if (k < 64) v = w_up_l[(size_t)k * 1024 + c]; }
            else if (kind == 1) { if (k >= 64 && k < 128) v = a_up[(size_t)(k - 64) * 1024 + c]; }
            else { if (k >= 128 && k < 288) v = g_up[(size_t)(k - 128) * 1024 + c]; }
            LORA[i] = f2bf(v);
          }
          if (gtid == 0) { const float* dlam = INP(10, 512); const float lam_init = 0.8f - 0.6f * expf(-0.3f * (float)L);
            float s01 = 0.f, s23 = 0.f; for (int i = 0; i < 128; ++i) { s01 += dlam[i] * dlam[128 + i]; s23 += dlam[256 + i] * dlam[384 + i]; } WSP(float, OFF_MISC)[L] = expf(s01) - expf(s23) + lam_init; } }
        if (L == 0) cg::this_grid().sync(); else GSYNC();

        { PH_BEGIN
          pg8::StaticOrder S; S.init(TT, NWIN, G, bid); EpiWin E{WSP(bf16_t, OFF_QK), WSP(bf16_t, OFF_VT), WSP(float, OFF_G), WSP(bf16_t, OFF_PR), WSP(const float2, OFF_ROPE)};
          pg8::gemm_phase<EpiWin, pg8::StaticOrder>(lds, Gemm{WSP(bf16_t, OFF_U), WSP(bf16_t, OFF_WIN), TT, NWIN, 2048}, S, E, nullptr); }
        GSYNC();

        { PH_BEGIN
          bf16_t* Dr = WSP(bf16_t, OFF_D);
          rwkv_shift(WSP(bf16_t, OFF_PR), INP(12, 3360), Dr, Dr + (size_t)TT * 1024, Dr + (size_t)2 * TT * 1024, WSP(bf16_t, OFF_AL), gtid, gthreads);
          build_cmpa(WSP(bf16_t, OFF_QK), INP(7, 2 * 32 * 128), WSP(bf16_t, OFF_CMPA), gtid, gthreads); }
        GSYNC();

        { PH_BEGIN
          ListOrder S{16, G, G - 1 - bid, 0}; EpiBf<1> E{WSP(bf16_t, OFF_H), 256, 16, 1, 0};
          pg8::gemm_phase<EpiBf<1>, ListOrder>(lds, Gemm{WSP(bf16_t, OFF_CMPA), WSP(bf16_t, OFF_W1T), 4096, 512, 4096}, S, E, nullptr); }
        { PH_BEGIN
          int K384 = 384; asm volatile("" : "+s"(K384));
          if (bid < G - 16) {
          pg8::StaticOrder S; S.init(TT, 1024, G - 16, bid); EpiF32 E{WSP(float, OFF_YRAW), 1024};
          pg8::gemm_phase<EpiF32, pg8::StaticOrder>(lds, Gemm{WSP(bf16_t, OFF_AL), WSP(bf16_t, OFF_LORA), TT, 1024, K384}, S, E, nullptr); } }
        { PH_BEGIN
          int K384 = 384; asm volatile("" : "+s"(K384));
          if (bid < G - 16) {
          pg8::StaticOrder S; S.init(TT, 1024, G - 16, bid); EpiBf<0> E{WSP(bf16_t, OFF_D) + (size_t)4 * TT * 1024, 1024, 64, 4, 0};
          pg8::gemm_phase<EpiBf<0>, pg8::StaticOrder>(lds, Gemm{WSP(bf16_t, OFF_AL), WSP(bf16_t, OFF_LORA) + (size_t)1024 * 384, TT, 1024, K384}, S, E, nullptr); } }
        { PH_BEGIN
          int K384 = 384; asm volatile("" : "+s"(K384));
          if (bid < G - 16) {
          pg8::StaticOrder S; S.init(TT, 1024, G - 16, bid); EpiBf<0> E{WSP(bf16_t, OFF_PR) + (size_t)2 * TT * 1024, 1024, 64, 4, 0};
          pg8::gemm_phase<EpiBf<0>, pg8::StaticOrder>(lds, Gemm{WSP(bf16_t, OFF_AL), WSP(bf16_t, OFF_LORA) + (size_t)2048 * 384, TT, 1024, K384}, S, E, nullptr); } }
        GSYNC();

        { PH_BEGIN
          ListOrder S{8, G, bid, 1}; EpiCmp2<0> E{WSP(bf16_t, OFF_KC), WSP(bf16_t, OFF_VCT), WSP(const float2, OFF_ROPE)};
          pg8::gemm_phase<EpiCmp2<0>, ListOrder>(lds, Gemm{WSP(bf16_t, OFF_H), WSP(bf16_t, OFF_W2T), 2048, 256, 256}, S, E, nullptr); }
        { PH_BEGIN
          ListOrder S{8, G, G - 1 - bid, 1}; EpiCmp2<1> E{WSP(bf16_t, OFF_KC), WSP(bf16_t, OFF_VCT), WSP(const float2, OFF_ROPE)};
          pg8::gemm_phase<EpiCmp2<1>, ListOrder>(lds, Gemm{WSP(bf16_t, OFF_H) + (size_t)2048 * 256, WSP(bf16_t, OFF_W2T), 2048, 256, 256}, S, E, nullptr); }
        { PH_BEGIN
          bf16_t* Dr = WSP(bf16_t, OFF_D);
          rwkv_prep(Dr, Dr + (size_t)TT * 1024, Dr + (size_t)3 * TT * 1024, Dr + (size_t)4 * TT * 1024, INP(18, 1024), INP(19, 1024), INP(20, 1024), WSP(float, OFF_BON), WSP(float, OFF_YRAW), INP(13, 1024), INP(15, 1024), (_Float16*)(Dr + (size_t)5 * TT * 1024), gtid, gthreads); }
        GSYNC();

        {
            LAS int* qslot = (LAS int*)(lds + LDS_CTLW);
#ifndef DUP_F
#define DUP_F 1
#endif
            for (int rep = 0; rep < DUP_F; ++rep) { if (rep) GSYNC();
            const int myx = (int)(xb_xcc_id() & 7u);
#pragma unroll 1
            for (int qq = 0; qq < 8; ++qq) {
            const int xq = (myx + qq) & 7;
            for (;;) {
                PH_BEGIN
                __syncthreads();
                if (tid == 0) *qslot = (int)atomicAdd(WSP(unsigned, OFF_CTL) + 64 * L + 16 * rep + xq, 1u);
                __syncthreads();
                const int v = *qslot;
                if (v >= 16 + 256) break;
                bf16_t* Dr = WSP(bf16_t, OFF_D); bf16_t* Y3 = WSP(bf16_t, OFF_PR);
                if (v < 16) { const int u = xq * 16 + v;
                    scan_unit(Dr, Dr + (size_t)TT * 1024, Dr + (size_t)2 * TT * 1024, Dr + (size_t)3 * TT * 1024, Dr + (size_t)4 * TT * 1024, (const _Float16*)(Dr + (size_t)5 * TT * 1024), WSP(float, OFF_YRAW), u >> 5, (u >> 1) & 15, u & 1, lds); }
                else {
                    const int w = v - 16, r = w >> 2, k = w & 3;
                    if (k < 2) { const float lam_init = 0.8f - 0.6f * expf(-0.3f * (float)L); const int idx = 2 * xq + k;
                        diff_unit(WSP(bf16_t, OFF_QK), WSP(bf16_t, OFF_VT), INP(11, 256), WSP(float, OFF_MISC)[L], 1.f - lam_init, Y3 + (size_t)TT * 1024, idx >> 2, idx & 3, 63 - r, lds); }
                    else nsa_unit(WSP(bf16_t, OFF_QK), WSP(bf16_t, OFF_VT), WSP(bf16_t, OFF_KC), WSP(bf16_t, OFF_VCT), WSP(float, OFF_G), Y3, xq >> 1, xq & 1, 127 - 2 * r - (k - 2), lds);
                }
            }
            }
            }
        }
        GSYNC();

        { PH_BEGIN
          const float* w_gate = INP(23, 3 * 2048 * 2048); const float* w_branch = INP(25, 3 * 1024 * 2048);
#pragma unroll 1
          for (int b3 = 0; b3 < 3; ++b3) {
            cvt_transpose(tile, w_gate + (size_t)b3 * 2048 * 2048, 2048, 2048, 2048, WSP(bf16_t, OFF_WG) + (size_t)b3 * 2048 * 2048, [](int n) { return n; }, bid, G);
            cvt_transpose(tile, w_branch + (size_t)b3 * 1024 * 2048, 2048, 1024, 2048, WSP(bf16_t, OFF_WB) + (size_t)b3 * 2048 * 1024, [](int n) { return n; }, bid, G);
          }
          cvt_transpose(tile, INP(26, 2048 * 2048), 2048, 2048, 2048, WSP(bf16_t, OFF_WO), [](int n) { return n; }, bid, G);
          cvt_transpose(tile, INP(27, 2048 * 8192), 8192, 2048, 8192, WSP(bf16_t, OFF_WUP), [](int n) { return n; }, bid, G);
          cvt_transpose(tile, INP(28, 8192 * 2048), 2048, 8192, 2048, WSP(bf16_t, OFF_WDN), [](int n) { return n; }, bid, G);
          rwkv_final(WSP(float, OFF_YRAW), WSP(bf16_t, OFF_D) + (size_t)2 * TT * 1024, WSP(float, OFF_BON), INP(21, 1024), INP(22, 1024), WSP(bf16_t, OFF_PR) + (size_t)2 * TT * 1024, gtid, gthreads); }
        GSYNC();

        { PH_BEGIN
          ListOrder S{1536, G, bid, 3}; EpiBf<0> E{WSP(bf16_t, OFF_Z), 2048, 64, 8, (size_t)TT * 2048};
          pg8::gemm_phase<EpiBf<0>, ListOrder>(lds, Gemm{WSP(bf16_t, OFF_PR), WSP(bf16_t, OFF_WB), 3 * TT, 6144, 1024}, S, E, nullptr); }
        GSYNC();
        { PH_BEGIN
          ListOrder S{0, G, bid, 2}; EpiMerge E{WSP(bf16_t, OFF_Z), INP(24, 3 * 2048), WSP(float, OFF_SCR), WSP(bf16_t, OFF_MRG)};
          pg8::gemm_phase<EpiMerge, ListOrder>(lds, Gemm{WSP(bf16_t, OFF_U), WSP(bf16_t, OFF_WG), TT, 6144, 2048}, S, E, nullptr); }
        GSYNC();
        { PH_BEGIN
          pg8::StaticOrder S; S.init(TT, 2048, G, bid); EpiBf<0> E{WSP(bf16_t, OFF_T1A), 2048, 0, 0, 0};
          pg8::gemm_phase<EpiBf<0>, pg8::StaticOrder>(lds, Gemm{WSP(bf16_t, OFF_MRG), WSP(bf16_t, OFF_WO), TT, 2048, 2048}, S, E, nullptr); }
        GSYNC();
        { PH_BEGIN
          row_pass(L == 0 ? (const float*)PP->in[0] : PP->out, WSP(bf16_t, OFF_T1A), INP(3, 2048), PP->out, INP(4, 2048), WSP(bf16_t, OFF_U), bid, G); }
        GSYNC();
        { PH_BEGIN
          pg8::StaticOrder S; S.init(TT, DFF, G, bid); EpiBf<2> E{WSP(bf16_t, OFF_HID), DFF, 0, 0, 0};
          pg8::gemm_phase<EpiBf<2>, pg8::StaticOrder>(lds, Gemm{WSP(bf16_t, OFF_U), WSP(bf16_t, OFF_WUP), TT, DFF, 2048}, S, E, nullptr); }
        GSYNC();
        { PH_BEGIN
          pg8::StaticOrder S; S.init(TT, 2048, G, bid); EpiBf<0> E{WSP(bf16_t, OFF_T1B), 2048, 0, 0, 0};
          pg8::gemm_phase<EpiBf<0>, pg8::StaticOrder>(lds, Gemm{WSP(bf16_t, OFF_HID), WSP(bf16_t, OFF_WDN), TT, 2048, DFF}, S, E, nullptr); }
        GSYNC();
        { PH_BEGIN
          row_pass(PP->out, WSP(bf16_t, OFF_T1B), INP(5, 2048), PP->out, (const float*)PP->in[2] + 2048, (L == 0) ? WSP(bf16_t, OFF_U) : (bf16_t*)nullptr, bid, G); }
        GSYNC();

}

__global__ void __launch_bounds__(512, 2) fwd_megakernel(Params P) {
    extern __shared__ __attribute__((aligned(16))) unsigned char lds_raw[];
    LAS unsigned char* lds = (LAS unsigned char*)lds_raw;
    float* tile = (float*)lds_raw;
    if (threadIdx.x < 2) ((volatile LAS unsigned*)(lds + LDS_CTLW + 64))[threadIdx.x] = 0u;
    __syncthreads();
    (void)xcd_barrier_post((unsigned*)(P.ws + OFF_BAR), (volatile LAS unsigned*)(lds + LDS_CTLW + 64));
    { PH_BEGIN {
      const int* positions = (const int*)PP->in[1]; float2* ROPE = WSP(float2, OFF_ROPE);
      for (int i = gtid; i < TT * 16; i += gthreads) {
        const int tok = i >> 4, f = i & 15;
        const float inv = (float)pow(500000.0, -(double)f / 16.0);
        const float ang = (float)positions[tok] * inv;
        const double a = (double)ang; const double k = rint(a * 0.15915494309189535); const float r = (float)(a - k * 6.283185307179586);
        ROPE[i] = make_float2(__cosf(r), __sinf(r));
      }
      norm_pass((const float*)PP->in[0], (const float*)PP->in[2], WSP(bf16_t, OFF_U), bid, G); } }

    layer_body<0>(P, lds, tile);
    layer_body<1>(P, lds, tile);
}

extern "C" void kernel_launch(void* const* d_in, const int* in_sizes, int n_in, void* d_out, int out_size, void* d_ws, size_t ws_size, hipStream_t stream) {
    static int grid_blocks = 0;
    if (!grid_blocks) {
        int dev = 0, cus = 0, per_cu = 0;
        (void)hipGetDevice(&dev);
        (void)hipDeviceGetAttribute(&cus, hipDeviceAttributeMultiprocessorCount, dev);
        (void)hipFuncSetAttribute((const void*)fwd_megakernel, hipFuncAttributeMaxDynamicSharedMemorySize, LDS_BYTES);
        (void)hipOccupancyMaxActiveBlocksPerMultiprocessor(&per_cu, (const void*)fwd_megakernel, 512, LDS_BYTES);
        if (per_cu < 1) per_cu = 1;
        grid_blocks = cus * per_cu;
        if (ws_size < WS_END) fprintf(stderr, "kernel_launch: workspace too small: %zu < %zu\n", ws_size, (size_t)WS_END);
    }
    (void)hipMemsetAsync((char*)d_ws + OFF_CTL, 0, 32768, stream);
    Params p{};
    for (int k = 0; k < NIN; ++k) p.in[k] = d_in[k];
    p.out = (float*)d_out; p.ws = (unsigned char*)d_ws; p.stage = 0; p.pad = 0;
    void* args[] = {&p};
    hipError_t e = hipLaunchCooperativeKernel((const void*)fwd_megakernel, dim3(grid_blocks), dim3(512), args, LDS_BYTES, stream);
    if (e != hipSuccess) fprintf(stderr, "cooperative launch failed: %s (grid %d)\n", hipGetErrorString(e), grid_blocks);
}
```

```cpp
#include <hip/hip_runtime.h>
#include <hip/hip_cooperative_groups.h>
#include <cstdio>
#include <cstdint>
namespace cg = cooperative_groups;
#define DI __device__ __forceinline__
#define LAS __attribute__((address_space(3)))
#define GAS __attribute__((address_space(1)))
namespace pg8 {
#define PG8_LAS __attribute__((address_space(3)))
typedef unsigned short bf16_t;
typedef short bf16x8 __attribute__((ext_vector_type(8)));
typedef float f32x4 __attribute__((ext_vector_type(4)));
typedef unsigned u32x4 __attribute__((ext_vector_type(4)));
constexpr int BM = 256, BK = 64, HALF = 128, HTB = HALF * BK * 2  , STAGE_BYTES = 8 * HTB, NXCD = 8, WGM = 8;

__host__ __device__ __forceinline__ int lds_byte(int r, int c) { const int st = (r >> 4) * 2 + (c >> 5), rr = r & 15, cc = c & 31, ob = rr * 64 + cc * 2; return st * 1024 + (ob ^ (((ob >> 9) & 1) << 5)); }
__host__ __device__ __forceinline__ void stage_rc(int b, int& R, int& C) { const int st = b / 1024, sb = b % 1024, swz = sb ^ (((sb >> 9) & 1) << 5); R = (st >> 1) * 16 + swz / 64; C = (st & 1) * 32 + (swz % 64) / 2; }
__host__ __device__ __forceinline__ int perm32(int rho) { const int n = rho >> 4, i = rho & 15; return 8 * (i >> 2) + 4 * n + (i & 3); }

struct Unit { int pm, pn; };
struct Gemm { const bf16_t* A; const bf16_t* Bt; int M, N, K; };

struct StaticOrder {
    int nM, nN, nwg, G, c;
    __host__ __device__ void init(int M, int N, int G_, int c_) { nM = M / BM; nN = N / BM; nwg = nM * nN; G = G_; c = c_; }
    __host__ __device__ bool next(int i, Unit& u) const {
        const long L = (long)i * G + c; if (L >= nwg) return false;
        int wgid = (int)L; { const int q = nwg / NXCD, r = nwg % NXCD, xcd = wgid % NXCD, off = wgid / NXCD; wgid = (xcd < r ? xcd * (q + 1) : r * (q + 1) + (xcd - r) * q) + off; }
        const int nig = WGM * nN, gid = wgid / nig, fm = gid * WGM, gsz = (nM - fm) < WGM ? (nM - fm) : WGM;
        u.pm = fm + ((wgid % nig) % gsz); u.pn = (wgid % nig) / gsz; return true;
    }
    __device__ __forceinline__ void a_ready(const Unit&) const {}
    __device__ __forceinline__ void done(const Unit&) const {}
};
template <class Epi, class Sched, bool STAMP = false>
__device__ __forceinline__ void gemm_phase(PG8_LAS unsigned char* lds, const Gemm g, const Sched& S, const Epi& E, unsigned long long* stamps) {
    int tid_l = threadIdx.x; asm volatile("" : "+v"(tid_l)); const int tid = tid_l, wid = __builtin_amdgcn_readfirstlane(tid >> 6), lane = tid & 63, wr = wid >> 2, wc = wid & 3, fr = lane & 15, fq = lane >> 4;
    const int K = g.K, nt = K / BK;
    int ts_lo = 0, ts_hi = 0, nts = 0; const unsigned long long rt_entry = STAMP ? (unsigned long long)wall_clock64() : 0ull;
#define PG8_STAMP() do { if (STAMP && wid == 0 && nts < 64) { const unsigned long long _c = (unsigned long long)clock64(); \
        ts_lo = (lane == nts) ? (int)(unsigned)_c : ts_lo; ts_hi = (lane == nts) ? (int)(unsigned)(_c >> 32) : ts_hi; ++nts; } } while (0)
    PG8_STAMP();
    unsigned voffA[2], voffB[2];
#pragma unroll
    for (int i = 0; i < 2; ++i) { int R, C; stage_rc(tid * 16 + i * 8192, R, C); const int Rb = Epi::PERM ? ((R & ~31) + perm32(R & 31)) : R;
        voffA[i] = (unsigned)(R * K + C) * 2u; voffB[i] = (unsigned)(Rb * K + C) * 2u; }
    const size_t kstep = (size_t)(BK * 2);
    const size_t hstep = (size_t)HALF * K * 2;
    const size_t tstep = 2 * hstep;
    const unsigned ldsw = (unsigned)wid * 1024u;
    const int aoff = lds_byte(wr * 64 + fr, fq * 8), boff = lds_byte(wc * 32 + fr, fq * 8);
#define PG8_SA(b, h) (((b) * 2 + (h)) * HTB)
#define PG8_SB(b, h) ((4 + (b) * 2 + (h)) * HTB)
#define PG8_STAGE(bufoff, gbase, voff) do { _Pragma("unroll") for (int _i = 0; _i < 2; ++_i) \
        __builtin_amdgcn_global_load_lds((const unsigned*)((const char*)(gbase) + (voff)[_i]), (PG8_LAS unsigned*)(lds + (bufoff) + ldsw + _i * 8192), 16, 0, 0); } while (0)
#define PG8_LDA(dst, b, h) do { _Pragma("unroll") for (int m = 0; m < 4; ++m) _Pragma("unroll") for (int k = 0; k < 2; ++k) dst[m][k] = *(const PG8_LAS bf16x8*)(lds + PG8_SA(b, h) + aoff + m * 2048 + k * 1024); } while (0)
#define PG8_LDB(dst, b, h) do { _Pragma("unroll") for (int n = 0; n < 2; ++n) _Pragma("unroll") for (int k = 0; k < 2; ++k) dst[n][k] = *(const PG8_LAS bf16x8*)(lds + PG8_SB(b, h) + boff + n * 2048 + k * 1024); } while (0)
#define PG8_MMA(ai, bj, At, Bt) do { __builtin_amdgcn_s_setprio(1); _Pragma("unroll") for (int m = 0; m < 4; ++m) _Pragma("unroll") for (int n = 0; n < 2; ++n) _Pragma("unroll") for (int k = 0; k < 2; ++k) \
        acc[ai][bj][m][n] = __builtin_amdgcn_mfma_f32_16x16x32_bf16(Bt[n][k], At[m][k], acc[ai][bj][m][n], 0, 0, 0); __builtin_amdgcn_s_setprio(0); } while (0)
#define PG8_WAIT_V(n) asm volatile("s_waitcnt vmcnt(" #n ")" ::: "memory")
#define PG8_WAIT_L(n) asm volatile("s_waitcnt lgkmcnt(" #n ")" ::: "memory")
#define PG8_BAR __builtin_amdgcn_s_barrier()
#define PG8_SCHED __builtin_amdgcn_sched_barrier(0)
    Unit cur, nxt; int ui = 0;
    if (!S.next(0, cur)) return;
    f32x4 acc[2][2][4][2];
#pragma unroll
    for (int a = 0; a < 2; ++a)
#pragma unroll
        for (int b = 0; b < 2; ++b)
#pragma unroll
            for (int m = 0; m < 4; ++m)
#pragma unroll
                for (int n = 0; n < 2; ++n) acc[a][b][m][n] = (f32x4){0.f, 0.f, 0.f, 0.f};
    bf16x8 At[4][2], B0[2][2], B1[2][2];
    const char* cA = (const char*)g.A + (size_t)cur.pm * tstep; const char* cB = (const char*)g.Bt + (size_t)cur.pn * tstep;
    S.a_ready(cur);
    PG8_STAGE(PG8_SB(0, 0), cB, voffB); PG8_STAGE(PG8_SA(0, 0), cA, voffA); PG8_STAGE(PG8_SB(0, 1), cB + hstep, voffB); PG8_STAGE(PG8_SA(0, 1), cA + hstep, voffA);
    if (wr == 1) PG8_BAR;
    PG8_WAIT_V(4); PG8_BAR;
    PG8_STAGE(PG8_SB(1, 0), cB + kstep, voffB); PG8_STAGE(PG8_SA(1, 0), cA + kstep, voffA); PG8_STAGE(PG8_SB(1, 1), cB + hstep + kstep, voffB);
    PG8_WAIT_V(6); PG8_BAR;
    PG8_STAMP();
    for (;;) {
        const bool has_next = S.next(ui + 1, nxt);
        const char* nA = has_next ? (const char*)g.A + (size_t)nxt.pm * tstep : cA; const char* nB = has_next ? (const char*)g.Bt + (size_t)nxt.pn * tstep : cB;
        for (int t = 0; t < nt; t += 2) {
            const bool last = (t == nt - 2);
            const char* a1 = cA + (size_t)(t + 1) * kstep;
            const char* a2 = last ? nA : cA + (size_t)(t + 2) * kstep; const char* b2 = last ? nB : cB + (size_t)(t + 2) * kstep;
            const char* a3 = a2 + kstep; const char* b3 = b2 + kstep;
            if (last && has_next) S.a_ready(nxt);
            PG8_LDB(B0, 0, 0); PG8_SCHED; PG8_LDA(At, 0, 0); PG8_STAGE(PG8_SA(1, 1), a1 + hstep, voffA);
            PG8_WAIT_L(8); PG8_BAR; PG8_WAIT_L(0); PG8_MMA(0, 0, At, B0); PG8_BAR; PG8_SCHED;
            PG8_LDB(B1, 0, 1); PG8_STAGE(PG8_SB(0, 0), b2, voffB);
            PG8_BAR; PG8_WAIT_L(0); PG8_MMA(0, 1, At, B1); PG8_BAR;
            PG8_LDA(At, 0, 1); PG8_STAGE(PG8_SA(0, 0), a2, voffA);
            PG8_BAR; PG8_WAIT_L(0); PG8_MMA(1, 0, At, B0); PG8_BAR; PG8_SCHED;
            PG8_STAGE(PG8_SB(0, 1), b2 + hstep, voffB);
            PG8_WAIT_V(6); PG8_BAR; PG8_MMA(1, 1, At, B1); PG8_BAR;
            PG8_LDB(B0, 1, 0); PG8_SCHED; PG8_LDA(At, 1, 0); PG8_STAGE(PG8_SA(0, 1), a2 + hstep, voffA);
            PG8_WAIT_L(8); PG8_BAR; PG8_WAIT_L(0); PG8_MMA(0, 0, At, B0); PG8_BAR; PG8_SCHED;
            PG8_LDB(B1, 1, 1); PG8_STAGE(PG8_SB(1, 0), b3, voffB);
            PG8_BAR; PG8_WAIT_L(0); PG8_MMA(0, 1, At, B1); PG8_BAR;
            PG8_LDA(At, 1, 1); PG8_STAGE(PG8_SA(1, 0), a3, voffA);
            PG8_BAR; PG8_WAIT_L(0); PG8_MMA(1, 0, At, B0); PG8_BAR; PG8_SCHED;
            PG8_STAGE(PG8_SB(1, 1), b3 + hstep, voffB);
            PG8_WAIT_V(6); PG8_BAR; PG8_MMA(1, 1, At, B1); PG8_BAR;
        }
        PG8_STAMP();
        if constexpr (!Epi::AFTER_DRAIN) { E(acc, cur, wr, wc, fr, fq); S.done(cur); }
        PG8_STAMP();
        if (!has_next) break;
#pragma unroll
        for (int a = 0; a < 2; ++a)
#pragma unroll
            for (int b = 0; b < 2; ++b)
#pragma unroll
                for (int m = 0; m < 4; ++m)
#pragma unroll
                    for (int n = 0; n < 2; ++n) acc[a][b][m][n] = (f32x4){0.f, 0.f, 0.f, 0.f};
        cur = nxt; cA = nA; cB = nB; ++ui;
    }
    PG8_WAIT_V(0);
    if (wr == 0) PG8_BAR;
    PG8_BAR;
    if constexpr (Epi::AFTER_DRAIN) { E.fused(acc, cur, wr, wc, fr, fq, lds, wid, lane); S.done(cur); }
    PG8_STAMP();
    if (STAMP && wid == 0) { stamps[lane] = lane < nts ? (((unsigned long long)(unsigned)ts_hi << 32) | (unsigned)ts_lo) : 0ull;
        if (lane == 62) stamps[62] = rt_entry; if (lane == 63) stamps[63] = (unsigned long long)wall_clock64(); }
#undef PG8_STAMP
#undef PG8_SA
#undef PG8_SB
#undef PG8_STAGE
#undef PG8_LDA
#undef PG8_LDB
#undef PG8_MMA
#undef PG8_WAIT_V
#undef PG8_WAIT_L
#undef PG8_BAR
#undef PG8_SCHED
}
}
using pg8::bf16_t; using pg8::bf16x8; using pg8::f32x4; using pg8::Unit; using pg8::Gemm;
typedef short s16x4 __attribute__((ext_vector_type(4)));
typedef float f32x2 __attribute__((ext_vector_type(2)));

constexpr int NB = 4, SEQ = 4096, TT = NB * SEQ, DM = 2048, DFF = 8192;
constexpr int NWIN = 9216;
constexpr int LDPR = 3360;
constexpr int NIN = 29;
constexpr float SC_LOG2E = 0.08838834764831845f * 1.4426950408889634f;

constexpr size_t al4k(size_t x) { return (x + 4095) & ~(size_t)4095; }
constexpr size_t OFF_CTL  = 0;
constexpr size_t OFF_MISC = 65536;
constexpr size_t OFF_ROPE = 1u << 20;
constexpr size_t OFF_WIN  = OFF_ROPE + (size_t)TT * 16 * 8;
constexpr size_t OFF_W1T  = OFF_WIN + (size_t)NWIN * 2048 * 2;
constexpr size_t OFF_W2T  = OFF_W1T + (size_t)512 * 4096 * 2;
constexpr size_t OFF_LORA = OFF_W2T + (size_t)256 * 256 * 2;
constexpr size_t OFF_U    = al4k(OFF_LORA + (size_t)3072 * 384 * 2);
constexpr size_t OFF_QK   = OFF_U + (size_t)TT * 2048 * 2;
constexpr size_t OFF_VT   = OFF_QK + (size_t)TT * 4096 * 2;
constexpr size_t OFF_G    = OFF_VT + (size_t)NB * 1536 * SEQ * 2;
constexpr size_t OFF_PR   = OFF_G + (size_t)TT * 32 * 4;
constexpr size_t OFF_D    = al4k(OFF_PR + (size_t)TT * LDPR * 2);
constexpr size_t DSZ      = (size_t)TT * 1024 * 2;
constexpr size_t OFF_AL   = OFF_D + 6 * DSZ;
constexpr size_t OFF_BON  = OFF_AL + (size_t)TT * 384 * 2;
constexpr size_t OFF_CMPA = OFF_BON + (size_t)TT * 16 * 4;
constexpr size_t OFF_H    = OFF_CMPA + (size_t)4096 * 4096 * 2;
constexpr size_t OFF_KC   = OFF_H + (size_t)4096 * 256 * 2;
constexpr size_t OFF_VCT  = OFF_KC + (size_t)NB * 2 * 256 * 128 * 2;
constexpr size_t OFF_YRAW = OFF_VCT + (size_t)NB * 2 * 128 * 256 * 2;
constexpr size_t WS_END   = OFF_YRAW + (size_t)TT * 1024 * 4;
constexpr size_t OFF_WG   = OFF_QK;
constexpr size_t OFF_WB   = OFF_WG + (size_t)6144 * 2048 * 2;
constexpr size_t OFF_WO   = OFF_WB + (size_t)6144 * 1024 * 2;
constexpr size_t OFF_WUP  = OFF_WO + (size_t)2048 * 2048 * 2;
constexpr size_t OFF_WDN  = OFF_WUP + (size_t)8192 * 2048 * 2;
static_assert(OFF_WDN + (size_t)2048 * 8192 * 2 <= OFF_VT, "W2 must fit in the QK region");
constexpr size_t OFF_Z    = OFF_D;
constexpr size_t OFF_T1A  = OFF_D;
constexpr size_t OFF_HID  = OFF_D;
static_assert(OFF_HID + (size_t)TT * 8192 * 2 <= WS_END, "h must fit");
constexpr size_t OFF_T1B  = OFF_VT;
static_assert(OFF_T1B + (size_t)TT * 2048 * 4 <= OFF_D, "t1b must fit before D");
constexpr size_t OFF_MRG  = OFF_YRAW;
constexpr size_t OFF_SCR  = OFF_PR;
static_assert(OFF_SCR + (size_t)256 * 256 * 256 * 4 <= OFF_D, "scratch must fit");
constexpr int LDS_CTLW = 156672;
constexpr int LDS_BYTES = LDS_CTLW + 1024;

struct Params { const void* in[NIN]; float* out; unsigned char* ws; int stage; int pad; };

DI bf16_t f2bf(float f) { unsigned u = __float_as_uint(f); u += 0x7fffu + ((u >> 16) & 1u); return (bf16_t)(u >> 16); }
DI float bf2f(bf16_t b) { return __uint_as_float(((unsigned)b) << 16); }
typedef __bf16 bf16v2 __attribute__((ext_vector_type(2)));
DI unsigned pack2(float lo, float hi) { const f32x2 v = {lo, hi}; return __builtin_bit_cast(unsigned, __builtin_convertvector(v, bf16v2)); }
DI float sigmoidf_(float x) { return __builtin_amdgcn_rcpf(1.f + __expf(-x)); }
DI float wave_sum(float v) {
#pragma unroll
    for (int o = 32; o > 0; o >>= 1) v += __shfl_xor(v, o);
    return v;
}
DI void unpack8(const uint4& u, float (&f)[8]) {
    f[0] = __uint_as_float(u.x << 16); f[1] = __uint_as_float(u.x & 0xffff0000u);
    f[2] = __uint_as_float(u.y << 16); f[3] = __uint_as_float(u.y & 0xffff0000u);
    f[4] = __uint_as_float(u.z << 16); f[5] = __uint_as_float(u.z & 0xffff0000u);
    f[6] = __uint_as_float(u.w << 16); f[7] = __uint_as_float(u.w & 0xffff0000u);
}
DI uint4 pack8(const float (&f)[8]) { uint4 u; u.x = pack2(f[0], f[1]); u.y = pack2(f[2], f[3]); u.z = pack2(f[4], f[5]); u.w = pack2(f[6], f[7]); return u; }

struct ListOrder {
    int n, G, c, mode;
    DI bool next(int i, Unit& u) const {
        if (mode == 2) {
            const int j = i / 3, b = i - 3 * j, tile = j * G + c; if (tile >= 512) return false;
            u.pm = tile >> 3; u.pn = b * 8 + (tile & 7); return true;
        }
        const int L = i * G + c; if (L >= n) return false;
        if (mode == 0) { u.pm = L; u.pn = L >> 3; }
        else if (mode == 1) { u.pm = L; u.pn = 0; }
        else { const int b = L >> 9, tile = L & 511; u.pm = b * 64 + (tile >> 3); u.pn = b * 8 + (tile & 7); }
        return true;
    }
    DI void a_ready(const Unit&) const {}
    DI void done(const Unit&) const {}
};
struct EpiWin {
    static constexpr bool PERM = true, AFTER_DRAIN = false;
    bf16_t* QK; bf16_t* VT; float* G; bf16_t* PR; const float2* rope;
    DI void operator()(const f32x4 (&acc)[2][2][4][2], const Unit& u, int wr, int wc, int fr, int fq) const {
        const int pn = u.pn;
        const int row0 = u.pm * 256 + wr * 64 + fr;
        const bool isV = (pn == 7) || (pn == 9) || (pn >= 18 && pn <= 21);
        if (isV) {
            const int vbase = (pn == 7) ? 0 : (pn == 9) ? 256 : 512 + (pn - 18) * 256;
#pragma unroll
            for (int ai = 0; ai < 2; ++ai)
#pragma unroll
                for (int m = 0; m < 4; ++m) {
                    const int row = row0 + ai * 128 + m * 16; const int b = row >> 12, s = row & 4095;
#pragma unroll
                    for (int bj = 0; bj < 2; ++bj) {
                        const int cu = bj * 128 + wc * 32 + fq * 8;
                        bf16_t* dst = VT + ((size_t)(b * 1536 + vbase + cu) * SEQ + s);
#pragma unroll
                        for (int n = 0; n < 2; ++n)
#pragma unroll
                            for (int e = 0; e < 4; ++e) dst[(size_t)(n * 4 + e) * SEQ] = f2bf(acc[ai][bj][m][n][e]);
                    }
                }
        } else if (pn >= 22) {
#pragma unroll
            for (int ai = 0; ai < 2; ++ai)
#pragma unroll
                for (int m = 0; m < 4; ++m) {
                    const int row = row0 + ai * 128 + m * 16;
#pragma unroll
                    for (int bj = 0; bj < 2; ++bj) {
                        const int cu = bj * 128 + wc * 32 + fq * 8;
                        const f32x4 v0 = acc[ai][bj][m][0], v1 = acc[ai][bj][m][1];
                        if (pn < 35 || cu < 32) {
                            const int col = (pn - 22) * 256 + cu;
                            uint4 o; o.x = pack2(v0[0], v0[1]); o.y = pack2(v0[2], v0[3]); o.z = pack2(v1[0], v1[1]); o.w = pack2(v1[2], v1[3]);
                            *(uint4*)(PR + (size_t)row * LDPR + col) = o;
                        } else if (cu < 56) {
                            *(f32x4*)(G + (size_t)row * 32 + (cu - 32)) = v0; *(f32x4*)(G + (size_t)row * 32 + (cu - 32) + 4) = v1;
                        }
                    }
                }
        } else {
            const int qoff = (pn <= 6) ? 0 : (pn == 8) ? -256 : -512;
            const bool dorope = (wc == 0) && (pn != 4) && (pn != 5);
            const bool lowhalf = fq < 2;
#pragma unroll
            for (int ai = 0; ai < 2; ++ai)
#pragma unroll
                for (int m = 0; m < 4; ++m) {
                    const int row = row0 + ai * 128 + m * 16;
#pragma unroll
                    for (int bj = 0; bj < 2; ++bj) {
                        f32x4 v0 = acc[ai][bj][m][0], v1 = acc[ai][bj][m][1];
                        if (dorope) {
                            const float2* rp = rope + (size_t)row * 16 + (fq & 1) * 8;
#pragma unroll
                            for (int e = 0; e < 4; ++e) {
                                const float2 c0 = rp[e], c1 = rp[4 + e];
                                const float p0 = __shfl_xor(v0[e], 32), p1 = __shfl_xor(v1[e], 32);
                                v0[e] = lowhalf ? (v0[e] * c0.x - p0 * c0.y) : (v0[e] * c0.x + p0 * c0.y);
                                v1[e] = lowhalf ? (v1[e] * c1.x - p1 * c1.y) : (v1[e] * c1.x + p1 * c1.y);
                            }
                        }
                        const int col = pn * 256 + qoff + bj * 128 + wc * 32 + fq * 8;
                        uint4 o; o.x = pack2(v0[0], v0[1]); o.y = pack2(v0[2], v0[3]); o.z = pack2(v1[0], v1[1]); o.w = pack2(v1[2], v1[3]);
                        *(uint4*)(QK + (size_t)row * 4096 + col) = o;
                    }
                }
        }
    }
};

typedef _Float16 f16x4 __attribute__((ext_vector_type(4)));
DI float gelu_tanh(float x) { const float t = 0.7978845608028654f * (x + 0.044715f * x * x * x); const float e = __expf(2.f * t); const float th = 1.f - 2.f / (e + 1.f); return 0.5f * x * (1.f + th); }

template <int ACT  > struct EpiBf {
    static constexpr bool PERM = true, AFTER_DRAIN = false;
    bf16_t* O; int ldc; int pm_mod, pn_mod; size_t grp_stride;
    DI void operator()(const f32x4 (&acc)[2][2][4][2], const Unit& u, int wr, int wc, int fr, int fq) const {
        int pm = u.pm, pn = u.pn; bf16_t* base = O;
        if (pm_mod) { base += (size_t)(pm / pm_mod) * grp_stride; pm %= pm_mod; pn %= pn_mod; }
        const int row0 = pm * 256 + wr * 64 + fr, col0 = pn * 256 + wc * 32 + fq * 8;
#pragma unroll
        for (int ai = 0; ai < 2; ++ai)
#pragma unroll
            for (int m = 0; m < 4; ++m) {
                bf16_t* rowp = base + (size_t)(row0 + ai * 128 + m * 16) * ldc + col0;
#pragma unroll
                for (int bj = 0; bj < 2; ++bj) {
                    float f[8];
#pragma unroll
                    for (int e = 0; e < 4; ++e) { f[e] = acc[ai][bj][m][0][e]; f[4 + e] = acc[ai][bj][m][1][e]; }
#pragma unroll
                    for (int e = 0; e < 8; ++e) { if (ACT == 1) f[e] = gelu_tanh(f[e]); else if (ACT == 2) { const float r = fmaxf(f[e], 0.f); f[e] = r * r; } }
                    *(uint4*)(rowp + bj * 128) = pack8(f);
                }
            }
    }
};

template <int KV> struct EpiCmp2 {
    static constexpr bool PERM = false, AFTER_DRAIN = false;
    bf16_t* KC; bf16_t* VCT; const float2* rope;
    DI void operator()(const f32x4 (&acc)[2][2][4][2], const Unit& u, int wr, int wc, int fr, int fq) const {
        constexpr int kv = KV;
        const int row0 = (u.pm & 7) * 256 + wr * 64 + fr;
        if (kv == 0) {
#pragma unroll
            for (int ai = 0; ai < 2; ++ai)
#pragma unroll
                for (int m = 0; m < 4; ++m) {
                    int rr = row0 + ai * 128 + m * 16; asm volatile("" : "+v"(rr)); __builtin_amdgcn_sched_barrier(0); const int b = rr >> 9, c = (rr & 511) >> 1, g = rr & 1;
                    f32x4 v0 = acc[ai][0][m][0], v1 = acc[ai][0][m][1];
                    if (wc == 0) {
                        const int tok = b * SEQ + (c < 255 ? 16 * c + 31 : 0);
                        const float2* rp = rope + (size_t)tok * 16 + fq * 4;
#pragma unroll
                        for (int e = 0; e < 4; ++e) { const float2 cs = rp[e]; const float a = v0[e], b2 = v1[e]; v0[e] = a * cs.x - b2 * cs.y; v1[e] = b2 * cs.x + a * cs.y; }
                    }
                    bf16_t* dst = KC + ((size_t)((b * 2 + g) * 256 + c) * 128 + wc * 32 + fq * 4);
                    uint2 o; o.x = pack2(v0[0], v0[1]); o.y = pack2(v0[2], v0[3]); *(uint2*)dst = o;
                    o.x = pack2(v1[0], v1[1]); o.y = pack2(v1[2], v1[3]); *(uint2*)(dst + 16) = o;
                }
        } else {
#pragma unroll
            for (int ai = 0; ai < 2; ++ai)
#pragma unroll
                for (int m = 0; m < 4; ++m) {
                    int rr = row0 + ai * 128 + m * 16; asm volatile("" : "+v"(rr)); __builtin_amdgcn_sched_barrier(0); const int b = rr >> 9, c = (rr & 511) >> 1, g = rr & 1;
                    bf16_t* dst = VCT + (size_t)((b * 2 + g) * 128 + wc * 32 + fq * 4) * 256 + c;
#pragma unroll
                    for (int n = 0; n < 2; ++n)
#pragma unroll
                        for (int e = 0; e < 4; ++e) dst[(n * 16 + e) * 256] = f2bf(acc[ai][1][m][n][e]);
                }
        }
    }
};

struct EpiMerge {
    static constexpr bool PERM = true, AFTER_DRAIN = false;
    const bf16_t* Z; const float* bias; float* scr; bf16_t* M;
    template <int MODE> DI void run(const f32x4 (&acc)[2][2][4][2], const bf16_t* zp, const float* bp, float* sp, bf16_t* mp) const {
        typedef unsigned u32x2 __attribute__((ext_vector_type(2)));
        GAS float* s = (GAS float*)sp;
#pragma unroll
        for (int bj = 0; bj < 2; ++bj)
#pragma unroll
            for (int n = 0; n < 2; ++n) {
                const f32x4 bv = *(const f32x4*)(bp + bj * 128 + n * 4);
#pragma unroll
                for (int ai = 0; ai < 2; ++ai) {
                    GAS const bf16_t* zr = (GAS const bf16_t*)(zp + (size_t)(ai * 128) * 2048 + bj * 128 + n * 4);
                    GAS bf16_t* mr = (GAS bf16_t*)(mp + (size_t)(ai * 128) * 2048 + bj * 128 + n * 4);
                    asm volatile("" : "+v"(zr), "+v"(mr), "+v"(s));
                    u32x2 zz[4]; f32x4 pv[4];
#pragma unroll
                    for (int m = 0; m < 4; ++m) { zz[m] = *(GAS const u32x2*)(zr + (size_t)m * 16 * 2048); if (MODE > 0) pv[m] = *(GAS const f32x4*)(s + m * 2048); }
#pragma unroll
                    for (int m = 0; m < 4; ++m) {
                        f32x4 v;
                        v[0] = sigmoidf_(acc[ai][bj][m][n][0] + bv[0]) * __uint_as_float(zz[m].x << 16);
                        v[1] = sigmoidf_(acc[ai][bj][m][n][1] + bv[1]) * __uint_as_float(zz[m].x & 0xffff0000u);
                        v[2] = sigmoidf_(acc[ai][bj][m][n][2] + bv[2]) * __uint_as_float(zz[m].y << 16);
                        v[3] = sigmoidf_(acc[ai][bj][m][n][3] + bv[3]) * __uint_as_float(zz[m].y & 0xffff0000u);
                        if (MODE > 0) v += pv[m];
                        if (MODE < 2) *(GAS f32x4*)(s + m * 2048) = v;
                        else { u32x2 o; o.x = pack2(v[0], v[1]); o.y = pack2(v[2], v[3]); *(GAS u32x2*)(mr + (size_t)m * 16 * 2048) = o; }
                    }
                    s += 4 * 2048;
                }
            }
    }
    DI void operator()(const f32x4 (&acc)[2][2][4][2], const Unit& u, int wr, int wc, int fr, int fq) const {
        const int b = u.pn >> 3, pn = u.pn & 7;
        const int row0 = u.pm * 256 + wr * 64 + fr, col0 = pn * 256 + wc * 32 + fq * 8;
        float* sp = scr + (size_t)blockIdx.x * 65536 + threadIdx.x * 4;
        const bf16_t* zp = Z + ((size_t)b * TT + row0) * 2048 + col0;
        bf16_t* mp = M + (size_t)row0 * 2048 + col0;
        const float* bp = bias + b * 2048 + col0;
        if (b == 0) run<0>(acc, zp, bp, sp, mp); else if (b == 1) run<1>(acc, zp, bp, sp, mp); else run<2>(acc, zp, bp, sp, mp);
    }
};
struct EpiF32 {
    static constexpr bool PERM = false, AFTER_DRAIN = false;
    float* C; int ldc;
    DI void operator()(const f32x4 (&acc)[2][2][4][2], const Unit& u, int wr, int wc, int fr, int fq) const {
        const int row0 = u.pm * 256 + wr * 64 + fr, col0 = u.pn * 256 + wc * 32 + 4 * fq;
#pragma unroll
        for (int ai = 0; ai < 2; ++ai)
#pragma unroll
            for (int m = 0; m < 4; ++m) { float* rowp = C + (size_t)(row0 + ai * 128 + m * 16) * ldc + col0;
#pragma unroll
                for (int bj = 0; bj < 2; ++bj)
#pragma unroll
                    for (int n = 0; n < 2; ++n) *(f32x4*)(rowp + bj * 128 + n * 16) = acc[ai][bj][m][n]; }
    }
};

template <class CM> DI void cvt_transpose(float* tile, const float* src, size_t ld_src, int K, int Ndst, bf16_t* dst, CM cm, int bid, int nblk) {
    int tid_l = threadIdx.x; asm volatile("" : "+v"(tid_l)); const int tid = tid_l, nkt = K >> 6, ntile = nkt * (Ndst >> 6);
    const int j = tid & 63, kb = tid >> 6;
    float cur[8];
    auto ld = [&](int t) { const int k0 = (t % nkt) << 6, n0 = (t / nkt) << 6; const int sc = cm(n0 + j);
#pragma unroll
        for (int i = 0; i < 8; ++i) cur[i] = (sc >= 0) ? src[(size_t)(k0 + kb + 8 * i) * ld_src + sc] : 0.f; };
    int t = bid;
    if (t < ntile) ld(t);
    for (; t < ntile; t += nblk) {
        const int k0 = (t % nkt) << 6, n0 = (t / nkt) << 6;
        __syncthreads();
#pragma unroll
        for (int i = 0; i < 8; ++i) tile[(kb + 8 * i) * 65 + j] = cur[i];
        __syncthreads();
        if (t + nblk < ntile) ld(t + nblk);
        { const int kk = (tid & 7) * 8, nb = tid >> 3;
          float v[8];
#pragma unroll
          for (int i = 0; i < 8; ++i) v[i] = tile[(kk + i) * 65 + nb];
          *(uint4*)(dst + (size_t)(n0 + nb) * K + k0 + kk) = pack8(v); }
    }
}

DI void row_pass(const float* xin, const bf16_t* t1, const float* g1, float* xout, const float* g2, bf16_t* nout, int bid, int nblk) {
    int tid_l = threadIdx.x; asm volatile("" : "+v"(tid_l)); const int lane = tid_l & 63, w = tid_l >> 6;
    for (int row = bid * 8 + w; row < TT; row += nblk * 8) {
        f32x4 xv[8], tv[8]; float ss = 0.f;
#pragma unroll
        for (int i = 0; i < 8; ++i) { { const uint2 tb = *(const uint2*)(t1 + (size_t)row * DM + i * 256 + lane * 4); tv[i] = (f32x4){__uint_as_float(tb.x << 16), __uint_as_float(tb.x & 0xffff0000u), __uint_as_float(tb.y << 16), __uint_as_float(tb.y & 0xffff0000u)}; } xv[i] = *(const f32x4*)(xin + (size_t)row * DM + i * 256 + lane * 4);
            ss += tv[i][0] * tv[i][0] + tv[i][1] * tv[i][1] + tv[i][2] * tv[i][2] + tv[i][3] * tv[i][3]; }
        ss = wave_sum(ss); const float rs = rsqrtf(ss * (1.f / DM) + 1e-6f);
        float s2 = 0.f;
#pragma unroll
        for (int i = 0; i < 8; ++i) { const f32x4 gg = *(const f32x4*)(g1 + i * 256 + lane * 4); xv[i] += tv[i] * rs * gg; *(f32x4*)(xout + (size_t)row * DM + i * 256 + lane * 4) = xv[i];
            s2 += xv[i][0] * xv[i][0] + xv[i][1] * xv[i][1] + xv[i][2] * xv[i][2] + xv[i][3] * xv[i][3]; }
        if (nout) {
            s2 = wave_sum(s2); const float r2 = rsqrtf(s2 * (1.f / DM) + 1e-6f);
#pragma unroll
            for (int i = 0; i < 8; ++i) { const f32x4 gg = *(const f32x4*)(g2 + i * 256 + lane * 4); const f32x4 v = xv[i] * r2 * gg; uint2 o; o.x = pack2(v[0], v[1]); o.y = pack2(v[2], v[3]);
                *(uint2*)(nout + (size_t)row * DM + i * 256 + lane * 4) = o; }
        }
    }
}
DI void norm_pass(const float* xin, const float* g, bf16_t* nout, int bid, int nblk) {
    int tid_l = threadIdx.x; asm volatile("" : "+v"(tid_l)); const int lane = tid_l & 63, w = tid_l >> 6;
    for (int row = bid * 8 + w; row < TT; row += nblk * 8) {
        f32x4 xv[8]; float ss = 0.f;
#pragma unroll
        for (int i = 0; i < 8; ++i) { xv[i] = *(const f32x4*)(xin + (size_t)row * DM + i * 256 + lane * 4); ss += xv[i][0] * xv[i][0] + xv[i][1] * xv[i][1] + xv[i][2] * xv[i][2] + xv[i][3] * xv[i][3]; }
        ss = wave_sum(ss); const float rs = rsqrtf(ss * (1.f / DM) + 1e-6f);
#pragma unroll
        for (int i = 0; i < 8; ++i) { const f32x4 gg = *(const f32x4*)(g + i * 256 + lane * 4); const f32x4 v = xv[i] * rs * gg; uint2 o; o.x = pack2(v[0], v[1]); o.y = pack2(v[2], v[3]);
            *(uint2*)(nout + (size_t)row * DM + i * 256 + lane * 4) = o; }
    }
}

DI void rwkv_shift(const bf16_t* PR, const float* mu, bf16_t* Dr, bf16_t* Dk, bf16_t* Dv, bf16_t* AL, int gtid, int gthreads) {
    const int NCH = 432;
    for (size_t idx = gtid; idx < (size_t)TT * NCH; idx += gthreads) {
        const int tok = (int)(idx / NCH), ch = (int)(idx % NCH);
        if (ch >= 420) { *(uint4*)(AL + (size_t)tok * 384 + 288 + (ch - 420) * 8) = make_uint4(0, 0, 0, 0); continue; }
        const int j = ch * 8;
        float p[8], q[8], v[8];
        unpack8(*(const uint4*)(PR + (size_t)tok * LDPR + j), p);
        if ((tok & (SEQ - 1)) != 0) unpack8(*(const uint4*)(PR + (size_t)(tok - 1) * LDPR + j), q);
        else {
#pragma unroll
            for (int e = 0; e < 8; ++e) q[e] = 0.f; }
        const f32x4 m0 = *(const f32x4*)(mu + j), m1 = *(const f32x4*)(mu + j + 4);
#pragma unroll
        for (int e = 0; e < 8; ++e) v[e] = p[e] + (q[e] - p[e]) * (e < 4 ? m0[e] : m1[e - 4]);
        bf16_t* dst;
        if (j < 1024) dst = Dr + (size_t)tok * 1024 + j;
        else if (j < 2048) dst = Dk + (size_t)tok * 1024 + (j - 1024);
        else if (j < 3072) dst = Dv + (size_t)tok * 1024 + (j - 2048);
        else {
            dst = AL + (size_t)tok * 384 + (j - 3072);
            if (j < 3136) {
#pragma unroll
                for (int e = 0; e < 8; ++e) { const float ex = __expf(2.f * v[e]); v[e] = 1.f - 2.f / (ex + 1.f); } }
            else if (j >= 3200) {
#pragma unroll
                for (int e = 0; e < 8; ++e) v[e] = sigmoidf_(v[e]); }
        }
        *(uint4*)dst = pack8(v);
    }
}

DI void build_cmpa(const bf16_t* QK, const float* pe, bf16_t* CMPA, int gtid, int gthreads) {
    for (size_t idx = gtid; idx < (size_t)4096 * 512; idx += gthreads) {
        const int R = (int)(idx >> 9), ch = (int)(idx & 511);
        const int kv = R >> 11, rr = R & 2047, b = rr >> 9, c = (rr & 511) >> 1, g = rr & 1;
        const int i = ch >> 4, d = (ch & 15) * 8;
        uint4 o = make_uint4(0, 0, 0, 0);
        if (c < 255) {
            float v[8]; unpack8(*(const uint4*)(QK + (size_t)(b * SEQ + 16 * c + i) * 4096 + 1024 + kv * 256 + g * 128 + d), v);
            const float* pp = pe + (size_t)kv * 4096 + i * 128 + d;
            const f32x4 p0 = *(const f32x4*)pp, p1 = *(const f32x4*)(pp + 4);
#pragma unroll
            for (int e = 0; e < 4; ++e) { v[e] += p0[e]; v[4 + e] += p1[e]; }
            o = pack8(v);
        }
        *(uint4*)(CMPA + (size_t)R * 4096 + ch * 8) = o;
    }
}

DI void rwkv_prep(const bf16_t* Dr, bf16_t* Dk, bf16_t* Dkk, bf16_t* Dka, const float* k_k, const float* k_a, const float* r_k, float* BON, const float* WRAW, const float* w0, const float* a0, _Float16* Dw, int gtid, int gthreads) {
    for (size_t idx = gtid; idx < (size_t)TT * 128; idx += gthreads) {
        const size_t off = idx * 8; const int col = (int)(off & 1023);
        float k[8], a[8], r[8], kk[8], kp[8], ka[8];
        unpack8(*(const uint4*)(Dk + off), k); unpack8(*(const uint4*)(Dka + off), a); unpack8(*(const uint4*)(Dr + off), r);
        { f16x4 h0, h1; const f32x4 wr0 = *(const f32x4*)(WRAW + off), wr1 = *(const f32x4*)(WRAW + off + 4);
#pragma unroll
          for (int e = 0; e < 4; ++e) { h0[e] = (_Float16)(__expf(-0.6065306597126334f * sigmoidf_(wr0[e] + w0[col + e])) - 1.0f); h1[e] = (_Float16)(__expf(-0.6065306597126334f * sigmoidf_(wr1[e] + w0[col + 4 + e])) - 1.0f); }
          *(f16x4*)(Dw + off) = h0; *(f16x4*)(Dw + off + 4) = h1; }
#pragma unroll
        for (int e = 0; e < 8; ++e) a[e] = sigmoidf_(a[e] + a0[col + e]);
        float ss = 0.f, bs = 0.f;
#pragma unroll
        for (int e = 0; e < 8; ++e) { kk[e] = k[e] * k_k[col + e]; ss += kk[e] * kk[e]; kp[e] = k[e] * (1.f + (a[e] - 1.f) * k_a[col + e]); bs += r[e] * kp[e] * r_k[col + e]; }
        ss += __shfl_xor(ss, 1); ss += __shfl_xor(ss, 2); ss += __shfl_xor(ss, 4);
        bs += __shfl_xor(bs, 1); bs += __shfl_xor(bs, 2); bs += __shfl_xor(bs, 4);
        const float inv = 1.f / fmaxf(sqrtf(ss), 1e-12f);
#pragma unroll
        for (int e = 0; e < 8; ++e) { kk[e] *= inv; ka[e] = kk[e] * a[e]; }
        *(uint4*)(Dk + off) = pack8(kp); *(uint4*)(Dkk + off) = pack8(kk); *(uint4*)(Dka + off) = pack8(ka);
        if ((idx & 7) == 0) BON[idx >> 3] = bs;
    }
}

DI void rwkv_final(const float* YRAW, const bf16_t* Dv, const float* BON, const float* lw, const float* lb, bf16_t* Y3R, int gtid, int gthreads) {
    for (size_t idx = gtid; idx < (size_t)TT * 128; idx += gthreads) {
        const size_t off = idx * 8; const int col = (int)(off & 1023);
        const f32x4 y0 = *(const f32x4*)(YRAW + off), y1 = *(const f32x4*)(YRAW + off + 4);
        float y[8] = {y0[0], y0[1], y0[2], y0[3], y1[0], y1[1], y1[2], y1[3]};
        float s = 0.f;
#pragma unroll
        for (int e = 0; e < 8; ++e) s += y[e];
        s += __shfl_xor(s, 1); s += __shfl_xor(s, 2); s += __shfl_xor(s, 4);
        const float mean = s * (1.f / 64.f);
        float vs = 0.f;
#pragma unroll
        for (int e = 0; e < 8; ++e) { y[e] -= mean; vs += y[e] * y[e]; }
        vs += __shfl_xor(vs, 1); vs += __shfl_xor(vs, 2); vs += __shfl_xor(vs, 4);
        const float rs = rsqrtf(vs * (1.f / 64.f) + 64e-5f);
        float v[8], g[8], o[8]; unpack8(*(const uint4*)(Dv + off), v); unpack8(*(const uint4*)(Y3R + off), g);
        const float bon = BON[idx >> 3];
#pragma unroll
        for (int e = 0; e < 8; ++e) o[e] = (y[e] * rs * lw[col + e] + lb[col + e] + bon * v[e]) * g[e];
        *(uint4*)(Y3R + off) = pack8(o);
    }
}

#define MFMA16(a, b, c) __builtin_amdgcn_mfma_f32_16x16x32_bf16((a), (b), (c), 0, 0, 0)
constexpr int KPITCH = 288, VPITCH = 160, KTILE_B = 64 * KPITCH;
constexpr int DSTAGE = 2 * KTILE_B + 256 * VPITCH, NSTAGE = KTILE_B + 128 * VPITCH;

typedef unsigned u32x2_t __attribute__((ext_vector_type(2)));
DI float xrow_max(float x) {
    u32x2_t r = __builtin_amdgcn_permlane16_swap(__float_as_uint(x), __float_as_uint(x), false, false);
    x = fmaxf(__uint_as_float(r[0]), __uint_as_float(r[1]));
    r = __builtin_amdgcn_permlane32_swap(__float_as_uint(x), __float_as_uint(x), false, false);
    return fmaxf(__uint_as_float(r[0]), __uint_as_float(r[1]));
}
DI float xrow_sum(float x) {
    u32x2_t r = __builtin_amdgcn_permlane16_swap(__float_as_uint(x), __float_as_uint(x), false, false);
    x = __uint_as_float(r[0]) + __uint_as_float(r[1]);
    r = __builtin_amdgcn_permlane32_swap(__float_as_uint(x), __float_as_uint(x), false, false);
    return __uint_as_float(r[0]) + __uint_as_float(r[1]);
}
DI void qk_tile(const LAS unsigned char* Kt, const bf16x8 (&qf)[4], f32x4 (&s)[4], int lane) {
    const LAS unsigned char* kp = Kt + (lane & 15) * KPITCH + (lane >> 4) * 16;
    bf16x8 ka[4], kb[4];
#pragma unroll
    for (int ks = 0; ks < 4; ++ks) ka[ks] = *(const LAS bf16x8*)(kp + ks * 64);
#pragma unroll
    for (int sub = 0; sub < 4; ++sub) {
        if (sub < 3) {
#pragma unroll
            for (int ks = 0; ks < 4; ++ks) kb[ks] = *(const LAS bf16x8*)(kp + (sub + 1) * 16 * KPITCH + ks * 64);
        }
        __builtin_amdgcn_sched_barrier(0);
        f32x4 a = {0.f, 0.f, 0.f, 0.f};
#pragma unroll
        for (int ks = 0; ks < 4; ++ks) a = MFMA16(ka[ks], qf[ks], a);
        s[sub] = a;
        __builtin_amdgcn_sched_barrier(0);
        if (sub < 3) {
#pragma unroll
            for (int ks = 0; ks < 4; ++ks) ka[ks] = kb[ks];
        }
    }
}
template <int DVT, bool MASKED, class MaskFn> DI void softmax_pv(const LAS unsigned char* Vt, f32x4 (&s)[4], f32x4 (&o)[DVT], float& m, float& l, MaskFn valid, int lane, bool need_mask = true) {
    const int quad = lane >> 4, dv = lane & 15;
    bf16x8 vpre[4];
    { const LAS unsigned char* vp0 = Vt + dv * VPITCH + quad * 16;
#pragma unroll
      for (int i = 0; i < 4; ++i) vpre[i] = *(const LAS bf16x8*)(vp0 + i * 16 * VPITCH); }
    __builtin_amdgcn_sched_barrier(0);
    if (MASKED && need_mask) {
#pragma unroll
        for (int sub = 0; sub < 4; ++sub)
#pragma unroll
            for (int j = 0; j < 4; ++j) s[sub][j] = valid(sub * 16 + quad * 4 + j) ? s[sub][j] : -INFINITY;
    }
    float mx = fmaxf(fmaxf(s[0][0], s[0][1]), fmaxf(s[0][2], s[0][3]));
#pragma unroll
    for (int sub = 1; sub < 4; ++sub) mx = fmaxf(fmaxf(fmaxf(mx, s[sub][0]), fmaxf(s[sub][1], s[sub][2])), s[sub][3]);
    mx = fmaxf(mx, __shfl_xor(mx, 16)); mx = fmaxf(mx, __shfl_xor(mx, 32));
    const float mn = fmaxf(m, mx * SC_LOG2E);
    if (__any(mn > m)) {
        const float alpha = __builtin_amdgcn_exp2f(m - mn);
        m = mn; l *= alpha;
#pragma unroll
        for (int t = 0; t < DVT; ++t) o[t] *= alpha;
    }
    const float nm = -m;
    float ps = 0.f;
#pragma unroll
    for (int sub = 0; sub < 4; ++sub)
#pragma unroll
        for (int j = 0; j < 4; ++j) { const float p = __builtin_amdgcn_exp2f(__builtin_fmaf(s[sub][j], SC_LOG2E, nm)); s[sub][j] = p; ps += p; }
    l += ps;
#pragma unroll
    for (int k2 = 0; k2 < 2; ++k2) {
        union { unsigned u[4]; bf16x8 v; } pb;
        pb.u[0] = pack2(s[2 * k2][0], s[2 * k2][1]); pb.u[1] = pack2(s[2 * k2][2], s[2 * k2][3]);
        pb.u[2] = pack2(s[2 * k2 + 1][0], s[2 * k2 + 1][1]); pb.u[3] = pack2(s[2 * k2 + 1][2], s[2 * k2 + 1][3]);
        const LAS unsigned char* vp = Vt + dv * VPITCH + (k2 * 32 + quad * 8) * 2;
        bf16x8 va[4], vb[4];
#pragma unroll
        for (int i = 0; i < 4; ++i) va[i] = (k2 == 0) ? vpre[i] : *(const LAS bf16x8*)(vp + i * 16 * VPITCH);
#pragma unroll
        for (int g = 0; g < DVT / 4; ++g) {
            if (g + 1 < DVT / 4) {
#pragma unroll
                for (int i = 0; i < 4; ++i) vb[i] = *(const LAS bf16x8*)(vp + ((g + 1) * 4 + i) * 16 * VPITCH);
            }
            __builtin_amdgcn_sched_barrier(0);
#pragma unroll
            for (int i = 0; i < 4; ++i) o[g * 4 + i] = MFMA16(va[i], pb.v, o[g * 4 + i]);
            __builtin_amdgcn_sched_barrier(0);
            if (g + 1 < DVT / 4) {
#pragma unroll
                for (int i = 0; i < 4; ++i) va[i] = vb[i];
            }
        }
    }
}
DI void ldk(uint4 (&r)[2], const bf16_t* src, size_t ld, int tid) {
#pragma unroll
    for (int i = 0; i < 2; ++i) { const int c = tid + 512 * i; r[i] = *(const uint4*)(src + (size_t)(c >> 4) * ld + (c & 15) * 8); }
}
DI void stk(LAS unsigned char* Kt, const uint4 (&r)[2], int tid) {
#pragma unroll
    for (int i = 0; i < 2; ++i) { const int c = tid + 512 * i; *(LAS pg8::u32x4*)(Kt + (c >> 4) * KPITCH + (c & 15) * 16) = (pg8::u32x4){r[i].x, r[i].y, r[i].z, r[i].w}; }
}
template <int NCH> DI void ldv(uint4 (&r)[NCH], const bf16_t* src, size_t ld, int tid) {
#pragma unroll
    for (int i = 0; i < NCH; ++i) { const int c = tid + 512 * i; r[i] = *(const uint4*)(src + (size_t)(c >> 3) * ld + (c & 7) * 8); }
}
template <int NCH> DI void stv(LAS unsigned char* Vt, const uint4 (&r)[NCH], int tid) {
#pragma unroll
    for (int i = 0; i < NCH; ++i) { const int c = tid + 512 * i; const int ch = c & 7, lc = ch & 3;
        LAS unsigned char* p = Vt + (c >> 3) * VPITCH + ((ch >> 2) * 32 + 16 * (lc & 1) + 4 * (lc >> 1)) * 2;
        typedef unsigned u32x2 __attribute__((ext_vector_type(2)));
        *(LAS u32x2*)p = (u32x2){r[i].x, r[i].y}; *(LAS u32x2*)(p + 16) = (u32x2){r[i].z, r[i].w}; }
}


template <class R, class NextFn, class LoadFn, class StoreFn, class ComputeFn>
DI void tile_pipeline(NextFn next, LoadFn load, StoreFn store, ComputeFn compute) {
    R A, B;
    int tA = next(), tB = (tA >= 0) ? next() : -1;
    if (tA >= 0) load(A, tA);
    if (tB >= 0) load(B, tB);
    while (tA >= 0) {
        __syncthreads(); store(A, 0); __syncthreads();
        const int tC = (tB >= 0) ? next() : -1;
        if (tC >= 0) load(A, tC);
        compute(tA, 0);
        if (tB < 0) break;
        __syncthreads(); store(B, 0); __syncthreads();
        const int tD = (tC >= 0) ? next() : -1;
        if (tD >= 0) load(B, tD);
        compute(tB, 0);
        tA = tC; tB = tD;
    }
    __syncthreads();
}
struct RegsKV { uint4 k[2], v[2]; };
struct RegsK { uint4 k[2]; };
struct RegsD { uint4 k0[2], k1[2], v[4]; };

DI void diff_unit(const bf16_t* QK, const bf16_t* VT, const float* subln, float lam_full, float out_scale, bf16_t* Y, int b, int h, int qt, LAS unsigned char* lds) {
    int tid_l = threadIdx.x; asm volatile("" : "+v"(tid_l)); const int tid = tid_l, lane = tid & 63, w = tid >> 6, mm = w >> 2, quad = lane >> 4;
    const int q0 = qt * 64, t = q0 + (w & 3) * 16 + (lane & 15);
    LAS unsigned char* K0 = lds; LAS unsigned char* Vt = lds + 2 * KTILE_B;
    bf16x8 qf[4];
    { const bf16_t* qp = QK + (size_t)(b * SEQ + t) * 4096 + 2048 + (h * 2 + mm) * 128 + quad * 8;
#pragma unroll
      for (int ks = 0; ks < 4; ++ks) qf[ks] = *(const bf16x8*)(qp + ks * 32); }
    f32x4 o[16];
#pragma unroll
    for (int i = 0; i < 16; ++i) o[i] = (f32x4){0.f, 0.f, 0.f, 0.f};
    float m = -1e30f, l = 0.f;
    const bf16_t* kbase = QK + (size_t)b * SEQ * 4096 + 3072 + h * 256;
    const bf16_t* vbase = VT + (size_t)(b * 1536 + 512 + h * 256) * SEQ;
    { int jn = 0;
      tile_pipeline<RegsD>(
        [&]() { return (jn <= qt) ? jn++ : -1; },
        [&](RegsD& R, int j) { const bf16_t* kp = kbase + (size_t)j * 64 * 4096; ldk(R.k0, kp, 4096, tid); ldk(R.k1, kp + 128, 4096, tid); ldv<4>(R.v, vbase + j * 64, SEQ, tid); },
        [&](RegsD& R, int bf) { stk(K0 + bf * DSTAGE, R.k0, tid); stk(K0 + bf * DSTAGE + KTILE_B, R.k1, tid); stv<4>(Vt + bf * DSTAGE, R.v, tid); },
        [&](int j, int bf) { f32x4 s[4]; qk_tile(K0 + bf * DSTAGE + mm * KTILE_B, qf, s, lane); const int kb = j * 64;
                     softmax_pv<16, true>(Vt + bf * DSTAGE, s, o, m, l, [&](int kidx) { return kb + kidx <= t; }, lane, j == qt); }); }
    l += __shfl_xor(l, 16); l += __shfl_xor(l, 32);
    const float inv = 1.f / l;
    __syncthreads();
    float* xb = (float*)lds;
    if (mm == 1) {
#pragma unroll
        for (int i = 0; i < 16; ++i) *(f32x4*)(xb + ((size_t)((w & 3) * 16 + (lane & 15)) * 256 + i * 16 + quad * 4)) = o[i] * (inv * lam_full);
    }
    __syncthreads();
    if (mm == 0) {
        float ss = 0.f;
#pragma unroll
        for (int i = 0; i < 16; ++i) { const f32x4 o1 = *(const f32x4*)(xb + ((size_t)((w & 3) * 16 + (lane & 15)) * 256 + i * 16 + quad * 4));
            o[i] = o[i] * inv - o1; ss += o[i][0] * o[i][0] + o[i][1] * o[i][1] + o[i][2] * o[i][2] + o[i][3] * o[i][3]; }
        ss += __shfl_xor(ss, 16); ss += __shfl_xor(ss, 32);
        const float rs = rsqrtf(ss * (1.f / 256.f) + 1e-5f) * out_scale;
        bf16_t* yp = Y + (size_t)(b * SEQ + t) * 1024 + h * 256 + quad * 4;
#pragma unroll
        for (int i = 0; i < 16; ++i) { const f32x4 g = *(const f32x4*)(subln + i * 16 + quad * 4); const f32x4 v = o[i] * rs * g; uint2 pk; pk.x = pack2(v[0], v[1]); pk.y = pack2(v[2], v[3]); *(uint2*)(yp + i * 16) = pk; }
    }
    __syncthreads();
}

DI void nsa_unit(const bf16_t* QK, const bf16_t* VT, const bf16_t* KC, const bf16_t* VCT, const float* G, bf16_t* Y, int b, int g, int qt, LAS unsigned char* lds) {
    int tid_l = threadIdx.x; asm volatile("" : "+v"(tid_l)); const int tid = tid_l, lane = tid & 63, w = tid >> 6, hh = w >> 1, quad = lane >> 4;
    const int q0 = qt * 32, ql = (w & 1) * 16 + (lane & 15), t = q0 + ql;
    LAS unsigned char* Kt = lds; LAS unsigned char* Vt = lds + KTILE_B;
    float* impA = (float*)(lds + 2 * NSTAGE);
    float* impB = impA + 4 * 32 * 64;
    unsigned long long* selm = (unsigned long long*)(impB + 4 * 32 * 64);
    const size_t tok = (size_t)b * SEQ + t;
    bf16x8 qf[4];
    { const bf16_t* qp = QK + tok * 4096 + (g * 4 + hh) * 128 + quad * 8;
#pragma unroll
      for (int ks = 0; ks < 4; ++ks) qf[ks] = *(const bf16x8*)(qp + ks * 32); }
    const float* gp = G + tok * 32 + (g * 4 + hh) * 3;
    const float g0 = sigmoidf_(gp[0]), g1 = sigmoidf_(gp[1]), g2 = sigmoidf_(gp[2]);
    f32x4 out[8];
#pragma unroll
    for (int i = 0; i < 8; ++i) out[i] = (f32x4){0.f, 0.f, 0.f, 0.f};
    for (int i = tid; i < 2 * 4 * 32 * 64; i += 512) impA[i] = 0.f;
    f32x4 o[8];
    float m, l;
    const int ntc = (q0 >> 10) + 1;
    const bf16_t* kcb = KC + (size_t)(b * 2 + g) * 256 * 128;
    const bf16_t* vcb = VCT + (size_t)(b * 2 + g) * 128 * 256;
#pragma unroll
    for (int i = 0; i < 8; ++i) o[i] = (f32x4){0.f, 0.f, 0.f, 0.f};
    m = -1e30f; l = 0.f;
    { int jn = 0;
      tile_pipeline<RegsKV>(
        [&]() { return (jn < ntc) ? jn++ : -1; },
        [&](RegsKV& R, int j) { ldk(R.k, kcb + (size_t)j * 64 * 128, 128, tid); ldv<2>(R.v, vcb + j * 64, 256, tid); },
        [&](RegsKV& R, int bf) { stk(Kt + bf * NSTAGE, R.k, tid); stv<2>(Vt + bf * NSTAGE, R.v, tid); },
        [&](int j, int bf) { f32x4 s[4]; qk_tile(Kt + bf * NSTAGE, qf, s, lane); const int cb = j * 64;
                     softmax_pv<8, true>(Vt + bf * NSTAGE, s, o, m, l, [&](int kidx) { const int c = cb + kidx; return (c <= 254) && (16 * c + 31 <= t); }, lane); }); }
    l += __shfl_xor(l, 16); l += __shfl_xor(l, 32);
    const float invc = (l > 0.f) ? 1.f / l : 0.f;
#pragma unroll
    for (int i = 0; i < 8; ++i) out[i] += o[i] * (invc * g0);
    { int jn = 0;
      tile_pipeline<RegsK>(
        [&]() { return (jn < ntc) ? jn++ : -1; },
        [&](RegsK& R, int j) { ldk(R.k, kcb + (size_t)j * 64 * 128, 128, tid); },
        [&](RegsK& R, int bf) { stk(Kt + bf * NSTAGE, R.k, tid); },
        [&](int j, int bf) { f32x4 s[4]; qk_tile(Kt + bf * NSTAGE, qf, s, lane);
#pragma unroll
            for (int sub = 0; sub < 4; ++sub) {
                float p[4];
#pragma unroll
                for (int e = 0; e < 4; ++e) { const int c = j * 64 + sub * 16 + quad * 4 + e; const bool ok = (c <= 254) && (16 * c + 31 <= t);
                    p[e] = ok ? __builtin_amdgcn_exp2f(s[sub][e] * SC_LOG2E - m) * invc : 0.f; }
                const int jb = j * 16 + sub * 4 + quad;
                impA[(hh * 32 + ql) * 64 + jb] = p[0] + p[1] + p[2] + p[3];
                if (jb + 1 < 64) impB[(hh * 32 + ql) * 64 + jb + 1] = p[3];
            } }); }
    __syncthreads();
#pragma unroll 1
    for (int qi = 0; qi < 4; ++qi) {
        const int qq = w * 4 + qi, tq = q0 + qq, blk = tq >> 6;
        float v = 0.f;
#pragma unroll
        for (int h2 = 0; h2 < 4; ++h2) v += impA[(h2 * 32 + qq) * 64 + lane] + impB[(h2 * 32 + qq) * 64 + lane];
        if (lane == 0 || lane == blk || lane == blk - 1) v = 1e9f; else if (lane > blk) v = -INFINITY;
        int rank = 0;
#pragma unroll 2
        for (int jj = 0; jj < 64; ++jj) { const float o2 = __int_as_float(__builtin_amdgcn_readlane(__float_as_int(v), jj)); rank += (o2 > v || (o2 == v && jj < lane)) ? 1 : 0; }
        const unsigned long long msk = __ballot((rank < 16) && (lane <= blk));
        if (lane == 0) selm[qq] = msk;
    }
    __syncthreads();
    unsigned long long un = 0ull;
#pragma unroll 1
    for (int i = 0; i < 32; ++i) un |= selm[i];
    const unsigned long long my = selm[ql];
    {
        const bf16_t* kb = QK + (size_t)b * SEQ * 4096 + 1536 + g * 128;
        const bf16_t* vb = VT + (size_t)(b * 1536 + g * 128) * SEQ;
#pragma unroll
        for (int i = 0; i < 8; ++i) o[i] = (f32x4){0.f, 0.f, 0.f, 0.f};
        m = -1e30f; l = 0.f;
        unsigned long long rem = un;
        tile_pipeline<RegsKV>(
          [&]() { if (!rem) return -1; const int j = __builtin_ctzll(rem); rem &= rem - 1; return j; },
          [&](RegsKV& R, int j) { ldk(R.k, kb + (size_t)j * 64 * 4096, 4096, tid); ldv<2>(R.v, vb + j * 64, SEQ, tid); },
          [&](RegsKV& R, int bf) { stk(Kt + bf * NSTAGE, R.k, tid); stv<2>(Vt + bf * NSTAGE, R.v, tid); },
          [&](int j, int bf) { f32x4 s[4]; qk_tile(Kt + bf * NSTAGE, qf, s, lane); const bool sel = (my >> j) & 1ull; const int kbs = j * 64;
                       softmax_pv<8, true>(Vt + bf * NSTAGE, s, o, m, l, [&](int kidx) { return sel && (kbs + kidx <= t); }, lane, !__all(sel) || (kbs + 63 > q0)); });
        l += __shfl_xor(l, 16); l += __shfl_xor(l, 32);
        const float inv = (l > 0.f) ? 1.f / l : 0.f;
#pragma unroll
        for (int i = 0; i < 8; ++i) out[i] += o[i] * (inv * g1);
    }
    {
        const bf16_t* kb = QK + (size_t)b * SEQ * 4096 + 1792 + g * 128;
        const bf16_t* vb = VT + (size_t)(b * 1536 + 256 + g * 128) * SEQ;
#pragma unroll
        for (int i = 0; i < 8; ++i) o[i] = (f32x4){0.f, 0.f, 0.f, 0.f};
        m = -1e30f; l = 0.f;
        const int jlo = (q0 >= 511) ? ((q0 - 511) >> 6) : 0, jhi = q0 >> 6;
        { int jn = jlo;
          tile_pipeline<RegsKV>(
            [&]() { return (jn <= jhi) ? jn++ : -1; },
            [&](RegsKV& R, int j) { ldk(R.k, kb + (size_t)j * 64 * 4096, 4096, tid); ldv<2>(R.v, vb + j * 64, SEQ, tid); },
            [&](RegsKV& R, int bf) { stk(Kt + bf * NSTAGE, R.k, tid); stv<2>(Vt + bf * NSTAGE, R.v, tid); },
            [&](int j, int bf) { f32x4 s[4]; qk_tile(Kt + bf * NSTAGE, qf, s, lane); const int kbs = j * 64;
                         softmax_pv<8, true>(Vt + bf * NSTAGE, s, o, m, l, [&](int kidx) { return (unsigned)(t - (kbs + kidx)) < 512u; }, lane, (kbs + 63 > q0) || ((q0 + 31) - kbs >= 512)); }); }
        l += __shfl_xor(l, 16); l += __shfl_xor(l, 32);
        const float inv = (l > 0.f) ? 1.f / l : 0.f;
#pragma unroll
        for (int i = 0; i < 8; ++i) out[i] += o[i] * (inv * g2);
    }
    bf16_t* yp = Y + tok * 1024 + (g * 4 + hh) * 128 + quad * 4;
#pragma unroll
    for (int i = 0; i < 8; ++i) { uint2 pk; pk.x = pack2(out[i][0], out[i][1]); pk.y = pack2(out[i][2], out[i][3]); *(uint2*)(yp + i * 16) = pk; }
    __syncthreads();
}
template <int CTRL> DI float dpp_add(float x) { const int y = __builtin_amdgcn_update_dpp(0, __float_as_int(x), CTRL, 0xF, 0xF, true); return x + __int_as_float(y); }
DI float red16(float x) { x = dpp_add<0xB1>(x); x = dpp_add<0x4E>(x); x = dpp_add<0x141>(x); x = dpp_add<0x140>(x); return x; }
constexpr int SCH = 32, SBUF_F = 5 * SCH * 64 + SCH * 32;
DI void scan_unit(const bf16_t* Dr, const bf16_t* Dk, const bf16_t* Dv, const bf16_t* Dkk, const bf16_t* Dka, const _Float16* Dw, float* YRAW, int b, int h, int half, LAS unsigned char* lds) {
    int tid_l = threadIdx.x; asm volatile("" : "+v"(tid_l)); const int tid = tid_l, lane = tid & 63, w = tid >> 6;
    const int rl = w * 4 + (lane >> 4), kq = lane & 15;
    LAS float* buf = (LAS float*)lds;
    const size_t base = (size_t)b * SEQ * 1024 + h * 64;
    const int st_tok = tid >> 4, st_k = (tid & 15) * 4;
    const int sv_tok = (tid >> 3) & 31, sv_r = (tid & 7) * 4;
    uint2 g_r, g_k, g_kk, g_ka, g_w, g_v;
    auto gload = [&](int ck) {
        const size_t o = base + (size_t)(ck * SCH + st_tok) * 1024 + st_k;
        g_r = *(const uint2*)(Dr + o); g_k = *(const uint2*)(Dk + o); g_kk = *(const uint2*)(Dkk + o); g_ka = *(const uint2*)(Dka + o); g_w = *(const uint2*)(Dw + o);
        if (tid < 256) g_v = *(const uint2*)(Dv + base + (size_t)(ck * SCH + sv_tok) * 1024 + half * 32 + sv_r);
    };
    auto cvt4 = [&](const uint2& u) { f32x4 f; f[0] = __uint_as_float(u.x << 16); f[1] = __uint_as_float(u.x & 0xffff0000u); f[2] = __uint_as_float(u.y << 16); f[3] = __uint_as_float(u.y & 0xffff0000u); return f; };
    auto lstore = [&](int bi) {
        LAS float* p = buf + bi * SBUF_F + st_tok * 64 + st_k;
        *(LAS f32x4*)(p) = cvt4(g_r); *(LAS f32x4*)(p + SCH * 64) = cvt4(g_k); *(LAS f32x4*)(p + 2 * SCH * 64) = cvt4(g_kk); *(LAS f32x4*)(p + 3 * SCH * 64) = cvt4(g_ka);
        { union { uint2 u; _Float16 hh[4]; } c; c.u = g_w; f32x4 f; f[0] = 1.f + (float)c.hh[0]; f[1] = 1.f + (float)c.hh[1]; f[2] = 1.f + (float)c.hh[2]; f[3] = 1.f + (float)c.hh[3]; *(LAS f32x4*)(p + 4 * SCH * 64) = f; }
        if (tid < 256) *(LAS f32x4*)(buf + bi * SBUF_F + 5 * SCH * 64 + sv_tok * 32 + sv_r) = cvt4(g_v);
    };
    f32x4 st = {0.f, 0.f, 0.f, 0.f};
    gload(0);
    __syncthreads();
    lstore(0);
    __syncthreads();
    LAS float* ypart = buf + 2 * SBUF_F;
    float* yflush = YRAW + base + half * 32;
    for (int ck = 0; ck < SEQ / SCH; ++ck) {
        const int bi = ck & 1;
        if (ck + 1 < SEQ / SCH) gload(ck + 1);
        const LAS float* p = buf + bi * SBUF_F + kq * 4;
        const LAS float* pv = buf + bi * SBUF_F + 5 * SCH * 64 + rl;
        LAS float* yp = ypart + rl * 16 + kq;
#pragma unroll 4
        for (int tt = 0; tt < SCH; ++tt) {
            const f32x4 r4 = *(const LAS f32x4*)(p + tt * 64), k4 = *(const LAS f32x4*)(p + SCH * 64 + tt * 64), kk4 = *(const LAS f32x4*)(p + 2 * SCH * 64 + tt * 64),
                        ka4 = *(const LAS f32x4*)(p + 3 * SCH * 64 + tt * 64), w4 = *(const LAS f32x4*)(p + 4 * SCH * 64 + tt * 64);
            const float vv = pv[tt * 32];
            float dot = st[0] * kk4[0] + st[1] * kk4[1] + st[2] * kk4[2] + st[3] * kk4[3];
            dot = red16(dot);
            const float sa = -dot;
            st = st * w4 + ka4 * sa + k4 * vv;
            yp[tt * 512] = st[0] * r4[0] + st[1] * r4[1] + st[2] * r4[2] + st[3] * r4[3];
        }
        if (ck + 1 < SEQ / SCH) lstore(bi ^ 1);
        __syncthreads();
        { const int idx = tid * 2, tt = idx >> 5, r = idx & 31;
          const LAS float* ys = ypart + idx * 16;
          f32x4 a = *(const LAS f32x4*)ys + *(const LAS f32x4*)(ys + 4) + *(const LAS f32x4*)(ys + 8) + *(const LAS f32x4*)(ys + 12);
          f32x4 b2 = *(const LAS f32x4*)(ys + 16) + *(const LAS f32x4*)(ys + 20) + *(const LAS f32x4*)(ys + 24) + *(const LAS f32x4*)(ys + 28);
          *(f32x2*)(yflush + (size_t)(ck * SCH + tt) * 1024 + r) = (f32x2){(a[0] + a[1]) + (a[2] + a[3]), (b2[0] + b2[1]) + (b2[2] + b2[3])}; }
        __syncthreads();
    }
}
#define PH_BEGIN const Params* PP = &P; GAS unsigned char* wsg_ = (GAS unsigned char*)P.ws; asm volatile("" : "+s"(wsg_)); unsigned char* ws = (unsigned char*)wsg_; int tid = threadIdx.x; asm volatile("" : "+v"(tid)); int bid = blockIdx.x; asm volatile("" : "+s"(bid)); \
    const int G = gridDim.x; const int gtid = bid * 512 + tid, gthreads = G * 512; (void)gtid; (void)gthreads; (void)ws;
#define WSP(T, off) ((T*)(ws + (off)))
#define INP(i, stride) ((const float*)PP->in[i] + (size_t)L * (stride))
#define XB_TMO      128
#define XB_XCNT(j)  (256  + 64 * (j))
#define XB_XSUB(j)  (1280 + 64 * (j))
#define XB_XGEN(j)  (2304 + 64 * (j))
#define XB_TOP      3328
#define XB_TOPGEN   3392
#define XCD_BAR_WORDS 3456
#define XB_SPIN_CAP (1u << 18)

__device__ __forceinline__ unsigned xb_ld(unsigned* p)              { return __hip_atomic_load(p, __ATOMIC_RELAXED, __HIP_MEMORY_SCOPE_AGENT); }
__device__ __forceinline__ unsigned xb_add(unsigned* p, unsigned v) { return __hip_atomic_fetch_add(p, v, __ATOMIC_RELAXED, __HIP_MEMORY_SCOPE_AGENT); }
__device__ __forceinline__ unsigned xb_xcc_id() { return (unsigned)__builtin_amdgcn_s_getreg((3 << 11) | 20) & 0xFu; }
#define XB_SPIN(cond, bar) do { unsigned _sp = 0; while (cond) { __builtin_amdgcn_s_sleep(1); \
    if ((++_sp & 255u) == 0u) { if (xb_ld(&(bar)[XB_TMO])) break; if (_sp > XB_SPIN_CAP) { atomicAdd(&(bar)[XB_TMO], 1u); break; } } } } while (0)

struct XcdBarrier {
    unsigned* bar; unsigned x;
    volatile LAS unsigned* st;
};

__device__ __forceinline__ XcdBarrier xcd_barrier_post(unsigned* bar, volatile LAS unsigned* st) {
    XcdBarrier b; b.bar = bar; b.x = xb_xcc_id(); b.st = st;
    if (threadIdx.x == 0) (void)xb_add(&bar[XB_XCNT(b.x)], 1u);
    return b;
}
__device__ __forceinline__ void xcd_barrier_complete(unsigned* bar, unsigned x, unsigned& nloc, unsigned& nx) {
    const unsigned G = gridDim.x * gridDim.y * gridDim.z;
    unsigned sum, cnt, mine, sp = 0u;
    for (;;) {
        sum = 0u; cnt = 0u; mine = 0u;
#pragma unroll
        for (unsigned j = 0; j < 16; ++j) { const unsigned c = xb_ld(&bar[XB_XCNT(j)]); sum += c; cnt += (c > 0u) ? 1u : 0u; mine = (j == x) ? c : mine; }
        if (sum == G) break;
        __builtin_amdgcn_s_sleep(1);
        if ((++sp & 255u) == 0u) { if (xb_ld(&bar[XB_TMO])) break; if (sp > XB_SPIN_CAP) { atomicAdd(&bar[XB_TMO], 1u); break; } }
    }
    nloc = mine > 0u ? mine : 1u; nx = cnt > 0u ? cnt : 1u;
}

__device__ __forceinline__ void xcd_barrier(const XcdBarrier& b) {
    asm volatile("s_waitcnt vmcnt(0)" ::: "memory");
    __syncthreads();
    if (threadIdx.x == 0) {
        unsigned* bar = b.bar;
        __builtin_amdgcn_s_waitcnt(0);
        unsigned nloc = b.st[0], nx = b.st[1];
        if (nloc == 0u) { xcd_barrier_complete(bar, b.x, nloc, nx); b.st[0] = nloc; b.st[1] = nx; }
        const unsigned old = xb_add(&bar[XB_XSUB(b.x)], 1u);
        const unsigned gen = old / nloc;
        if (old + 1u == (gen + 1u) * nloc) {
            __builtin_amdgcn_fence(__ATOMIC_RELEASE, "agent");
            asm volatile("s_waitcnt vmcnt(0)" ::: "memory");
            const unsigned og = xb_add(&bar[XB_TOP], 1u);
            const unsigned tg = og / nx;
            if (og + 1u == (tg + 1u) * nx) xb_add(&bar[XB_TOPGEN], 1u);
            else XB_SPIN(xb_ld(&bar[XB_TOPGEN]) == tg, bar);
            __builtin_amdgcn_fence(__ATOMIC_ACQUIRE, "agent");
            xb_add(&bar[XB_XGEN(b.x)], 1u);
            asm volatile("s_waitcnt vmcnt(0)" ::: "memory");
        } else {
            XB_SPIN(xb_ld(&bar[XB_XGEN(b.x)]) == gen, bar);
            __builtin_amdgcn_fence(__ATOMIC_ACQUIRE, "agent");
            asm volatile("s_waitcnt vmcnt(0)" ::: "memory");
        }
    }
    __syncthreads();
}


constexpr size_t OFF_BAR = 8192;
#define GSYNC() do { XcdBarrier xb_; xb_.bar = (unsigned*)(P.ws + OFF_BAR); xb_.x = xb_xcc_id(); xb_.st = (volatile LAS unsigned*)(lds + LDS_CTLW + 64); xcd_barrier(xb_); } while (0)
template <int L> DI void layer_body(const Params& P, LAS unsigned char* lds, float* tile) {
        { PH_BEGIN
          const float* cmp_w1 = INP(8, 2 * 4096 * 256); const float* cmp_w2 = INP(9, 2 * 256 * 128);
          cvt_transpose(tile, INP(6, 2048 * 9016), 9016, 2048, NWIN, WSP(bf16_t, OFF_WIN), [](int n) { return n < 2560 ? n : (n < 8992 ? n + 24 : (n < 9016 ? n - 8992 + 2560 : -1)); }, bid, G);
          cvt_transpose(tile, cmp_w1, 256, 4096, 256, WSP(bf16_t, OFF_W1T), [](int n) { return n; }, bid, G);
          cvt_transpose(tile, cmp_w1 + (size_t)4096 * 256, 256, 4096, 256, WSP(bf16_t, OFF_W1T) + (size_t)256 * 4096, [](int n) { return n; }, bid, G);
          bf16_t* W2T = WSP(bf16_t, OFF_W2T);
          for (int i = gtid; i < 256 * 256; i += gthreads) { const int n = i >> 8, k = i & 255; W2T[i] = f2bf(cmp_w2[(size_t)(n >> 7) * 256 * 128 + (size_t)k * 128 + (n & 127)]); }
          const float* w_up_l = INP(14, 64 * 1024); const float* a_up = INP(16, 64 * 1024); const float* g_up = INP(17, 160 * 1024); bf16_t* LORA = WSP(bf16_t, OFF_LORA);
          for (int i = gtid; i < 3072 * 384; i += gthreads) {
            const int n = i / 384, k = i - n * 384, kind = n >> 10, c = n & 1023; float v = 0.f;
            if (kind == 0) { if (k < 64) v = w_up_l[(size_t)k * 1024 + c]; }
            else if (kind == 1) { if (k >= 64 && k < 128) v = a_up[(size_t)(k - 64) * 1024 + c]; }
            else { if (k >= 128 && k < 288) v = g_up[(size_t)(k - 128) * 1024 + c]; }
            LORA[i] = f2bf(v);
          }
          if (gtid == 0) { const float* dlam = INP(10, 512); const float lam_init = 0.8f - 0.6f * expf(-0.3f * (float)L);
            float s01 = 0.f, s23 = 0.f; for (int i = 0; i < 128; ++i) { s01 += dlam[i] * dlam[128 + i]; s23 += dlam[256 + i] * dlam[384 + i]; } WSP(float, OFF_MISC)[L] = expf(s01) - expf(s23) + lam_init; } }
        if (L == 0) cg::this_grid().sync(); else GSYNC();

        { PH_BEGIN
          pg8::StaticOrder S; S.init(TT, NWIN, G, bid); EpiWin E{WSP(bf16_t, OFF_QK), WSP(bf16_t, OFF_VT), WSP(float, OFF_G), WSP(bf16_t, OFF_PR), WSP(const float2, OFF_ROPE)};
          pg8::gemm_phase<EpiWin, pg8::StaticOrder>(lds, Gemm{WSP(bf16_t, OFF_U), WSP(bf16_t, OFF_WIN), TT, NWIN, 2048}, S, E, nullptr); }
        GSYNC();

        { PH_BEGIN
          bf16_t* Dr = WSP(bf16_t, OFF_D);
          rwkv_shift(WSP(bf16_t, OFF_PR), INP(12, 3360), Dr, Dr + (size_t)TT * 1024, Dr + (size_t)2 * TT * 1024, WSP(bf16_t, OFF_AL), gtid, gthreads);
          build_cmpa(WSP(bf16_t, OFF_QK), INP(7, 2 * 32 * 128), WSP(bf16_t, OFF_CMPA), gtid, gthreads); }
        GSYNC();

        { PH_BEGIN
          ListOrder S{16, G, G - 1 - bid, 0}; EpiBf<1> E{WSP(bf16_t, OFF_H), 256, 16, 1, 0};
          pg8::gemm_phase<EpiBf<1>, ListOrder>(lds, Gemm{WSP(bf16_t, OFF_CMPA), WSP(bf16_t, OFF_W1T), 4096, 512, 4096}, S, E, nullptr); }
        { PH_BEGIN
          int K384 = 384; asm volatile("" : "+s"(K384));
          if (bid < G - 16) {
          pg8::StaticOrder S; S.init(TT, 1024, G - 16, bid); EpiF32 E{WSP(float, OFF_YRAW), 1024};
          pg8::gemm_phase<EpiF32, pg8::StaticOrder>(lds, Gemm{WSP(bf16_t, OFF_AL), WSP(bf16_t, OFF_LORA), TT, 1024, K384}, S, E, nullptr); } }
        { PH_BEGIN
          int K384 = 384; asm volatile("" : "+s"(K384));
          if (bid < G - 16) {
          pg8::StaticOrder S; S.init(TT, 1024, G - 16, bid); EpiBf<0> E{WSP(bf16_t, OFF_D) + (size_t)4 * TT * 1024, 1024, 64, 4, 0};
          pg8::gemm_phase<EpiBf<0>, pg8::StaticOrder>(lds, Gemm{WSP(bf16_t, OFF_AL), WSP(bf16_t, OFF_LORA) + (size_t)1024 * 384, TT, 1024, K384}, S, E, nullptr); } }
        { PH_BEGIN
          int K384 = 384; asm volatile("" : "+s"(K384));
          if (bid < G - 16) {
          pg8::StaticOrder S; S.init(TT, 1024, G - 16, bid); EpiBf<0> E{WSP(bf16_t, OFF_PR) + (size_t)2 * TT * 1024, 1024, 64, 4, 0};
          pg8::gemm_phase<EpiBf<0>, pg8::StaticOrder>(lds, Gemm{WSP(bf16_t, OFF_AL), WSP(bf16_t, OFF_LORA) + (size_t)2048 * 384, TT, 1024, K384}, S, E, nullptr); } }
        GSYNC();

        { PH_BEGIN
          ListOrder S{8, G, bid, 1}; EpiCmp2<0> E{WSP(bf16_t, OFF_KC), WSP(bf16_t, OFF_VCT), WSP(const float2, OFF_ROPE)};
          pg8::gemm_phase<EpiCmp2<0>, ListOrder>(lds, Gemm{WSP(bf16_t, OFF_H), WSP(bf16_t, OFF_W2T), 2048, 256, 256}, S, E, nullptr); }
        { PH_BEGIN
          ListOrder S{8, G, G - 1 - bid, 1}; EpiCmp2<1> E{WSP(bf16_t, OFF_KC), WSP(bf16_t, OFF_VCT), WSP(const float2, OFF_ROPE)};
          pg8::gemm_phase<EpiCmp2<1>, ListOrder>(lds, Gemm{WSP(bf16_t, OFF_H) + (size_t)2048 * 256, WSP(bf16_t, OFF_W2T), 2048, 256, 256}, S, E, nullptr); }
        { PH_BEGIN
          bf16_t* Dr = WSP(bf16_t, OFF_D);
          rwkv_prep(Dr, Dr + (size_t)TT * 1024, Dr + (size_t)3 * TT * 1024, Dr + (size_t)4 * TT * 1024, INP(18, 1024), INP(19, 1024), INP(20, 1024), WSP(float, OFF_BON), WSP(float, OFF_YRAW), INP(13, 1024), INP(15, 1024), (_Float16*)(Dr + (size_t)5 * TT * 1024), gtid, gthreads); }
        GSYNC();

        {
            LAS int* qslot = (LAS int*)(lds + LDS_CTLW);
#ifndef DUP_F
#define DUP_F 1
#endif
            for (int rep = 0; rep < DUP_F; ++rep) { if (rep) GSYNC();
            const int myx = (int)(xb_xcc_id() & 7u);
#pragma unroll 1
            for (int qq = 0; qq < 8; ++qq) {
            const int xq = (myx + qq) & 7;
            for (;;) {
                PH_BEGIN
                __syncthreads();
                if (tid == 0) *qslot = (int)atomicAdd(WSP(unsigned, OFF_CTL) + 64 * L + 16 * rep + xq, 1u);
                __syncthreads();
                const int v = *qslot;
                if (v >= 16 + 256) break;
                bf16_t* Dr = WSP(bf16_t, OFF_D); bf16_t* Y3 = WSP(bf16_t, OFF_PR);
                if (v < 16) { const int u = xq * 16 + v;
                    scan_unit(Dr, Dr + (size_t)TT * 1024, Dr + (size_t)2 * TT * 1024, Dr + (size_t)3 * TT * 1024, Dr + (size_t)4 * TT * 1024, (const _Float16*)(Dr + (size_t)5 * TT * 1024), WSP(float, OFF_YRAW), u >> 5, (u >> 1) & 15, u & 1, lds); }
                else {
                    const int w = v - 16, r = w >> 2, k = w & 3;
                    if (k < 2) { const float lam_init = 0.8f - 0.6f * expf(-0.3f * (float)L); const int idx = 2 * xq + k;
                        diff_unit(WSP(bf16_t, OFF_QK), WSP(bf16_t, OFF_VT), INP(11, 256), WSP(float, OFF_MISC)[L], 1.f - lam_init, Y3 + (size_t)TT * 1024, idx >> 2, idx & 3, 63 - r, lds); }
                    else nsa_unit(WSP(bf16_t, OFF_QK), WSP(bf16_t, OFF_VT), WSP(bf16_t, OFF_KC), WSP(bf16_t, OFF_VCT), WSP(float, OFF_G), Y3, xq >> 1, xq & 1, 127 - 2 * r - (k - 2), lds);
                }
            }
            }
            }
        }
        GSYNC();

        { PH_BEGIN
          const float* w_gate = INP(23, 3 * 2048 * 2048); const float* w_branch = INP(25, 3 * 1024 * 2048);
#pragma unroll 1
          for (int b3 = 0; b3 < 3; ++b3) {
            cvt_transpose(tile, w_gate + (size_t)b3 * 2048 * 2048, 2048, 2048, 2048, WSP(bf16_t, OFF_WG) + (size_t)b3 * 2048 * 2048, [](int n) { return n; }, bid, G);
            cvt_transpose(tile, w_branch + (size_t)b3 * 1024 * 2048, 2048, 1024, 2048, WSP(bf16_t, OFF_WB) + (size_t)b3 * 2048 * 1024, [](int n) { return n; }, bid, G);
          }
          cvt_transpose(tile, INP(26, 2048 * 2048), 2048, 2048, 2048, WSP(bf16_t, OFF_WO), [](int n) { return n; }, bid, G);
          cvt_transpose(tile, INP(27, 2048 * 8192), 8192, 2048, 8192, WSP(bf16_t, OFF_WUP), [](int n) { return n; }, bid, G);
          cvt_transpose(tile, INP(28, 8192 * 2048), 2048, 8192, 2048, WSP(bf16_t, OFF_WDN), [](int n) { return n; }, bid, G);
          rwkv_final(WSP(float, OFF_YRAW), WSP(bf16_t, OFF_D) + (size_t)2 * TT * 1024, WSP(float, OFF_BON), INP(21, 1024), INP(22, 1024), WSP(bf16_t, OFF_PR) + (size_t)2 * TT * 1024, gtid, gthreads); }
        GSYNC();

        { PH_BEGIN
          ListOrder S{1536, G, bid, 3}; EpiBf<0> E{WSP(bf16_t, OFF_Z), 2048, 64, 8, (size_t)TT * 2048};
          pg8::gemm_phase<EpiBf<0>, ListOrder>(lds, Gemm{WSP(bf16_t, OFF_PR), WSP(bf16_t, OFF_WB), 3 * TT, 6144, 1024}, S, E, nullptr); }
        GSYNC();
        { PH_BEGIN
          ListOrder S{0, G, bid, 2}; EpiMerge E{WSP(bf16_t, OFF_Z), INP(24, 3 * 2048), WSP(float, OFF_SCR), WSP(bf16_t, OFF_MRG)};
          pg8::gemm_phase<EpiMerge, ListOrder>(lds, Gemm{WSP(bf16_t, OFF_U), WSP(bf16_t, OFF_WG), TT, 6144, 2048}, S, E, nullptr); }
        GSYNC();
        { PH_BEGIN
          pg8::StaticOrder S; S.init(TT, 2048, G, bid); EpiBf<0> E{WSP(bf16_t, OFF_T1A), 2048, 0, 0, 0};
          pg8::gemm_phase<EpiBf<0>, pg8::StaticOrder>(lds, Gemm{WSP(bf16_t, OFF_MRG), WSP(bf16_t, OFF_WO), TT, 2048, 2048}, S, E, nullptr); }
        GSYNC();
        { PH_BEGIN
          row_pass(L == 0 ? (const float*)PP->in[0] : PP->out, WSP(bf16_t, OFF_T1A), INP(3, 2048), PP->out, INP(4, 2048), WSP(bf16_t, OFF_U), bid, G); }
        GSYNC();
        { PH_BEGIN
          pg8::StaticOrder S; S.init(TT, DFF, G, bid); EpiBf<2> E{WSP(bf16_t, OFF_HID), DFF, 0, 0, 0};
          pg8::gemm_phase<EpiBf<2>, pg8::StaticOrder>(lds, Gemm{WSP(bf16_t, OFF_U), WSP(bf16_t, OFF_WUP), TT, DFF, 2048}, S, E, nullptr); }
        GSYNC();
        { PH_BEGIN
          pg8::StaticOrder S; S.init(TT, 2048, G, bid); EpiBf<0> E{WSP(bf16_t, OFF_T1B), 2048, 0, 0, 0};
          pg8::gemm_phase<EpiBf<0>, pg8::StaticOrder>(lds, Gemm{WSP(bf16_t, OFF_HID), WSP(bf16_t, OFF_WDN), TT, 2048, DFF}, S, E, nullptr); }
        GSYNC();
        { PH_BEGIN
          row_pass(PP->out, WSP(bf16_t, OFF_T1B), INP(5, 2048), PP->out, (const float*)PP->in[2] + 2048, (L == 0) ? WSP(bf16_t, OFF_U) : (bf16_t*)nullptr, bid, G); }
        GSYNC();

}

__global__ void __launch_bounds__(512, 2) fwd_megakernel(Params P) {
    extern __shared__ __attribute__((aligned(16))) unsigned char lds_raw[];
    LAS unsigned char* lds = (LAS unsigned char*)lds_raw;
    float* tile = (float*)lds_raw;
    if (threadIdx.x < 2) ((volatile LAS unsigned*)(lds + LDS_CTLW + 64))[threadIdx.x] = 0u;
    __syncthreads();
    (void)xcd_barrier_post((unsigned*)(P.ws + OFF_BAR), (volatile LAS unsigned*)(lds + LDS_CTLW + 64));
    { PH_BEGIN {
      const int* positions = (const int*)PP->in[1]; float2* ROPE = WSP(float2, OFF_ROPE);
      for (int i = gtid; i < TT * 16; i += gthreads) {
        const int tok = i >> 4, f = i & 15;
        const float inv = (float)pow(500000.0, -(double)f / 16.0);
        const float ang = (float)positions[tok] * inv;
        const double a = (double)ang; const double k = rint(a * 0.15915494309189535); const float r = (float)(a - k * 6.283185307179586);
        ROPE[i] = make_float2(__cosf(r), __sinf(r));
      }
      norm_pass((const float*)PP->in[0], (const float*)PP->in[2], WSP(bf16_t, OFF_U), bid, G); } }

    layer_body<0>(P, lds, tile);
    layer_body<1>(P, lds, tile);
}

extern "C" void kernel_launch(void* const* d_in, const int* in_sizes, int n_in, void* d_out, int out_size, void* d_ws, size_t ws_size, hipStream_t stream) {
    static int grid_blocks = 0;
    if (!grid_blocks) {
        int dev = 0, cus = 0, per_cu = 0;
        (void)hipGetDevice(&dev);
        (void)hipDeviceGetAttribute(&cus, hipDeviceAttributeMultiprocessorCount, dev);
        (void)hipFuncSetAttribute((const void*)fwd_megakernel, hipFuncAttributeMaxDynamicSharedMemorySize, LDS_BYTES);
        (void)hipOccupancyMaxActiveBlocksPerMultiprocessor(&per_cu, (const void*)fwd_megakernel, 512, LDS_BYTES);
        if (per_cu < 1) per_cu = 1;
        grid_blocks = cus * per_cu;
        if (ws_size < WS_END) fprintf(stderr, "kernel_launch: workspace too small: %zu < %zu\n", ws_size, (size_t)WS_END);
    }
    (void)hipMemsetAsync((char*)d_ws + OFF_CTL, 0, 32768, stream);
    Params p{};
    for (int k = 0; k < NIN; ++k) p.in[k] = d_in[k];
    p.out = (float*)d_out; p.ws = (unsigned char*)d_ws; p.stage = 0; p.pad = 0;
    void* args[] = {&p};
    hipError_t e = hipLaunchCooperativeKernel((const void*)fwd_megakernel, dim3(grid_blocks), dim3(512), args, LDS_BYTES, stream);
    if (e != hipSuccess) fprintf(stderr, "cooperative launch failed: %s (grid %d)\n", hipGetErrorString(e), grid_blocks);
}
```

```cpp
#include <hip/hip_runtime.h>
#include <hip/hip_cooperative_groups.h>
#include <cstdio>
#include <cstdint>
namespace cg = cooperative_groups;
#define DI __device__ __forceinline__
#define LAS __attribute__((address_space(3)))
#define GAS __attribute__((address_space(1)))
namespace pg8 {
#define PG8_LAS __attribute__((address_space(3)))
typedef unsigned short bf16_t;
typedef short bf16x8 __attribute__((ext_vector_type(8)));
typedef float f32x4 __attribute__((ext_vector_type(4)));
typedef unsigned u32x4 __attribute__((ext_vector_type(4)));
constexpr int BM = 256, BK = 64, HALF = 128, HTB = HALF * BK * 2  , STAGE_BYTES = 8 * HTB, NXCD = 8, WGM = 8;

__host__ __device__ __forceinline__ int lds_byte(int r, int c) { const int st = (r >> 4) * 2 + (c >> 5), rr = r & 15, cc = c & 31, ob = rr * 64 + cc * 2; return st * 1024 + (ob ^ (((ob >> 9) & 1) << 5)); }
__host__ __device__ __forceinline__ void stage_rc(int b, int& R, int& C) { const int st = b / 1024, sb = b % 1024, swz = sb ^ (((sb >> 9) & 1) << 5); R = (st >> 1) * 16 + swz / 64; C = (st & 1) * 32 + (swz % 64) / 2; }
__host__ __device__ __forceinline__ int perm32(int rho) { const int n = rho >> 4, i = rho & 15; return 8 * (i >> 2) + 4 * n + (i & 3); }

struct Unit { int pm, pn; };
struct Gemm { const bf16_t* A; const bf16_t* Bt; int M, N, K; };

struct StaticOrder {
    int nM, nN, nwg, G, c;
    __host__ __device__ void init(int M, int N, int G_, int c_) { nM = M / BM; nN = N / BM; nwg = nM * nN; G = G_; c = c_; }
    __host__ __device__ bool next(int i, Unit& u) const {
        const long L = (long)i * G + c; if (L >= nwg) return false;
        int wgid = (int)L; { const int q = nwg / NXCD, r = nwg % NXCD, xcd = wgid % NXCD, off = wgid / NXCD; wgid = (xcd < r ? xcd * (q + 1) : r * (q + 1) + (xcd - r) * q) + off; }
        const int nig = WGM * nN, gid = wgid / nig, fm = gid * WGM, gsz = (nM - fm) < WGM ? (nM - fm) : WGM;
        u.pm = fm + ((wgid % nig) % gsz); u.pn = (wgid % nig) / gsz; return true;
    }
    __device__ __forceinline__ void a_ready(const Unit&) const {}
    __device__ __forceinline__ void done(const Unit&) const {}
};
template <class Epi, class Sched, bool STAMP = false>
__device__ __forceinline__ void gemm_phase(PG8_LAS unsigned char* lds, const Gemm g, const Sched& S, const Epi& E, unsigned long long* stamps) {
    int tid_l = threadIdx.x; asm volatile("" : "+v"(tid_l)); const int tid = tid_l, wid = __builtin_amdgcn_readfirstlane(tid >> 6), lane = tid & 63, wr = wid >> 2, wc = wid & 3, fr = lane & 15, fq = lane >> 4;
    const int K = g.K, nt = K / BK;
    int ts_lo = 0, ts_hi = 0, nts = 0; const unsigned long long rt_entry = STAMP ? (unsigned long long)wall_clock64() : 0ull;
#define PG8_STAMP() do { if (STAMP && wid == 0 && nts < 64) { const unsigned long long _c = (unsigned long long)clock64(); \
        ts_lo = (lane == nts) ? (int)(unsigned)_c : ts_lo; ts_hi = (lane == nts) ? (int)(unsigned)(_c >> 32) : ts_hi; ++nts; } } while (0)
    PG8_STAMP();
    unsigned voffA[2], voffB[2];
#pragma unroll
    for (int i = 0; i < 2; ++i) { int R, C; stage_rc(tid * 16 + i * 8192, R, C); const int Rb = Epi::PERM ? ((R & ~31) + perm32(R & 31)) : R;
        voffA[i] = (unsigned)(R * K + C) * 2u; voffB[i] = (unsigned)(Rb * K + C) * 2u; }
    const size_t kstep = (size_t)(BK * 2);
    const size_t hstep = (size_t)HALF * K * 2;
    const size_t tstep = 2 * hstep;
    const unsigned ldsw = (unsigned)wid * 1024u;
    const int aoff = lds_byte(wr * 64 + fr, fq * 8), boff = lds_byte(wc * 32 + fr, fq * 8);
#define PG8_SA(b, h) (((b) * 2 + (h)) * HTB)
#define PG8_SB(b, h) ((4 + (b) * 2 + (h)) * HTB)
#define PG8_STAGE(bufoff, gbase, voff) do { _Pragma("unroll") for (int _i = 0; _i < 2; ++_i) \
        __builtin_amdgcn_global_load_lds((const unsigned*)((const char*)(gbase) + (voff)[_i]), (PG8_LAS unsigned*)(lds + (bufoff) + ldsw + _i * 8192), 16, 0, 0); } while (0)
#define PG8_LDA(dst, b, h) do { _Pragma("unroll") for (int m = 0; m < 4; ++m) _Pragma("unroll") for (int k = 0; k < 2; ++k) dst[m][k] = *(const PG8_LAS bf16x8*)(lds + PG8_SA(b, h) + aoff + m * 2048 + k * 1024); } while (0)
#define PG8_LDB(dst, b, h) do { _Pragma("unroll") for (int n = 0; n < 2; ++n) _Pragma("unroll") for (int k = 0; k < 2; ++k) dst[n][k] = *(const PG8_LAS bf16x8*)(lds + PG8_SB(b, h) + boff + n * 2048 + k * 1024); } while (0)
#define PG8_MMA(ai, bj, At, Bt) do { __builtin_amdgcn_s_setprio(1); _Pragma("unroll") for (int m = 0; m < 4; ++m) _Pragma("unroll") for (int n = 0; n < 2; ++n) _Pragma("unroll") for (int k = 0; k < 2; ++k) \
        acc[ai][bj][m][n] = __builtin_amdgcn_mfma_f32_16x16x32_bf16(Bt[n][k], At[m][k], acc[ai][bj][m][n], 0, 0, 0); __builtin_amdgcn_s_setprio(0); } while (0)
#define PG8_WAIT_V(n) asm volatile("s_waitcnt vmcnt(" #n ")" ::: "memory")
#define PG8_WAIT_L(n) asm volatile("s_waitcnt lgkmcnt(" #n ")" ::: "memory")
#define PG8_BAR __builtin_amdgcn_s_barrier()
#define PG8_SCHED __builtin_amdgcn_sched_barrier(0)
    Unit cur, nxt; int ui = 0;
    if (!S.next(0, cur)) return;
    f32x4 acc[2][2][4][2];
#pragma unroll
    for (int a = 0; a < 2; ++a)
#pragma unroll
        for (int b = 0; b < 2; ++b)
#pragma unroll
            for (int m = 0; m < 4; ++m)
#pragma unroll
                for (int n = 0; n < 2; ++n) acc[a][b][m][n] = (f32x4){0.f, 0.f, 0.f, 0.f};
    bf16x8 At[4][2], B0[2][2], B1[2][2];
    const char* cA = (const char*)g.A + (size_t)cur.pm * tstep; const char* cB = (const char*)g.Bt + (size_t)cur.pn * tstep;
    S.a_ready(cur);
    PG8_STAGE(PG8_SB(0, 0), cB, voffB); PG8_STAGE(PG8_SA(0, 0), cA, voffA); PG8_STAGE(PG8_SB(0, 1), cB + hstep, voffB); PG8_STAGE(PG8_SA(0, 1), cA + hstep, voffA);
    if (wr == 1) PG8_BAR;
    PG8_WAIT_V(4); PG8_BAR;
    PG8_STAGE(PG8_SB(1, 0), cB + kstep, voffB); PG8_STAGE(PG8_SA(1, 0), cA + kstep, voffA); PG8_STAGE(PG8_SB(1, 1), cB + hstep + kstep, voffB);
    PG8_WAIT_V(6); PG8_BAR;
    PG8_STAMP();
    for (;;) {
        const bool has_next = S.next(ui + 1, nxt);
        const char* nA = has_next ? (const char*)g.A + (size_t)nxt.pm * tstep : cA; const char* nB = has_next ? (const char*)g.Bt + (size_t)nxt.pn * tstep : cB;
        for (int t = 0; t < nt; t += 2) {
            const bool last = (t == nt - 2);
            const char* a1 = cA + (size_t)(t + 1) * kstep;
            const char* a2 = last ? nA : cA + (size_t)(t + 2) * kstep; const char* b2 = last ? nB : cB + (size_t)(t + 2) * kstep;
            const char* a3 = a2 + kstep; const char* b3 = b2 + kstep;
            if (last && has_next) S.a_ready(nxt);
            PG8_LDB(B0, 0, 0); PG8_SCHED; PG8_LDA(At, 0, 0); PG8_STAGE(PG8_SA(1, 1), a1 + hstep, voffA);
            PG8_WAIT_L(8); PG8_BAR; PG8_WAIT_L(0); PG8_MMA(0, 0, At, B0); PG8_BAR; PG8_SCHED;
            PG8_LDB(B1, 0, 1); PG8_STAGE(PG8_SB(0, 0), b2, voffB);
            PG8_BAR; PG8_WAIT_L(0); PG8_MMA(0, 1, At, B1); PG8_BAR;
            PG8_LDA(At, 0, 1); PG8_STAGE(PG8_SA(0, 0), a2, voffA);
            PG8_BAR; PG8_WAIT_L(0); PG8_MMA(1, 0, At, B0); PG8_BAR; PG8_SCHED;
            PG8_STAGE(PG8_SB(0, 1), b2 + hstep, voffB);
            PG8_WAIT_V(6); PG8_BAR; PG8_MMA(1, 1, At, B1); PG8_BAR;
            PG8_LDB(B0, 1, 0); PG8_SCHED; PG8_LDA(At, 1, 0); PG8_STAGE(PG8_SA(0, 1), a2 + hstep, voffA);
            PG8_WAIT_L(8); PG8_BAR; PG8_WAIT_L(0); PG8_MMA(0, 0, At, B0); PG8_BAR; PG8_SCHED;
            PG8_LDB(B1, 1, 1); PG8_STAGE(PG8_SB(1, 0), b3, voffB);
            PG8_BAR; PG8_WAIT_L(0); PG8_MMA(0, 1, At, B1); PG8_BAR;
            PG8_LDA(At, 1, 1); PG8_STAGE(PG8_SA(1, 0), a3, voffA);
            PG8_BAR; PG8_WAIT_L(0); PG8_MMA(1, 0, At, B0); PG8_BAR; PG8_SCHED;
            PG8_STAGE(PG8_SB(1, 1), b3 + hstep, voffB);
            PG8_WAIT_V(6); PG8_BAR; PG8_MMA(1, 1, At, B1); PG8_BAR;
        }
        PG8_STAMP();
        if constexpr (!Epi::AFTER_DRAIN) { E(acc, cur, wr, wc, fr, fq); S.done(cur); }
        PG8_STAMP();
        if (!has_next) break;
#pragma unroll
        for (int a = 0; a < 2; ++a)
#pragma unroll
            for (int b = 0; b < 2; ++b)
#pragma unroll
                for (int m = 0; m < 4; ++m)
#pragma unroll
                    for (int n = 0; n < 2; ++n) acc[a][b][m][n] = (f32x4){0.f, 0.f, 0.f, 0.f};
        cur = nxt; cA = nA; cB = nB; ++ui;
    }
    PG8_WAIT_V(0);
    if (wr == 0) PG8_BAR;
    PG8_BAR;
    if constexpr (Epi::AFTER_DRAIN) { E.fused(acc, cur, wr, wc, fr, fq, lds, wid, lane); S.done(cur); }
    PG8_STAMP();
    if (STAMP && wid == 0) { stamps[lane] = lane < nts ? (((unsigned long long)(unsigned)ts_hi << 32) | (unsigned)ts_lo) : 0ull;
        if (lane == 62) stamps[62] = rt_entry; if (lane == 63) stamps[63] = (unsigned long long)wall_clock64(); }
#undef PG8_STAMP
#undef PG8_SA
#undef PG8_SB
#undef PG8_STAGE
#undef PG8_LDA
#undef PG8_LDB
#undef PG8_MMA
#undef PG8_WAIT_V
#undef PG8_WAIT_L
#undef PG8_BAR
#undef PG8_SCHED
}
}
using pg8::bf16_t; using pg8::bf16x8; using pg8::f32x4; using pg8::Unit; using pg8::Gemm;
typedef short s16x4 __attribute__((ext_vector_type(4)));
typedef float f32x2 __attribute__((ext_vector_type(2)));

constexpr int NB = 4, SEQ = 4096, TT = NB * SEQ, DM = 2048, DFF = 8192;
constexpr int NWIN = 9216;
constexpr int LDPR = 3360;
constexpr int NIN = 29;
constexpr float SC_LOG2E = 0.08838834764831845f * 1.4426950408889634f;

constexpr size_t al4k(size_t x) { return (x + 4095) & ~(size_t)4095; }
constexpr size_t OFF_CTL  = 0;
constexpr size_t OFF_MISC = 65536;
constexpr size_t OFF_ROPE = 1u << 20;
constexpr size_t OFF_WIN  = OFF_ROPE + (size_t)TT * 16 * 8;
constexpr size_t OFF_W1T  = OFF_WIN + (size_t)NWIN * 2048 * 2;
constexpr size_t OFF_W2T  = OFF_W1T + (size_t)512 * 4096 * 2;
constexpr size_t OFF_LORA = OFF_W2T + (size_t)256 * 256 * 2;
constexpr size_t OFF_U    = al4k(OFF_LORA + (size_t)3072 * 384 * 2);
constexpr size_t OFF_QK   = OFF_U + (size_t)TT * 2048 * 2;
constexpr size_t OFF_VT   = OFF_QK + (size_t)TT * 4096 * 2;
constexpr size_t OFF_G    = OFF_VT + (size_t)NB * 1536 * SEQ * 2;
constexpr size_t OFF_PR   = OFF_G + (size_t)TT * 32 * 4;
constexpr size_t OFF_D    = al4k(OFF_PR + (size_t)TT * LDPR * 2);
constexpr size_t DSZ      = (size_t)TT * 1024 * 2;
constexpr size_t OFF_AL   = OFF_D + 6 * DSZ;
constexpr size_t OFF_BON  = OFF_AL + (size_t)TT * 384 * 2;
constexpr size_t OFF_CMPA = OFF_BON + (size_t)TT * 16 * 4;
constexpr size_t OFF_H    = OFF_CMPA + (size_t)4096 * 4096 * 2;
constexpr size_t OFF_KC   = OFF_H + (size_t)4096 * 256 * 2;
constexpr size_t OFF_VCT  = OFF_KC + (size_t)NB * 2 * 256 * 128 * 2;
constexpr size_t OFF_YRAW = OFF_VCT + (size_t)NB * 2 * 128 * 256 * 2;
constexpr size_t WS_END   = OFF_YRAW + (size_t)TT * 1024 * 4;
constexpr size_t OFF_WG   = OFF_QK;
constexpr size_t OFF_WB   = OFF_WG + (size_t)6144 * 2048 * 2;
constexpr size_t OFF_WO   = OFF_WB + (size_t)6144 * 1024 * 2;
constexpr size_t OFF_WUP  = OFF_WO + (size_t)2048 * 2048 * 2;
constexpr size_t OFF_WDN  = OFF_WUP + (size_t)8192 * 2048 * 2;
static_assert(OFF_WDN + (size_t)2048 * 8192 * 2 <= OFF_VT, "W2 must fit in the QK region");
constexpr size_t OFF_Z    = OFF_D;
constexpr size_t OFF_T1A  = OFF_D;
constexpr size_t OFF_HID  = OFF_D;
static_assert(OFF_HID + (size_t)TT * 8192 * 2 <= WS_END, "h must fit");
constexpr size_t OFF_T1B  = OFF_VT;
static_assert(OFF_T1B + (size_t)TT * 2048 * 4 <= OFF_D, "t1b must fit before D");
constexpr size_t OFF_MRG  = OFF_YRAW;
constexpr size_t OFF_SCR  = OFF_PR;
static_assert(OFF_SCR + (size_t)256 * 256 * 256 * 4 <= OFF_D, "scratch must fit");
constexpr int LDS_CTLW = 156672;
constexpr int LDS_BYTES = LDS_CTLW + 1024;

struct Params { const void* in[NIN]; float* out; unsigned char* ws; int stage; int pad; };

DI bf16_t f2bf(float f) { unsigned u = __float_as_uint(f); u += 0x7fffu + ((u >> 16) & 1u); return (bf16_t)(u >> 16); }
DI float bf2f(bf16_t b) { return __uint_as_float(((unsigned)b) << 16); }
typedef __bf16 bf16v2 __attribute__((ext_vector_type(2)));
DI unsigned pack2(float lo, float hi) { const f32x2 v = {lo, hi}; return __builtin_bit_cast(unsigned, __builtin_convertvector(v, bf16v2)); }
DI float sigmoidf_(float x) { return __builtin_amdgcn_rcpf(1.f + __expf(-x)); }
DI float wave_sum(float v) {
#pragma unroll
    for (int o = 32; o > 0; o >>= 1) v += __shfl_xor(v, o);
    return v;
}
DI void unpack8(const uint4& u, float (&f)[8]) {
    f[0] = __uint_as_float(u.x << 16); f[1] = __uint_as_float(u.x & 0xffff0000u);
    f[2] = __uint_as_float(u.y << 16); f[3] = __uint_as_float(u.y & 0xffff0000u);
    f[4] = __uint_as_float(u.z << 16); f[5] = __uint_as_float(u.z & 0xffff0000u);
    f[6] = __uint_as_float(u.w << 16); f[7] = __uint_as_float(u.w & 0xffff0000u);
}
DI uint4 pack8(const float (&f)[8]) { uint4 u; u.x = pack2(f[0], f[1]); u.y = pack2(f[2], f[3]); u.z = pack2(f[4], f[5]); u.w = pack2(f[6], f[7]); return u; }

struct ListOrder {
    int n, G, c, mode;
    DI bool next(int i, Unit& u) const {
        if (mode == 2) {
            const int j = i / 3, b = i - 3 * j, tile = j * G + c; if (tile >= 512) return false;
            u.pm = tile >> 3; u.pn = b * 8 + (tile & 7); return true;
        }
        const int L = i * G + c; if (L >= n) return false;
        if (mode == 0) { u.pm = L; u.pn = L >> 3; }
        else if (mode == 1) { u.pm = L; u.pn = 0; }
        else { const int b = L >> 9, tile = L & 511; u.pm = b * 64 + (tile >> 3); u.pn = b * 8 + (tile & 7); }
        return true;
    }
    DI void a_ready(const Unit&) const {}
    DI void done(const Unit&) const {}
};
struct EpiWin {
    static constexpr bool PERM = true, AFTER_DRAIN = false;
    bf16_t* QK; bf16_t* VT; float* G; bf16_t* PR; const float2* rope;
    DI void operator()(const f32x4 (&acc)[2][2][4][2], const Unit& u, int wr, int wc, int fr, int fq) const {
        const int pn = u.pn;
        const int row0 = u.pm * 256 + wr * 64 + fr;
        const bool isV = (pn == 7) || (pn == 9) || (pn >= 18 && pn <= 21);
        if (isV) {
            const int vbase = (pn == 7) ? 0 : (pn == 9) ? 256 : 512 + (pn - 18) * 256;
#pragma unroll
            for (int ai = 0; ai < 2; ++ai)
#pragma unroll
                for (int m = 0; m < 4; ++m) {
                    const int row = row0 + ai * 128 + m * 16; const int b = row >> 12, s = row & 4095;
#pragma unroll
                    for (int bj = 0; bj < 2; ++bj) {
                        const int cu = bj * 128 + wc * 32 + fq * 8;
                        bf16_t* dst = VT + ((size_t)(b * 1536 + vbase + cu) * SEQ + s);
#pragma unroll
                        for (int n = 0; n < 2; ++n)
#pragma unroll
                            for (int e = 0; e < 4; ++e) dst[(size_t)(n * 4 + e) * SEQ] = f2bf(acc[ai][bj][m][n][e]);
                    }
                }
        } else if (pn >= 22) {
#pragma unroll
            for (int ai = 0; ai < 2; ++ai)
#pragma unroll
                for (int m = 0; m < 4; ++m) {
                    const int row = row0 + ai * 128 + m * 16;
#pragma unroll
                    for (int bj = 0; bj < 2; ++bj) {
                        const int cu = bj * 128 + wc * 32 + fq * 8;
                        const f32x4 v0 = acc[ai][bj][m][0], v1 = acc[ai][bj][m][1];
                        if (pn < 35 || cu < 32) {
                            const int col = (pn - 22) * 256 + cu;
                            uint4 o; o.x = pack2(v0[0], v0[1]); o.y = pack2(v0[2], v0[3]); o.z = pack2(v1[0], v1[1]); o.w = pack2(v1[2], v1[3]);
                            *(uint4*)(PR + (size_t)row * LDPR + col) = o;
                        } else if (cu < 56) {
                            *(f32x4*)(G + (size_t)row * 32 + (cu - 32)) = v0; *(f32x4*)(G + (size_t)row * 32 + (cu - 32) + 4) = v1;
                        }
                    }
                }
        } else {
            const int qoff = (pn <= 6) ? 0 : (pn == 8) ? -256 : -512;
            const bool dorope = (wc == 0) && (pn != 4) && (pn != 5);
            const bool lowhalf = fq < 2;
#pragma unroll
            for (int ai = 0; ai < 2; ++ai)
#pragma unroll
                for (int m = 0; m < 4; ++m) {
                    const int row = row0 + ai * 128 + m * 16;
#pragma unroll
                    for (int bj = 0; bj < 2; ++bj) {
                        f32x4 v0 = acc[ai][bj][m][0], v1 = acc[ai][bj][m][1];
                        if (dorope) {
                            const float2* rp = rope + (size_t)row * 16 + (fq & 1) * 8;
#pragma unroll
                            for (int e = 0; e < 4; ++e) {
                                const float2 c0 = rp[e], c1 = rp[4 + e];
                                const float p0 = __shfl_xor(v0[e], 32), p1 = __shfl_xor(v1[e], 32);
                                v0[e] = lowhalf ? (v0[e] * c0.x - p0 * c0.y) : (v0[e] * c0.x + p0 * c0.y);
                                v1[e] = lowhalf ? (v1[e] * c1.x - p1 * c1.y) : (v1[e] * c1.x + p1 * c1.y);
                            }
                        }
                        const int col = pn * 256 + qoff + bj * 128 + wc * 32 + fq * 8;
                        uint4 o; o.x = pack2(v0[0], v0[1]); o.y = pack2(v0[2], v0[3]); o.z = pack2(v1[0], v1[1]); o.w = pack2(v1[2], v1[3]);
                        *(uint4*)(QK + (size_t)row * 4096 + col) = o;
                    }
                }
        }
    }
};

typedef _Float16 f16x4 __attribute__((ext_vector_type(4)));
DI float gelu_tanh(float x) { const float t = 0.7978845608028654f * (x + 0.044715f * x * x * x); const float e = __expf(2.f * t); const float th = 1.f - 2.f / (e + 1.f); return 0.5f * x * (1.f + th); }

template <int ACT  > struct EpiBf {
    static constexpr bool PERM = true, AFTER_DRAIN = false;
    bf16_t* O; int ldc; int pm_mod, pn_mod; size_t grp_stride;
    DI void operator()(const f32x4 (&acc)[2][2][4][2], const Unit& u, int wr, int wc, int fr, int fq) const {
        int pm = u.pm, pn = u.pn; bf16_t* base = O;
        if (pm_mod) { base += (size_t)(pm / pm_mod) * grp_stride; pm %= pm_mod; pn %= pn_mod; }
        const int row0 = pm * 256 + wr * 64 + fr, col0 = pn * 256 + wc * 32 + fq * 8;
#pragma unroll
        for (int ai = 0; ai < 2; ++ai)
#pragma unroll
            for (int m = 0; m < 4; ++m) {
                bf16_t* rowp = base + (size_t)(row0 + ai * 128 + m * 16) * ldc + col0;
#pragma unroll
                for (int bj = 0; bj < 2; ++bj) {
                    float f[8];
#pragma unroll
                    for (int e = 0; e < 4; ++e) { f[e] = acc[ai][bj][m][0][e]; f[4 + e] = acc[ai][bj][m][1][e]; }
#pragma unroll
                    for (int e = 0; e < 8; ++e) { if (ACT == 1) f[e] = gelu_tanh(f[e]); else if (ACT == 2) { const float r = fmaxf(f[e], 0.f); f[e] = r * r; } }
                    *(uint4*)(rowp + bj * 128) = pack8(f);
                }
            }
    }
};

template <int KV> struct EpiCmp2 {
    static constexpr bool PERM = false, AFTER_DRAIN = false;
    bf16_t* KC; bf16_t* VCT; const float2* rope;
    DI void operator()(const f32x4 (&acc)[2][2][4][2], const Unit& u, int wr, int wc, int fr, int fq) const {
        constexpr int kv = KV;
        const int row0 = (u.pm & 7) * 256 + wr * 64 + fr;
        if (kv == 0) {
#pragma unroll
            for (int ai = 0; ai < 2; ++ai)
#pragma unroll
                for (int m = 0; m < 4; ++m) {
                    int rr = row0 + ai * 128 + m * 16; asm volatile("" : "+v"(rr)); __builtin_amdgcn_sched_barrier(0); const int b = rr >> 9, c = (rr & 511) >> 1, g = rr & 1;
                    f32x4 v0 = acc[ai][0][m][0], v1 = acc[ai][0][m][1];
                    if (wc == 0) {
                        const int tok = b * SEQ + (c < 255 ? 16 * c + 31 : 0);
                        const float2* rp = rope + (size_t)tok * 16 + fq * 4;
#pragma unroll
                        for (int e = 0; e < 4; ++e) { const float2 cs = rp[e]; const float a = v0[e], b2 = v1[e]; v0[e] = a * cs.x - b2 * cs.y; v1[e] = b2 * cs.x + a * cs.y; }
                    }
                    bf16_t* dst = KC + ((size_t)((b * 2 + g) * 256 + c) * 128 + wc * 32 + fq * 4);
                    uint2 o; o.x = pack2(v0[0], v0[1]); o.y = pack2(v0[2], v0[3]); *(uint2*)dst = o;
                    o.x = pack2(v1[0], v1[1]); o.y = pack2(v1[2], v1[3]); *(uint2*)(dst + 16) = o;
                }
        } else {
#pragma unroll
            for (int ai = 0; ai < 2; ++ai)
#pragma unroll
                for (int m = 0; m < 4; ++m) {
                    int rr = row0 + ai * 128 + m * 16; asm volatile("" : "+v"(rr)); __builtin_amdgcn_sched_barrier(0); const int b = rr >> 9, c = (rr & 511) >> 1, g = rr & 1;
                    bf16_t* dst = VCT + (size_t)((b * 2 + g) * 128 + wc * 32 + fq * 4) * 256 + c;
#pragma unroll
                    for (int n = 0; n < 2; ++n)
#pragma unroll
                        for (int e = 0; e < 4; ++e) dst[(n * 16 + e) * 256] = f2bf(acc[ai][1][m][n][e]);
                }
        }
    }
};

struct EpiMerge {
    static constexpr bool PERM = true, AFTER_DRAIN = false;
    const bf16_t* Z; const float* bias; float* scr; bf16_t* M;
    template <int MODE> DI void run(const f32x4 (&acc)[2][2][4][2], const bf16_t* zp, const float* bp, float* sp, bf16_t* mp) const {
        typedef unsigned u32x2 __attribute__((ext_vector_type(2)));
        GAS float* s = (GAS float*)sp;
#pragma unroll
        for (int bj = 0; bj < 2; ++bj)
#pragma unroll
            for (int n = 0; n < 2; ++n) {
                const f32x4 bv = *(const f32x4*)(bp + bj * 128 + n * 4);
#pragma unroll
                for (int ai = 0; ai < 2; ++ai) {
                    GAS const bf16_t* zr = (GAS const bf16_t*)(zp + (size_t)(ai * 128) * 2048 + bj * 128 + n * 4);
                    GAS bf16_t* mr = (GAS bf16_t*)(mp + (size_t)(ai * 128) * 2048 + bj * 128 + n * 4);
                    asm volatile("" : "+v"(zr), "+v"(mr), "+v"(s));
                    u32x2 zz[4]; f32x4 pv[4];
#pragma unroll
                    for (int m = 0; m < 4; ++m) { zz[m] = *(GAS const u32x2*)(zr + (size_t)m * 16 * 2048); if (MODE > 0) pv[m] = *(GAS const f32x4*)(s + m * 2048); }
#pragma unroll
                    for (int m = 0; m < 4; ++m) {
                        f32x4 v;
                        v[0] = sigmoidf_(acc[ai][bj][m][n][0] + bv[0]) * __uint_as_float(zz[m].x << 16);
                        v[1] = sigmoidf_(acc[ai][bj][m][n][1] + bv[1]) * __uint_as_float(zz[m].x & 0xffff0000u);
                        v[2] = sigmoidf_(acc[ai][bj][m][n][2] + bv[2]) * __uint_as_float(zz[m].y << 16);
                        v[3] = sigmoidf_(acc[ai][bj][m][n][3] + bv[3]) * __uint_as_float(zz[m].y & 0xffff0000u);
                        if (MODE > 0) v += pv[m];
                        if (MODE < 2) *(GAS f32x4*)(s + m * 2048) = v;
                        else { u32x2 o; o.x = pack2(v[0], v[1]); o.y = pack2(v[2], v[3]); *(GAS u32x2*)(mr + (size_t)m * 16 * 2048) = o; }
                    }
                    s += 4 * 2048;
                }
            }
    }
    DI void operator()(const f32x4 (&acc)[2][2][4][2], const Unit& u, int wr, int wc, int fr, int fq) const {
        const int b = u.pn >> 3, pn = u.pn & 7;
        const int row0 = u.pm * 256 + wr * 64 + fr, col0 = pn * 256 + wc * 32 + fq * 8;
        float* sp = scr + (size_t)blockIdx.x * 65536 + threadIdx.x * 4;
        const bf16_t* zp = Z + ((size_t)b * TT + row0) * 2048 + col0;
        bf16_t* mp = M + (size_t)row0 * 2048 + col0;
        const float* bp = bias + b * 2048 + col0;
        if (b == 0) run<0>(acc, zp, bp, sp, mp); else if (b == 1) run<1>(acc, zp, bp, sp, mp); else run<2>(acc, zp, bp, sp, mp);
    }
};
struct EpiF32 {
    static constexpr bool PERM = false, AFTER_DRAIN = false;
    float* C; int ldc;
    DI void operator()(const f32x4 (&acc)[2][2][4][2], const Unit& u, int wr, int wc, int fr, int fq) const {
        const int row0 = u.pm * 256 + wr * 64 + fr, col0 = u.pn * 256 + wc * 32 + 4 * fq;
#pragma unroll
        for (int ai = 0; ai < 2; ++ai)
#pragma unroll
            for (int m = 0; m < 4; ++m) { float* rowp = C + (size_t)(row0 + ai * 128 + m * 16) * ldc + col0;
#pragma unroll
                for (int bj = 0; bj < 2; ++bj)
#pragma unroll
                    for (int n = 0; n < 2; ++n) *(f32x4*)(rowp + bj * 128 + n * 16) = acc[ai][bj][m][n]; }
    }
};

template <class CM> DI void cvt_transpose(float* tile, const float* src, size_t ld_src, int K, int Ndst, bf16_t* dst, CM cm, int bid, int nblk) {
    int tid_l = threadIdx.x; asm volatile("" : "+v"(tid_l)); const int tid = tid_l, nkt = K >> 6, ntile = nkt * (Ndst >> 6);
    const int j = tid & 63, kb = tid >> 6;
    float cur[8];
    auto ld = [&](int t) { const int k0 = (t % nkt) << 6, n0 = (t / nkt) << 6; const int sc = cm(n0 + j);
#pragma unroll
        for (int i = 0; i < 8; ++i) cur[i] = (sc >= 0) ? __builtin_nontemporal_load(&src[(size_t)(k0 + kb + 8 * i) * ld_src + sc]) : 0.f; };
    int t = bid;
    if (t < ntile) ld(t);
    for (; t < ntile; t += nblk) {
        const int k0 = (t % nkt) << 6, n0 = (t / nkt) << 6;
        __syncthreads();
#pragma unroll
        for (int i = 0; i < 8; ++i) tile[(kb + 8 * i) * 65 + j] = cur[i];
        __syncthreads();
        if (t + nblk < ntile) ld(t + nblk);
        { const int kk = (tid & 7) * 8, nb = tid >> 3;
          float v[8];
#pragma unroll
          for (int i = 0; i < 8; ++i) v[i] = tile[(kk + i) * 65 + nb];
          *(uint4*)(dst + (size_t)(n0 + nb) * K + k0 + kk) = pack8(v); }
    }
}

DI void row_pass(const float* xin, const bf16_t* t1, const float* g1, float* xout, const float* g2, bf16_t* nout, int bid, int nblk) {
    int tid_l = threadIdx.x; asm volatile("" : "+v"(tid_l)); const int lane = tid_l & 63, w = tid_l >> 6;
    for (int row = bid * 8 + w; row < TT; row += nblk * 8) {
        f32x4 xv[8], tv[8]; float ss = 0.f;
#pragma unroll
        for (int i = 0; i < 8; ++i) { { const uint2 tb = *(const uint2*)(t1 + (size_t)row * DM + i * 256 + lane * 4); tv[i] = (f32x4){__uint_as_float(tb.x << 16), __uint_as_float(tb.x & 0xffff0000u), __uint_as_float(tb.y << 16), __uint_as_float(tb.y & 0xffff0000u)}; } xv[i] = *(const f32x4*)(xin + (size_t)row * DM + i * 256 + lane * 4);
            ss += tv[i][0] * tv[i][0] + tv[i][1] * tv[i][1] + tv[i][2] * tv[i][2] + tv[i][3] * tv[i][3]; }
        ss = wave_sum(ss); const float rs = rsqrtf(ss * (1.f / DM) + 1e-6f);
        float s2 = 0.f;
#pragma unroll
        for (int i = 0; i < 8; ++i) { const f32x4 gg = *(const f32x4*)(g1 + i * 256 + lane * 4); xv[i] += tv[i] * rs * gg; *(f32x4*)(xout + (size_t)row * DM + i * 256 + lane * 4) = xv[i];
            s2 += xv[i][0] * xv[i][0] + xv[i][1] * xv[i][1] + xv[i][2] * xv[i][2] + xv[i][3] * xv[i][3]; }
        if (nout) {
            s2 = wave_sum(s2); const float r2 = rsqrtf(s2 * (1.f / DM) + 1e-6f);
#pragma unroll
            for (int i = 0; i < 8; ++i) { const f32x4 gg = *(const f32x4*)(g2 + i * 256 + lane * 4); const f32x4 v = xv[i] * r2 * gg; uint2 o; o.x = pack2(v[0], v[1]); o.y = pack2(v[2], v[3]);
                *(uint2*)(nout + (size_t)row * DM + i * 256 + lane * 4) = o; }
        }
    }
}
DI void norm_pass(const float* xin, const float* g, bf16_t* nout, int bid, int nblk) {
    int tid_l = threadIdx.x; asm volatile("" : "+v"(tid_l)); const int lane = tid_l & 63, w = tid_l >> 6;
    for (int row = bid * 8 + w; row < TT; row += nblk * 8) {
        f32x4 xv[8]; float ss = 0.f;
#pragma unroll
        for (int i = 0; i < 8; ++i) { xv[i] = *(const f32x4*)(xin + (size_t)row * DM + i * 256 + lane * 4); ss += xv[i][0] * xv[i][0] + xv[i][1] * xv[i][1] + xv[i][2] * xv[i][2] + xv[i][3] * xv[i][3]; }
        ss = wave_sum(ss); const float rs = rsqrtf(ss * (1.f / DM) + 1e-6f);
#pragma unroll
        for (int i = 0; i < 8; ++i) { const f32x4 gg = *(const f32x4*)(g + i * 256 + lane * 4); const f32x4 v = xv[i] * rs * gg; uint2 o; o.x = pack2(v[0], v[1]); o.y = pack2(v[2], v[3]);
            *(uint2*)(nout + (size_t)row * DM + i * 256 + lane * 4) = o; }
    }
}

DI void rwkv_shift(const bf16_t* PR, const float* mu, bf16_t* Dr, bf16_t* Dk, bf16_t* Dv, bf16_t* AL, int gtid, int gthreads) {
    const int NCH = 432;
    for (size_t idx = gtid; idx < (size_t)TT * NCH; idx += gthreads) {
        const int tok = (int)(idx / NCH), ch = (int)(idx % NCH);
        if (ch >= 420) { *(uint4*)(AL + (size_t)tok * 384 + 288 + (ch - 420) * 8) = make_uint4(0, 0, 0, 0); continue; }
        const int j = ch * 8;
        float p[8], q[8], v[8];
        unpack8(*(const uint4*)(PR + (size_t)tok * LDPR + j), p);
        if ((tok & (SEQ - 1)) != 0) unpack8(*(const uint4*)(PR + (size_t)(tok - 1) * LDPR + j), q);
        else {
#pragma unroll
            for (int e = 0; e < 8; ++e) q[e] = 0.f; }
        const f32x4 m0 = *(const f32x4*)(mu + j), m1 = *(const f32x4*)(mu + j + 4);
#pragma unroll
        for (int e = 0; e < 8; ++e) v[e] = p[e] + (q[e] - p[e]) * (e < 4 ? m0[e] : m1[e - 4]);
        bf16_t* dst;
        if (j < 1024) dst = Dr + (size_t)tok * 1024 + j;
        else if (j < 2048) dst = Dk + (size_t)tok * 1024 + (j - 1024);
        else if (j < 3072) dst = Dv + (size_t)tok * 1024 + (j - 2048);
        else {
            dst = AL + (size_t)tok * 384 + (j - 3072);
            if (j < 3136) {
#pragma unroll
                for (int e = 0; e < 8; ++e) { const float ex = __expf(2.f * v[e]); v[e] = 1.f - 2.f / (ex + 1.f); } }
            else if (j >= 3200) {
#pragma unroll
                for (int e = 0; e < 8; ++e) v[e] = sigmoidf_(v[e]); }
        }
        *(uint4*)dst = pack8(v);
    }
}

DI void build_cmpa(const bf16_t* QK, const float* pe, bf16_t* CMPA, int gtid, int gthreads) {
    for (size_t idx = gtid; idx < (size_t)4096 * 512; idx += gthreads) {
        const int R = (int)(idx >> 9), ch = (int)(idx & 511);
        const int kv = R >> 11, rr = R & 2047, b = rr >> 9, c = (rr & 511) >> 1, g = rr & 1;
        const int i = ch >> 4, d = (ch & 15) * 8;
        uint4 o = make_uint4(0, 0, 0, 0);
        if (c < 255) {
            float v[8]; unpack8(*(const uint4*)(QK + (size_t)(b * SEQ + 16 * c + i) * 4096 + 1024 + kv * 256 + g * 128 + d), v);
            const float* pp = pe + (size_t)kv * 4096 + i * 128 + d;
            const f32x4 p0 = *(const f32x4*)pp, p1 = *(const f32x4*)(pp + 4);
#pragma unroll
            for (int e = 0; e < 4; ++e) { v[e] += p0[e]; v[4 + e] += p1[e]; }
            o = pack8(v);
        }
        *(uint4*)(CMPA + (size_t)R * 4096 + ch * 8) = o;
    }
}

DI void rwkv_prep(const bf16_t* Dr, bf16_t* Dk, bf16_t* Dkk, bf16_t* Dka, const float* k_k, const float* k_a, const float* r_k, float* BON, const float* WRAW, const float* w0, const float* a0, _Float16* Dw, int gtid, int gthreads) {
    for (size_t idx = gtid; idx < (size_t)TT * 128; idx += gthreads) {
        const size_t off = idx * 8; const int col = (int)(off & 1023);
        float k[8], a[8], r[8], kk[8], kp[8], ka[8];
        unpack8(*(const uint4*)(Dk + off), k); unpack8(*(const uint4*)(Dka + off), a); unpack8(*(const uint4*)(Dr + off), r);
        { f16x4 h0, h1; const f32x4 wr0 = *(const f32x4*)(WRAW + off), wr1 = *(const f32x4*)(WRAW + off + 4);
#pragma unroll
          for (int e = 0; e < 4; ++e) { h0[e] = (_Float16)(__expf(-0.6065306597126334f * sigmoidf_(wr0[e] + w0[col + e])) - 1.0f); h1[e] = (_Float16)(__expf(-0.6065306597126334f * sigmoidf_(wr1[e] + w0[col + 4 + e])) - 1.0f); }
          *(f16x4*)(Dw + off) = h0; *(f16x4*)(Dw + off + 4) = h1; }
#pragma unroll
        for (int e = 0; e < 8; ++e) a[e] = sigmoidf_(a[e] + a0[col + e]);
        float ss = 0.f, bs = 0.f;
#pragma unroll
        for (int e = 0; e < 8; ++e) { kk[e] = k[e] * k_k[col + e]; ss += kk[e] * kk[e]; kp[e] = k[e] * (1.f + (a[e] - 1.f) * k_a[col + e]); bs += r[e] * kp[e] * r_k[col + e]; }
        ss += __shfl_xor(ss, 1); ss += __shfl_xor(ss, 2); ss += __shfl_xor(ss, 4);
        bs += __shfl_xor(bs, 1); bs += __shfl_xor(bs, 2); bs += __shfl_xor(bs, 4);
        const float inv = 1.f / fmaxf(sqrtf(ss), 1e-12f);
#pragma unroll
        for (int e = 0; e < 8; ++e) { kk[e] *= inv; ka[e] = kk[e] * a[e]; }
        *(uint4*)(Dk + off) = pack8(kp); *(uint4*)(Dkk + off) = pack8(kk); *(uint4*)(Dka + off) = pack8(ka);
        if ((idx & 7) == 0) BON[idx >> 3] = bs;
    }
}

DI void rwkv_final(const float* YRAW, const bf16_t* Dv, const float* BON, const float* lw, const float* lb, bf16_t* Y3R, int gtid, int gthreads) {
    for (size_t idx = gtid; idx < (size_t)TT * 128; idx += gthreads) {
        const size_t off = idx * 8; const int col = (int)(off & 1023);
        const f32x4 y0 = *(const f32x4*)(YRAW + off), y1 = *(const f32x4*)(YRAW + off + 4);
        float y[8] = {y0[0], y0[1], y0[2], y0[3], y1[0], y1[1], y1[2], y1[3]};
        float s = 0.f;
#pragma unroll
        for (int e = 0; e < 8; ++e) s += y[e];
        s += __shfl_xor(s, 1); s += __shfl_xor(s, 2); s += __shfl_xor(s, 4);
        const float mean = s * (1.f / 64.f);
        float vs = 0.f;
#pragma unroll
        for (int e = 0; e < 8; ++e) { y[e] -= mean; vs += y[e] * y[e]; }
        vs += __shfl_xor(vs, 1); vs += __shfl_xor(vs, 2); vs += __shfl_xor(vs, 4);
        const float rs = rsqrtf(vs * (1.f / 64.f) + 64e-5f);
        float v[8], g[8], o[8]; unpack8(*(const uint4*)(Dv + off), v); unpack8(*(const uint4*)(Y3R + off), g);
        const float bon = BON[idx >> 3];
#pragma unroll
        for (int e = 0; e < 8; ++e) o[e] = (y[e] * rs * lw[col + e] + lb[col + e] + bon * v[e]) * g[e];
        *(uint4*)(Y3R + off) = pack8(o);
    }
}

#define MFMA16(a, b, c) __builtin_amdgcn_mfma_f32_16x16x32_bf16((a), (b), (c), 0, 0, 0)
constexpr int KPITCH = 288, VPITCH = 160, KTILE_B = 64 * KPITCH;
constexpr int DSTAGE = 2 * KTILE_B + 256 * VPITCH, NSTAGE = KTILE_B + 128 * VPITCH;

typedef unsigned u32x2_t __attribute__((ext_vector_type(2)));
DI float xrow_max(float x) {
    u32x2_t r = __builtin_amdgcn_permlane16_swap(__float_as_uint(x), __float_as_uint(x), false, false);
    x = fmaxf(__uint_as_float(r[0]), __uint_as_float(r[1]));
    r = __builtin_amdgcn_permlane32_swap(__float_as_uint(x), __float_as_uint(x), false, false);
    return fmaxf(__uint_as_float(r[0]), __uint_as_float(r[1]));
}
DI float xrow_sum(float x) {
    u32x2_t r = __builtin_amdgcn_permlane16_swap(__float_as_uint(x), __float_as_uint(x), false, false);
    x = __uint_as_float(r[0]) + __uint_as_float(r[1]);
    r = __builtin_amdgcn_permlane32_swap(__float_as_uint(x), __float_as_uint(x), false, false);
    return __uint_as_float(r[0]) + __uint_as_float(r[1]);
}
DI void qk_tile(const LAS unsigned char* Kt, const bf16x8 (&qf)[4], f32x4 (&s)[4], int lane) {
    const LAS unsigned char* kp = Kt + (lane & 15) * KPITCH + (lane >> 4) * 16;
    bf16x8 ka[4], kb[4];
#pragma unroll
    for (int ks = 0; ks < 4; ++ks) ka[ks] = *(const LAS bf16x8*)(kp + ks * 64);
#pragma unroll
    for (int sub = 0; sub < 4; ++sub) {
        if (sub < 3) {
#pragma unroll
            for (int ks = 0; ks < 4; ++ks) kb[ks] = *(const LAS bf16x8*)(kp + (sub + 1) * 16 * KPITCH + ks * 64);
        }
        __builtin_amdgcn_sched_barrier(0);
        f32x4 a = {0.f, 0.f, 0.f, 0.f};
#pragma unroll
        for (int ks = 0; ks < 4; ++ks) a = MFMA16(ka[ks], qf[ks], a);
        s[sub] = a;
        __builtin_amdgcn_sched_barrier(0);
        if (sub < 3) {
#pragma unroll
            for (int ks = 0; ks < 4; ++ks) ka[ks] = kb[ks];
        }
    }
}
template <int DVT, bool MASKED, class MaskFn> DI void softmax_pv(const LAS unsigned char* Vt, f32x4 (&s)[4], f32x4 (&o)[DVT], float& m, float& l, MaskFn valid, int lane, bool need_mask = true) {
    const int quad = lane >> 4, dv = lane & 15;
    bf16x8 vpre[4];
    { const LAS unsigned char* vp0 = Vt + dv * VPITCH + quad * 16;
#pragma unroll
      for (int i = 0; i < 4; ++i) vpre[i] = *(const LAS bf16x8*)(vp0 + i * 16 * VPITCH); }
    __builtin_amdgcn_sched_barrier(0);
    if (MASKED && need_mask) {
#pragma unroll
        for (int sub = 0; sub < 4; ++sub)
#pragma unroll
            for (int j = 0; j < 4; ++j) s[sub][j] = valid(sub * 16 + quad * 4 + j) ? s[sub][j] : -INFINITY;
    }
    float mx = fmaxf(fmaxf(s[0][0], s[0][1]), fmaxf(s[0][2], s[0][3]));
#pragma unroll
    for (int sub = 1; sub < 4; ++sub) mx = fmaxf(fmaxf(fmaxf(mx, s[sub][0]), fmaxf(s[sub][1], s[sub][2])), s[sub][3]);
    mx = fmaxf(mx, __shfl_xor(mx, 16)); mx = fmaxf(mx, __shfl_xor(mx, 32));
    const float mn = fmaxf(m, mx * SC_LOG2E);
    if (__any(mx * SC_LOG2E - m > 8.f)) {
        const float alpha = __builtin_amdgcn_exp2f(m - mn);
        m = mn; l *= alpha;
#pragma unroll
        for (int t = 0; t < DVT; ++t) o[t] *= alpha;
    }
    const float nm = -m;
    float ps = 0.f;
#pragma unroll
    for (int sub = 0; sub < 4; ++sub)
#pragma unroll
        for (int j = 0; j < 4; ++j) { const float p = __builtin_amdgcn_exp2f(__builtin_fmaf(s[sub][j], SC_LOG2E, nm)); s[sub][j] = p; ps += p; }
    l += ps;
#pragma unroll
    for (int k2 = 0; k2 < 2; ++k2) {
        union { unsigned u[4]; bf16x8 v; } pb;
        pb.u[0] = pack2(s[2 * k2][0], s[2 * k2][1]); pb.u[1] = pack2(s[2 * k2][2], s[2 * k2][3]);
        pb.u[2] = pack2(s[2 * k2 + 1][0], s[2 * k2 + 1][1]); pb.u[3] = pack2(s[2 * k2 + 1][2], s[2 * k2 + 1][3]);
        const LAS unsigned char* vp = Vt + dv * VPITCH + (k2 * 32 + quad * 8) * 2;
        bf16x8 va[4], vb[4];
#pragma unroll
        for (int i = 0; i < 4; ++i) va[i] = (k2 == 0) ? vpre[i] : *(const LAS bf16x8*)(vp + i * 16 * VPITCH);
#pragma unroll
        for (int g = 0; g < DVT / 4; ++g) {
            if (g + 1 < DVT / 4) {
#pragma unroll
                for (int i = 0; i < 4; ++i) vb[i] = *(const LAS bf16x8*)(vp + ((g + 1) * 4 + i) * 16 * VPITCH);
            }
            __builtin_amdgcn_sched_barrier(0);
#pragma unroll
            for (int i = 0; i < 4; ++i) o[g * 4 + i] = MFMA16(va[i], pb.v, o[g * 4 + i]);
            __builtin_amdgcn_sched_barrier(0);
            if (g + 1 < DVT / 4) {
#pragma unroll
                for (int i = 0; i < 4; ++i) va[i] = vb[i];
            }
        }
    }
}
DI void ldk(uint4 (&r)[2], const bf16_t* src, size_t ld, int tid) {
#pragma unroll
    for (int i = 0; i < 2; ++i) { const int c = tid + 512 * i; r[i] = *(const uint4*)(src + (size_t)(c >> 4) * ld + (c & 15) * 8); }
}
DI void stk(LAS unsigned char* Kt, const uint4 (&r)[2], int tid) {
#pragma unroll
    for (int i = 0; i < 2; ++i) { const int c = tid + 512 * i; *(LAS pg8::u32x4*)(Kt + (c >> 4) * KPITCH + (c & 15) * 16) = (pg8::u32x4){r[i].x, r[i].y, r[i].z, r[i].w}; }
}
template <int NCH> DI void ldv(uint4 (&r)[NCH], const bf16_t* src, size_t ld, int tid) {
#pragma unroll
    for (int i = 0; i < NCH; ++i) { const int c = tid + 512 * i; r[i] = *(const uint4*)(src + (size_t)(c >> 3) * ld + (c & 7) * 8); }
}
template <int NCH> DI void stv(LAS unsigned char* Vt, const uint4 (&r)[NCH], int tid) {
#pragma unroll
    for (int i = 0; i < NCH; ++i) { const int c = tid + 512 * i; const int ch = c & 7, lc = ch & 3;
        LAS unsigned char* p = Vt + (c >> 3) * VPITCH + ((ch >> 2) * 32 + 16 * (lc & 1) + 4 * (lc >> 1)) * 2;
        typedef unsigned u32x2 __attribute__((ext_vector_type(2)));
        *(LAS u32x2*)p = (u32x2){r[i].x, r[i].y}; *(LAS u32x2*)(p + 16) = (u32x2){r[i].z, r[i].w}; }
}


template <class R, class NextFn, class LoadFn, class StoreFn, class ComputeFn>
DI void tile_pipeline(NextFn next, LoadFn load, StoreFn store, ComputeFn compute) {
    R A, B;
    int tA = next(), tB = (tA >= 0) ? next() : -1;
    if (tA >= 0) load(A, tA);
    if (tB >= 0) load(B, tB);
    while (tA >= 0) {
        __syncthreads(); store(A, 0); __syncthreads();
        const int tC = (tB >= 0) ? next() : -1;
        if (tC >= 0) load(A, tC);
        compute(tA, 0);
        if (tB < 0) break;
        __syncthreads(); store(B, 0); __syncthreads();
        const int tD = (tC >= 0) ? next() : -1;
        if (tD >= 0) load(B, tD);
        compute(tB, 0);
        tA = tC; tB = tD;
    }
    __syncthreads();
}
struct RegsKV { uint4 k[2], v[2]; };
struct RegsK { uint4 k[2]; };
struct RegsD { uint4 k0[2], k1[2], v[4]; };

DI void diff_unit(const bf16_t* QK, const bf16_t* VT, const float* subln, float lam_full, float out_scale, bf16_t* Y, int b, int h, int qt, LAS unsigned char* lds) {
    int tid_l = threadIdx.x; asm volatile("" : "+v"(tid_l)); const int tid = tid_l, lane = tid & 63, w = tid >> 6, mm = w >> 2, quad = lane >> 4;
    const int q0 = qt * 64, t = q0 + (w & 3) * 16 + (lane & 15);
    LAS unsigned char* K0 = lds; LAS unsigned char* Vt = lds + 2 * KTILE_B;
    bf16x8 qf[4];
    { const bf16_t* qp = QK + (size_t)(b * SEQ + t) * 4096 + 2048 + (h * 2 + mm) * 128 + quad * 8;
#pragma unroll
      for (int ks = 0; ks < 4; ++ks) qf[ks] = *(const bf16x8*)(qp + ks * 32); }
    f32x4 o[16];
#pragma unroll
    for (int i = 0; i < 16; ++i) o[i] = (f32x4){0.f, 0.f, 0.f, 0.f};
    float m = -1e30f, l = 0.f;
    const bf16_t* kbase = QK + (size_t)b * SEQ * 4096 + 3072 + h * 256;
    const bf16_t* vbase = VT + (size_t)(b * 1536 + 512 + h * 256) * SEQ;
    { int jn = 0;
      tile_pipeline<RegsD>(
        [&]() { return (jn <= qt) ? jn++ : -1; },
        [&](RegsD& R, int j) { const bf16_t* kp = kbase + (size_t)j * 64 * 4096; ldk(R.k0, kp, 4096, tid); ldk(R.k1, kp + 128, 4096, tid); ldv<4>(R.v, vbase + j * 64, SEQ, tid); },
        [&](RegsD& R, int bf) { stk(K0 + bf * DSTAGE, R.k0, tid); stk(K0 + bf * DSTAGE + KTILE_B, R.k1, tid); stv<4>(Vt + bf * DSTAGE, R.v, tid); },
        [&](int j, int bf) { f32x4 s[4]; qk_tile(K0 + bf * DSTAGE + mm * KTILE_B, qf, s, lane); const int kb = j * 64;
                     softmax_pv<16, true>(Vt + bf * DSTAGE, s, o, m, l, [&](int kidx) { return kb + kidx <= t; }, lane, j == qt); }); }
    l += __shfl_xor(l, 16); l += __shfl_xor(l, 32);
    const float inv = 1.f / l;
    __syncthreads();
    float* xb = (float*)lds;
    if (mm == 1) {
#pragma unroll
        for (int i = 0; i < 16; ++i) *(f32x4*)(xb + ((size_t)((w & 3) * 16 + (lane & 15)) * 256 + i * 16 + quad * 4)) = o[i] * (inv * lam_full);
    }
    __syncthreads();
    if (mm == 0) {
        float ss = 0.f;
#pragma unroll
        for (int i = 0; i < 16; ++i) { const f32x4 o1 = *(const f32x4*)(xb + ((size_t)((w & 3) * 16 + (lane & 15)) * 256 + i * 16 + quad * 4));
            o[i] = o[i] * inv - o1; ss += o[i][0] * o[i][0] + o[i][1] * o[i][1] + o[i][2] * o[i][2] + o[i][3] * o[i][3]; }
        ss += __shfl_xor(ss, 16); ss += __shfl_xor(ss, 32);
        const float rs = rsqrtf(ss * (1.f / 256.f) + 1e-5f) * out_scale;
        bf16_t* yp = Y + (size_t)(b * SEQ + t) * 1024 + h * 256 + quad * 4;
#pragma unroll
        for (int i = 0; i < 16; ++i) { const f32x4 g = *(const f32x4*)(subln + i * 16 + quad * 4); const f32x4 v = o[i] * rs * g; uint2 pk; pk.x = pack2(v[0], v[1]); pk.y = pack2(v[2], v[3]); *(uint2*)(yp + i * 16) = pk; }
    }
    __syncthreads();
}

DI void nsa_unit(const bf16_t* QK, const bf16_t* VT, const bf16_t* KC, const bf16_t* VCT, const float* G, bf16_t* Y, int b, int g, int qt, LAS unsigned char* lds) {
    int tid_l = threadIdx.x; asm volatile("" : "+v"(tid_l)); const int tid = tid_l, lane = tid & 63, w = tid >> 6, hh = w >> 1, quad = lane >> 4;
    const int q0 = qt * 32, ql = (w & 1) * 16 + (lane & 15), t = q0 + ql;
    LAS unsigned char* Kt = lds; LAS unsigned char* Vt = lds + KTILE_B;
    float* impA = (float*)(lds + 2 * NSTAGE);
    float* impB = impA + 4 * 32 * 64;
    unsigned long long* selm = (unsigned long long*)(impB + 4 * 32 * 64);
    const size_t tok = (size_t)b * SEQ + t;
    bf16x8 qf[4];
    { const bf16_t* qp = QK + tok * 4096 + (g * 4 + hh) * 128 + quad * 8;
#pragma unroll
      for (int ks = 0; ks < 4; ++ks) qf[ks] = *(const bf16x8*)(qp + ks * 32); }
    const float* gp = G + tok * 32 + (g * 4 + hh) * 3;
    const float g0 = sigmoidf_(gp[0]), g1 = sigmoidf_(gp[1]), g2 = sigmoidf_(gp[2]);
    f32x4 out[8];
#pragma unroll
    for (int i = 0; i < 8; ++i) out[i] = (f32x4){0.f, 0.f, 0.f, 0.f};
    for (int i = tid; i < 2 * 4 * 32 * 64; i += 512) impA[i] = 0.f;
    f32x4 o[8];
    float m, l;
    const int ntc = (q0 >> 10) + 1;
    const bf16_t* kcb = KC + (size_t)(b * 2 + g) * 256 * 128;
    const bf16_t* vcb = VCT + (size_t)(b * 2 + g) * 128 * 256;
#pragma unroll
    for (int i = 0; i < 8; ++i) o[i] = (f32x4){0.f, 0.f, 0.f, 0.f};
    m = -1e30f; l = 0.f;
    { int jn = 0;
      tile_pipeline<RegsKV>(
        [&]() { return (jn < ntc) ? jn++ : -1; },
        [&](RegsKV& R, int j) { ldk(R.k, kcb + (size_t)j * 64 * 128, 128, tid); ldv<2>(R.v, vcb + j * 64, 256, tid); },
        [&](RegsKV& R, int bf) { stk(Kt + bf * NSTAGE, R.k, tid); stv<2>(Vt + bf * NSTAGE, R.v, tid); },
        [&](int j, int bf) { f32x4 s[4]; qk_tile(Kt + bf * NSTAGE, qf, s, lane); const int cb = j * 64;
                     softmax_pv<8, true>(Vt + bf * NSTAGE, s, o, m, l, [&](int kidx) { const int c = cb + kidx; return (c <= 254) && (16 * c + 31 <= t); }, lane); }); }
    l += __shfl_xor(l, 16); l += __shfl_xor(l, 32);
    const float invc = (l > 0.f) ? 1.f / l : 0.f;
#pragma unroll
    for (int i = 0; i < 8; ++i) out[i] += o[i] * (invc * g0);
    { int jn = 0;
      tile_pipeline<RegsK>(
        [&]() { return (jn < ntc) ? jn++ : -1; },
        [&](RegsK& R, int j) { ldk(R.k, kcb + (size_t)j * 64 * 128, 128, tid); },
        [&](RegsK& R, int bf) { stk(Kt + bf * NSTAGE, R.k, tid); },
        [&](int j, int bf) { f32x4 s[4]; qk_tile(Kt + bf * NSTAGE, qf, s, lane);
#pragma unroll
            for (int sub = 0; sub < 4; ++sub) {
                float p[4];
#pragma unroll
                for (int e = 0; e < 4; ++e) { const int c = j * 64 + sub * 16 + quad * 4 + e; const bool ok = (c <= 254) && (16 * c + 31 <= t);
                    p[e] = ok ? __builtin_amdgcn_exp2f(s[sub][e] * SC_LOG2E - m) * invc : 0.f; }
                const int jb = j * 16 + sub * 4 + quad;
                impA[(hh * 32 + ql) * 64 + jb] = p[0] + p[1] + p[2] + p[3];
                if (jb + 1 < 64) impB[(hh * 32 + ql) * 64 + jb + 1] = p[3];
            } }); }
    __syncthreads();
#pragma unroll 1
    for (int qi = 0; qi < 4; ++qi) {
        const int qq = w * 4 + qi, tq = q0 + qq, blk = tq >> 6;
        float v = 0.f;
#pragma unroll
        for (int h2 = 0; h2 < 4; ++h2) v += impA[(h2 * 32 + qq) * 64 + lane] + impB[(h2 * 32 + qq) * 64 + lane];
        if (lane == 0 || lane == blk || lane == blk - 1) v = 1e9f; else if (lane > blk) v = -INFINITY;
        int rank = 0;
#pragma unroll 2
        for (int jj = 0; jj < 64; ++jj) { const float o2 = __int_as_float(__builtin_amdgcn_readlane(__float_as_int(v), jj)); rank += (o2 > v || (o2 == v && jj < lane)) ? 1 : 0; }
        const unsigned long long msk = __ballot((rank < 16) && (lane <= blk));
        if (lane == 0) selm[qq] = msk;
    }
    __syncthreads();
    unsigned long long un = 0ull;
#pragma unroll 1
    for (int i = 0; i < 32; ++i) un |= selm[i];
    const unsigned long long my = selm[ql];
    {
        const bf16_t* kb = QK + (size_t)b * SEQ * 4096 + 1536 + g * 128;
        const bf16_t* vb = VT + (size_t)(b * 1536 + g * 128) * SEQ;
#pragma unroll
        for (int i = 0; i < 8; ++i) o[i] = (f32x4){0.f, 0.f, 0.f, 0.f};
        m = -1e30f; l = 0.f;
        unsigned long long rem = un;
        tile_pipeline<RegsKV>(
          [&]() { if (!rem) return -1; const int j = __builtin_ctzll(rem); rem &= rem - 1; return j; },
          [&](RegsKV& R, int j) { ldk(R.k, kb + (size_t)j * 64 * 4096, 4096, tid); ldv<2>(R.v, vb + j * 64, SEQ, tid); },
          [&](RegsKV& R, int bf) { stk(Kt + bf * NSTAGE, R.k, tid); stv<2>(Vt + bf * NSTAGE, R.v, tid); },
          [&](int j, int bf) { f32x4 s[4]; qk_tile(Kt + bf * NSTAGE, qf, s, lane); const bool sel = (my >> j) & 1ull; const int kbs = j * 64;
                       softmax_pv<8, true>(Vt + bf * NSTAGE, s, o, m, l, [&](int kidx) { return sel && (kbs + kidx <= t); }, lane, !__all(sel) || (kbs + 63 > q0)); });
        l += __shfl_xor(l, 16); l += __shfl_xor(l, 32);
        const float inv = (l > 0.f) ? 1.f / l : 0.f;
#pragma unroll
        for (int i = 0; i < 8; ++i) out[i] += o[i] * (inv * g1);
    }
    {
        const bf16_t* kb = QK + (size_t)b * SEQ * 4096 + 1792 + g * 128;
        const bf16_t* vb = VT + (size_t)(b * 1536 + 256 + g * 128) * SEQ;
#pragma unroll
        for (int i = 0; i < 8; ++i) o[i] = (f32x4){0.f, 0.f, 0.f, 0.f};
        m = -1e30f; l = 0.f;
        const int jlo = (q0 >= 511) ? ((q0 - 511) >> 6) : 0, jhi = q0 >> 6;
        { int jn = jlo;
          tile_pipeline<RegsKV>(
            [&]() { return (jn <= jhi) ? jn++ : -1; },
            [&](RegsKV& R, int j) { ldk(R.k, kb + (size_t)j * 64 * 4096, 4096, tid); ldv<2>(R.v, vb + j * 64, SEQ, tid); },
            [&](RegsKV& R, int bf) { stk(Kt + bf * NSTAGE, R.k, tid); stv<2>(Vt + bf * NSTAGE, R.v, tid); },
            [&](int j, int bf) { f32x4 s[4]; qk_tile(Kt + bf * NSTAGE, qf, s, lane); const int kbs = j * 64;
                         softmax_pv<8, true>(Vt + bf * NSTAGE, s, o, m, l, [&](int kidx) { return (unsigned)(t - (kbs + kidx)) < 512u; }, lane, (kbs + 63 > q0) || ((q0 + 31) - kbs >= 512)); }); }
        l += __shfl_xor(l, 16); l += __shfl_xor(l, 32);
        const float inv = (l > 0.f) ? 1.f / l : 0.f;
#pragma unroll
        for (int i = 0; i < 8; ++i) out[i] += o[i] * (inv * g2);
    }
    bf16_t* yp = Y + tok * 1024 + (g * 4 + hh) * 128 + quad * 4;
#pragma unroll
    for (int i = 0; i < 8; ++i) { uint2 pk; pk.x = pack2(out[i][0], out[i][1]); pk.y = pack2(out[i][2], out[i][3]); *(uint2*)(yp + i * 16) = pk; }
    __syncthreads();
}
template <int CTRL> DI float dpp_add(float x) { const int y = __builtin_amdgcn_update_dpp(0, __float_as_int(x), CTRL, 0xF, 0xF, true); return x + __int_as_float(y); }
DI float red16(float x) { x = dpp_add<0xB1>(x); x = dpp_add<0x4E>(x); x = dpp_add<0x141>(x); x = dpp_add<0x140>(x); return x; }
constexpr int SCH = 32, SBUF_F = 5 * SCH * 64 + SCH * 32;
DI void scan_unit(const bf16_t* Dr, const bf16_t* Dk, const bf16_t* Dv, const bf16_t* Dkk, const bf16_t* Dka, const _Float16* Dw, float* YRAW, int b, int h, int half, LAS unsigned char* lds) {
    int tid_l = threadIdx.x; asm volatile("" : "+v"(tid_l)); const int tid = tid_l, lane = tid & 63, w = tid >> 6;
    const int rl = w * 4 + (lane >> 4), kq = lane & 15;
    LAS float* buf = (LAS float*)lds;
    const size_t base = (size_t)b * SEQ * 1024 + h * 64;
    const int st_tok = tid >> 4, st_k = (tid & 15) * 4;
    const int sv_tok = (tid >> 3) & 31, sv_r = (tid & 7) * 4;
    uint2 g_r, g_k, g_kk, g_ka, g_w, g_v;
    auto gload = [&](int ck) {
        const size_t o = base + (size_t)(ck * SCH + st_tok) * 1024 + st_k;
        g_r = *(const uint2*)(Dr + o); g_k = *(const uint2*)(Dk + o); g_kk = *(const uint2*)(Dkk + o); g_ka = *(const uint2*)(Dka + o); g_w = *(const uint2*)(Dw + o);
        if (tid < 256) g_v = *(const uint2*)(Dv + base + (size_t)(ck * SCH + sv_tok) * 1024 + half * 32 + sv_r);
    };
    auto cvt4 = [&](const uint2& u) { f32x4 f; f[0] = __uint_as_float(u.x << 16); f[1] = __uint_as_float(u.x & 0xffff0000u); f[2] = __uint_as_float(u.y << 16); f[3] = __uint_as_float(u.y & 0xffff0000u); return f; };
    auto lstore = [&](int bi) {
        LAS float* p = buf + bi * SBUF_F + st_tok * 64 + st_k;
        *(LAS f32x4*)(p) = cvt4(g_r); *(LAS f32x4*)(p + SCH * 64) = cvt4(g_k); *(LAS f32x4*)(p + 2 * SCH * 64) = cvt4(g_kk); *(LAS f32x4*)(p + 3 * SCH * 64) = cvt4(g_ka);
        { union { uint2 u; _Float16 hh[4]; } c; c.u = g_w; f32x4 f; f[0] = 1.f + (float)c.hh[0]; f[1] = 1.f + (float)c.hh[1]; f[2] = 1.f + (float)c.hh[2]; f[3] = 1.f + (float)c.hh[3]; *(LAS f32x4*)(p + 4 * SCH * 64) = f; }
        if (tid < 256) *(LAS f32x4*)(buf + bi * SBUF_F + 5 * SCH * 64 + sv_tok * 32 + sv_r) = cvt4(g_v);
    };
    f32x4 st = {0.f, 0.f, 0.f, 0.f};
    gload(0);
    __syncthreads();
    lstore(0);
    __syncthreads();
    LAS float* ypart = buf + 2 * SBUF_F;
    float* yflush = YRAW + base + half * 32;
    for (int ck = 0; ck < SEQ / SCH; ++ck) {
        const int bi = ck & 1;
        if (ck + 1 < SEQ / SCH) gload(ck + 1);
        const LAS float* p = buf + bi * SBUF_F + kq * 4;
        const LAS float* pv = buf + bi * SBUF_F + 5 * SCH * 64 + rl;
        LAS float* yp = ypart + rl * 16 + kq;
#pragma unroll 4
        for (int tt = 0; tt < SCH; ++tt) {
            const f32x4 r4 = *(const LAS f32x4*)(p + tt * 64), k4 = *(const LAS f32x4*)(p + SCH * 64 + tt * 64), kk4 = *(const LAS f32x4*)(p + 2 * SCH * 64 + tt * 64),
                        ka4 = *(const LAS f32x4*)(p + 3 * SCH * 64 + tt * 64), w4 = *(const LAS f32x4*)(p + 4 * SCH * 64 + tt * 64);
            const float vv = pv[tt * 32];
            float dot = st[0] * kk4[0] + st[1] * kk4[1] + st[2] * kk4[2] + st[3] * kk4[3];
            dot = red16(dot);
            const float sa = -dot;
            st = st * w4 + ka4 * sa + k4 * vv;
            yp[tt * 512] = st[0] * r4[0] + st[1] * r4[1] + st[2] * r4[2] + st[3] * r4[3];
        }
        if (ck + 1 < SEQ / SCH) lstore(bi ^ 1);
        __syncthreads();
        { const int idx = tid * 2, tt = idx >> 5, r = idx & 31;
          const LAS float* ys = ypart + idx * 16;
          f32x4 a = *(const LAS f32x4*)ys + *(const LAS f32x4*)(ys + 4) + *(const LAS f32x4*)(ys + 8) + *(const LAS f32x4*)(ys + 12);
          f32x4 b2 = *(const LAS f32x4*)(ys + 16) + *(const LAS f32x4*)(ys + 20) + *(const LAS f32x4*)(ys + 24) + *(const LAS f32x4*)(ys + 28);
          *(f32x2*)(yflush + (size_t)(ck * SCH + tt) * 1024 + r) = (f32x2){(a[0] + a[1]) + (a[2] + a[3]), (b2[0] + b2[1]) + (b2[2] + b2[3])}; }
        __syncthreads();
    }
}
#define PH_BEGIN const Params* PP = &P; GAS unsigned char* wsg_ = (GAS unsigned char*)P.ws; asm volatile("" : "+s"(wsg_)); unsigned char* ws = (unsigned char*)wsg_; int tid = threadIdx.x; asm volatile("" : "+v"(tid)); int bid = blockIdx.x; asm volatile("" : "+s"(bid)); \
    const int G = gridDim.x; const int gtid = bid * 512 + tid, gthreads = G * 512; (void)gtid; (void)gthreads; (void)ws;
#define WSP(T, off) ((T*)(ws + (off)))
#define INP(i, stride) ((const float*)PP->in[i] + (size_t)L * (stride))
#define XB_TMO      128
#define XB_XCNT(j)  (256  + 64 * (j))
#define XB_XSUB(j)  (1280 + 64 * (j))
#define XB_XGEN(j)  (2304 + 64 * (j))
#define XB_TOP      3328
#define XB_TOPGEN   3392
#define XCD_BAR_WORDS 3456
#define XB_SPIN_CAP (1u << 18)

__device__ __forceinline__ unsigned xb_ld(unsigned* p)              { return __hip_atomic_load(p, __ATOMIC_RELAXED, __HIP_MEMORY_SCOPE_AGENT); }
__device__ __forceinline__ unsigned xb_add(unsigned* p, unsigned v) { return __hip_atomic_fetch_add(p, v, __ATOMIC_RELAXED, __HIP_MEMORY_SCOPE_AGENT); }
__device__ __forceinline__ unsigned xb_xcc_id() { return (unsigned)__builtin_amdgcn_s_getreg((3 << 11) | 20) & 0xFu; }
#define XB_SPIN(cond, bar) do { unsigned _sp = 0; while (cond) { __builtin_amdgcn_s_sleep(1); \
    if ((++_sp & 255u) == 0u) { if (xb_ld(&(bar)[XB_TMO])) break; if (_sp > XB_SPIN_CAP) { atomicAdd(&(bar)[XB_TMO], 1u); break; } } } } while (0)

struct XcdBarrier {
    unsigned* bar; unsigned x;
    volatile LAS unsigned* st;
};

__device__ __forceinline__ XcdBarrier xcd_barrier_post(unsigned* bar, volatile LAS unsigned* st) {
    XcdBarrier b; b.bar = bar; b.x = xb_xcc_id(); b.st = st;
    if (threadIdx.x == 0) (void)xb_add(&bar[XB_XCNT(b.x)], 1u);
    return b;
}
__device__ __forceinline__ void xcd_barrier_complete(unsigned* bar, unsigned x, unsigned& nloc, unsigned& nx) {
    const unsigned G = gridDim.x * gridDim.y * gridDim.z;
    unsigned sum, cnt, mine, sp = 0u;
    for (;;) {
        sum = 0u; cnt = 0u; mine = 0u;
#pragma unroll
        for (unsigned j = 0; j < 16; ++j) { const unsigned c = xb_ld(&bar[XB_XCNT(j)]); sum += c; cnt += (c > 0u) ? 1u : 0u; mine = (j == x) ? c : mine; }
        if (sum == G) break;
        __builtin_amdgcn_s_sleep(1);
        if ((++sp & 255u) == 0u) { if (xb_ld(&bar[XB_TMO])) break; if (sp > XB_SPIN_CAP) { atomicAdd(&bar[XB_TMO], 1u); break; } }
    }
    nloc = mine > 0u ? mine : 1u; nx = cnt > 0u ? cnt : 1u;
}

__device__ __forceinline__ void xcd_barrier(const XcdBarrier& b) {
    asm volatile("s_waitcnt vmcnt(0)" ::: "memory");
    __syncthreads();
    if (threadIdx.x == 0) {
        unsigned* bar = b.bar;
        __builtin_amdgcn_s_waitcnt(0);
        unsigned nloc = b.st[0], nx = b.st[1];
        if (nloc == 0u) { xcd_barrier_complete(bar, b.x, nloc, nx); b.st[0] = nloc; b.st[1] = nx; }
        const unsigned old = xb_add(&bar[XB_XSUB(b.x)], 1u);
        const unsigned gen = old / nloc;
        if (old + 1u == (gen + 1u) * nloc) {
            __builtin_amdgcn_fence(__ATOMIC_RELEASE, "agent");
            asm volatile("s_waitcnt vmcnt(0)" ::: "memory");
            const unsigned og = xb_add(&bar[XB_TOP], 1u);
            const unsigned tg = og / nx;
            if (og + 1u == (tg + 1u) * nx) xb_add(&bar[XB_TOPGEN], 1u);
            else XB_SPIN(xb_ld(&bar[XB_TOPGEN]) == tg, bar);
            __builtin_amdgcn_fence(__ATOMIC_ACQUIRE, "agent");
            xb_add(&bar[XB_XGEN(b.x)], 1u);
            asm volatile("s_waitcnt vmcnt(0)" ::: "memory");
        } else {
            XB_SPIN(xb_ld(&bar[XB_XGEN(b.x)]) == gen, bar);
            __builtin_amdgcn_fence(__ATOMIC_ACQUIRE, "agent");
            asm volatile("s_waitcnt vmcnt(0)" ::: "memory");
        }
    }
    __syncthreads();
}


constexpr size_t OFF_BAR = 8192;
#define GSYNC() do { XcdBarrier xb_; xb_.bar = (unsigned*)(P.ws + OFF_BAR); xb_.x = xb_xcc_id(); xb_.st = (volatile LAS unsigned*)(lds + LDS_CTLW + 64); xcd_barrier(xb_); } while (0)
template <int L> DI void layer_body(const Params& P, LAS unsigned char* lds, float* tile) {
        { PH_BEGIN
          const float* cmp_w1 = INP(8, 2 * 4096 * 256); const float* cmp_w2 = INP(9, 2 * 256 * 128);
          cvt_transpose(tile, INP(6, 2048 * 9016), 9016, 2048, NWIN, WSP(bf16_t, OFF_WIN), [](int n) { return n < 2560 ? n : (n < 8992 ? n + 24 : (n < 9016 ? n - 8992 + 2560 : -1)); }, bid, G);
          cvt_transpose(tile, cmp_w1, 256, 4096, 256, WSP(bf16_t, OFF_W1T), [](int n) { return n; }, bid, G);
          cvt_transpose(tile, cmp_w1 + (size_t)4096 * 256, 256, 4096, 256, WSP(bf16_t, OFF_W1T) + (size_t)256 * 4096, [](int n) { return n; }, bid, G);
          bf16_t* W2T = WSP(bf16_t, OFF_W2T);
          for (int i = gtid; i < 256 * 256; i += gthreads) { const int n = i >> 8, k = i & 255; W2T[i] = f2bf(cmp_w2[(size_t)(n >> 7) * 256 * 128 + (size_t)k * 128 + (n & 127)]); }
          const float* w_up_l = INP(14, 64 * 1024); const float* a_up = INP(16, 64 * 1024); const float* g_up = INP(17, 160 * 1024); bf16_t* LORA = WSP(bf16_t, OFF_LORA);
          for (int i = gtid; i < 3072 * 384; i += gthreads) {
            const int n = i / 384, k = i - n * 384, kind = n >> 10, c = n & 1023; float v = 0.f;
            if (kind == 0) { if (k < 64) v = w_up_l[(size_t)k * 1024 + c]; }
            else if (kind == 1) { if (k >= 64 && k < 128) v = a_up[(size_t)(k - 64) * 1024 + c]; }
            else { if (k >= 128 && k < 288) v = g_up[(size_t)(k - 128) * 1024 + c]; }
            LORA[i] = f2bf(v);
          }
          if (gtid == 0) { const float* dlam = INP(10, 512); const float lam_init = 0.8f - 0.6f * expf(-0.3f * (float)L);
            float s01 = 0.f, s23 = 0.f; for (int i = 0; i < 128; ++i) { s01 += dlam[i] * dlam[128 + i]; s23 += dlam[256 + i] * dlam[384 + i]; } WSP(float, OFF_MISC)[L] = expf(s01) - expf(s23) + lam_init; } }
        if (L == 0) cg::this_grid().sync(); else GSYNC();

        { PH_BEGIN
          pg8::StaticOrder S; S.init(TT, NWIN, G, bid); EpiWin E{WSP(bf16_t, OFF_QK), WSP(bf16_t, OFF_VT), WSP(float, OFF_G), WSP(bf16_t, OFF_PR), WSP(const float2, OFF_ROPE)};
          pg8::gemm_phase<EpiWin, pg8::StaticOrder>(lds, Gemm{WSP(bf16_t, OFF_U), WSP(bf16_t, OFF_WIN), TT, NWIN, 2048}, S, E, nullptr); }
        GSYNC();

        { PH_BEGIN
          bf16_t* Dr = WSP(bf16_t, OFF_D);
          rwkv_shift(WSP(bf16_t, OFF_PR), INP(12, 3360), Dr, Dr + (size_t)TT * 1024, Dr + (size_t)2 * TT * 1024, WSP(bf16_t, OFF_AL), gtid, gthreads);
          build_cmpa(WSP(bf16_t, OFF_QK), INP(7, 2 * 32 * 128), WSP(bf16_t, OFF_CMPA), gtid, gthreads); }
        GSYNC();

        { PH_BEGIN
          ListOrder S{16, G, G - 1 - bid, 0}; EpiBf<1> E{WSP(bf16_t, OFF_H), 256, 16, 1, 0};
          pg8::gemm_phase<EpiBf<1>, ListOrder>(lds, Gemm{WSP(bf16_t, OFF_CMPA), WSP(bf16_t, OFF_W1T), 4096, 512, 4096}, S, E, nullptr); }
        { PH_BEGIN
          int K384 = 384; asm volatile("" : "+s"(K384));
          if (bid < G - 16) {
          pg8::StaticOrder S; S.init(TT, 1024, G - 16, bid); EpiF32 E{WSP(float, OFF_YRAW), 1024};
          pg8::gemm_phase<EpiF32, pg8::StaticOrder>(lds, Gemm{WSP(bf16_t, OFF_AL), WSP(bf16_t, OFF_LORA), TT, 1024, K384}, S, E, nullptr); } }
        { PH_BEGIN
          int K384 = 384; asm volatile("" : "+s"(K384));
          if (bid < G - 16) {
          pg8::StaticOrder S; S.init(TT, 1024, G - 16, bid); EpiBf<0> E{WSP(bf16_t, OFF_D) + (size_t)4 * TT * 1024, 1024, 64, 4, 0};
          pg8::gemm_phase<EpiBf<0>, pg8::StaticOrder>(lds, Gemm{WSP(bf16_t, OFF_AL), WSP(bf16_t, OFF_LORA) + (size_t)1024 * 384, TT, 1024, K384}, S, E, nullptr); } }
        { PH_BEGIN
          int K384 = 384; asm volatile("" : "+s"(K384));
          if (bid < G - 16) {
          pg8::StaticOrder S; S.init(TT, 1024, G - 16, bid); EpiBf<0> E{WSP(bf16_t, OFF_PR) + (size_t)2 * TT * 1024, 1024, 64, 4, 0};
          pg8::gemm_phase<EpiBf<0>, pg8::StaticOrder>(lds, Gemm{WSP(bf16_t, OFF_AL), WSP(bf16_t, OFF_LORA) + (size_t)2048 * 384, TT, 1024, K384}, S, E, nullptr); } }
        GSYNC();

        { PH_BEGIN
          ListOrder S{8, G, bid, 1}; EpiCmp2<0> E{WSP(bf16_t, OFF_KC), WSP(bf16_t, OFF_VCT), WSP(const float2, OFF_ROPE)};
          pg8::gemm_phase<EpiCmp2<0>, ListOrder>(lds, Gemm{WSP(bf16_t, OFF_H), WSP(bf16_t, OFF_W2T), 2048, 256, 256}, S, E, nullptr); }
        { PH_BEGIN
          ListOrder S{8, G, G - 1 - bid, 1}; EpiCmp2<1> E{WSP(bf16_t, OFF_KC), WSP(bf16_t, OFF_VCT), WSP(const float2, OFF_ROPE)};
          pg8::gemm_phase<EpiCmp2<1>, ListOrder>(lds, Gemm{WSP(bf16_t, OFF_H) + (size_t)2048 * 256, WSP(bf16_t, OFF_W2T), 2048, 256, 256}, S, E, nullptr); }
        { PH_BEGIN
          bf16_t* Dr = WSP(bf16_t, OFF_D);
          rwkv_prep(Dr, Dr + (size_t)TT * 1024, Dr + (size_t)3 * TT * 1024, Dr + (size_t)4 * TT * 1024, INP(18, 1024), INP(19, 1024), INP(20, 1024), WSP(float, OFF_BON), WSP(float, OFF_YRAW), INP(13, 1024), INP(15, 1024), (_Float16*)(Dr + (size_t)5 * TT * 1024), gtid, gthreads); }
        GSYNC();

        {
            LAS int* qslot = (LAS int*)(lds + LDS_CTLW);
#ifndef DUP_F
#define DUP_F 1
#endif
            for (int rep = 0; rep < DUP_F; ++rep) { if (rep) GSYNC();
            const int myx = (int)(xb_xcc_id() & 7u);
#pragma unroll 1
            for (int qq = 0; qq < 8; ++qq) {
            const int xq = (myx + qq) & 7;
            for (;;) {
                PH_BEGIN
                __syncthreads();
                if (tid == 0) *qslot = (int)atomicAdd(WSP(unsigned, OFF_CTL) + 64 * L + 16 * rep + xq, 1u);
                __syncthreads();
                const int v = *qslot;
                if (v >= 16 + 256) break;
                bf16_t* Dr = WSP(bf16_t, OFF_D); bf16_t* Y3 = WSP(bf16_t, OFF_PR);
                if (v < 16) { const int u = xq * 16 + v;
                    scan_unit(Dr, Dr + (size_t)TT * 1024, Dr + (size_t)2 * TT * 1024, Dr + (size_t)3 * TT * 1024, Dr + (size_t)4 * TT * 1024, (const _Float16*)(Dr + (size_t)5 * TT * 1024), WSP(float, OFF_YRAW), u >> 5, (u >> 1) & 15, u & 1, lds); }
                else {
                    const int w = v - 16, r = w >> 2, k = w & 3;
                    if (k < 2) { const float lam_init = 0.8f - 0.6f * expf(-0.3f * (float)L); const int idx = 2 * xq + k;
                        diff_unit(WSP(bf16_t, OFF_QK), WSP(bf16_t, OFF_VT), INP(11, 256), WSP(float, OFF_MISC)[L], 1.f - lam_init, Y3 + (size_t)TT * 1024, idx >> 2, idx & 3, 63 - r, lds); }
                    else nsa_unit(WSP(bf16_t, OFF_QK), WSP(bf16_t, OFF_VT), WSP(bf16_t, OFF_KC), WSP(bf16_t, OFF_VCT), WSP(float, OFF_G), Y3, xq >> 1, xq & 1, 127 - 2 * r - (k - 2), lds);
                }
            }
            }
            }
        }
        GSYNC();

        { PH_BEGIN
          const float* w_gate = INP(23, 3 * 2048 * 2048); const float* w_branch = INP(25, 3 * 1024 * 2048);
#pragma unroll 1
          for (int b3 = 0; b3 < 3; ++b3) {
            cvt_transpose(tile, w_gate + (size_t)b3 * 2048 * 2048, 2048, 2048, 2048, WSP(bf16_t, OFF_WG) + (size_t)b3 * 2048 * 2048, [](int n) { return n; }, bid, G);
            cvt_transpose(tile, w_branch + (size_t)b3 * 1024 * 2048, 2048, 1024, 2048, WSP(bf16_t, OFF_WB) + (size_t)b3 * 2048 * 1024, [](int n) { return n; }, bid, G);
          }
          cvt_transpose(tile, INP(26, 2048 * 2048), 2048, 2048, 2048, WSP(bf16_t, OFF_WO), [](int n) { return n; }, bid, G);
          cvt_transpose(tile, INP(27, 2048 * 8192), 8192, 2048, 8192, WSP(bf16_t, OFF_WUP), [](int n) { return n; }, bid, G);
          cvt_transpose(tile, INP(28, 8192 * 2048), 2048, 8192, 2048, WSP(bf16_t, OFF_WDN), [](int n) { return n; }, bid, G);
          rwkv_final(WSP(float, OFF_YRAW), WSP(bf16_t, OFF_D) + (size_t)2 * TT * 1024, WSP(float, OFF_BON), INP(21, 1024), INP(22, 1024), WSP(bf16_t, OFF_PR) + (size_t)2 * TT * 1024, gtid, gthreads); }
        GSYNC();

        { PH_BEGIN
          ListOrder S{1536, G, bid, 3}; EpiBf<0> E{WSP(bf16_t, OFF_Z), 2048, 64, 8, (size_t)TT * 2048};
          pg8::gemm_phase<EpiBf<0>, ListOrder>(lds, Gemm{WSP(bf16_t, OFF_PR), WSP(bf16_t, OFF_WB), 3 * TT, 6144, 1024}, S, E, nullptr); }
        GSYNC();
        { PH_BEGIN
          ListOrder S{0, G, bid, 2}; EpiMerge E{WSP(bf16_t, OFF_Z), INP(24, 3 * 2048), WSP(float, OFF_SCR), WSP(bf16_t, OFF_MRG)};
          pg8::gemm_phase<EpiMerge, ListOrder>(lds, Gemm{WSP(bf16_t, OFF_U), WSP(bf16_t, OFF_WG), TT, 6144, 2048}, S, E, nullptr); }
        GSYNC();
        { PH_BEGIN
          pg8::StaticOrder S; S.init(TT, 2048, G, bid); EpiBf<0> E{WSP(bf16_t, OFF_T1A), 2048, 0, 0, 0};
          pg8::gemm_phase<EpiBf<0>, pg8::StaticOrder>(lds, Gemm{WSP(bf16_t, OFF_MRG), WSP(bf16_t, OFF_WO), TT, 2048, 2048}, S, E, nullptr); }
        GSYNC();
        { PH_BEGIN
          row_pass(L == 0 ? (const float*)PP->in[0] : PP->out, WSP(bf16_t, OFF_T1A), INP(3, 2048), PP->out, INP(4, 2048), WSP(bf16_t, OFF_U), bid, G); }
        GSYNC();
        { PH_BEGIN
          pg8::StaticOrder S; S.init(TT, DFF, G, bid); EpiBf<2> E{WSP(bf16_t, OFF_HID), DFF, 0, 0, 0};
          pg8::gemm_phase<EpiBf<2>, pg8::StaticOrder>(lds, Gemm{WSP(bf16_t, OFF_U), WSP(bf16_t, OFF_WUP), TT, DFF, 2048}, S, E, nullptr); }
        GSYNC();
        { PH_BEGIN
          pg8::StaticOrder S; S.init(TT, 2048, G, bid); EpiBf<0> E{WSP(bf16_t, OFF_T1B), 2048, 0, 0, 0};
          pg8::gemm_phase<EpiBf<0>, pg8::StaticOrder>(lds, Gemm{WSP(bf16_t, OFF_HID), WSP(bf16_t, OFF_WDN), TT, 2048, DFF}, S, E, nullptr); }
        GSYNC();
        { PH_BEGIN
          row_pass(PP->out, WSP(bf16_t, OFF_T1B), INP(5, 2048), PP->out, (const float*)PP->in[2] + 2048, (L == 0) ? WSP(bf16_t, OFF_U) : (bf16_t*)nullptr, bid, G); }
        GSYNC();

}

__global__ void __launch_bounds__(512, 2) fwd_megakernel(Params P) {
    extern __shared__ __attribute__((aligned(16))) unsigned char lds_raw[];
    LAS unsigned char* lds = (LAS unsigned char*)lds_raw;
    float* tile = (float*)lds_raw;
    if (threadIdx.x < 2) ((volatile LAS unsigned*)(lds + LDS_CTLW + 64))[threadIdx.x] = 0u;
    __syncthreads();
    (void)xcd_barrier_post((unsigned*)(P.ws + OFF_BAR), (volatile LAS unsigned*)(lds + LDS_CTLW + 64));
    { PH_BEGIN {
      const int* positions = (const int*)PP->in[1]; float2* ROPE = WSP(float2, OFF_ROPE);
      for (int i = gtid; i < TT * 16; i += gthreads) {
        const int tok = i >> 4, f = i & 15;
        const float inv = (float)pow(500000.0, -(double)f / 16.0);
        const float ang = (float)positions[tok] * inv;
        const double a = (double)ang; const double k = rint(a * 0.15915494309189535); const float r = (float)(a - k * 6.283185307179586);
        ROPE[i] = make_float2(__cosf(r), __sinf(r));
      }
      norm_pass((const float*)PP->in[0], (const float*)PP->in[2], WSP(bf16_t, OFF_U), bid, G); } }

    layer_body<0>(P, lds, tile);
    layer_body<1>(P, lds, tile);
}

extern "C" void kernel_launch(void* const* d_in, const int* in_sizes, int n_in, void* d_out, int out_size, void* d_ws, size_t ws_size, hipStream_t stream) {
    static int grid_blocks = 0;
    if (!grid_blocks) {
        int dev = 0, cus = 0, per_cu = 0;
        (void)hipGetDevice(&dev);
        (void)hipDeviceGetAttribute(&cus, hipDeviceAttributeMultiprocessorCount, dev);
        (void)hipFuncSetAttribute((const void*)fwd_megakernel, hipFuncAttributeMaxDynamicSharedMemorySize, LDS_BYTES);
        (void)hipOccupancyMaxActiveBlocksPerMultiprocessor(&per_cu, (const void*)fwd_megakernel, 512, LDS_BYTES);
        if (per_cu < 1) per_cu = 1;
        grid_blocks = cus * per_cu;
        if (ws_size < WS_END) fprintf(stderr, "kernel_launch: workspace too small: %zu < %zu\n", ws_size, (size_t)WS_END);
    }
    (void)hipMemsetAsync((char*)d_ws + OFF_CTL, 0, 32768, stream);
    Params p{};
    for (int k = 0; k < NIN; ++k) p.in[k] = d_in[k];
    p.out = (float*)d_out; p.ws = (unsigned char*)d_ws; p.stage = 0; p.pad = 0;
    void* args[] = {&p};
    hipError_t e = hipLaunchCooperativeKernel((const void*)fwd_megakernel, dim3(grid_blocks), dim3(512), args, LDS_BYTES, stream);
    if (e != hipSuccess) fprintf(stderr, "cooperative launch failed: %s (grid %d)\n", hipGetErrorString(e), grid_blocks);
}
```

```cpp
#include <hip/hip_runtime.h>
#include <hip/hip_cooperative_groups.h>
#include <cstdio>
#include <cstdint>
namespace cg = cooperative_groups;
#define DI __device__ __forceinline__
#define LAS __attribute__((address_space(3)))
#define GAS __attribute__((address_space(1)))
namespace pg8 {
#define PG8_LAS __attribute__((address_space(3)))
typedef unsigned short bf16_t;
typedef short bf16x8 __attribute__((ext_vector_type(8)));
typedef float f32x4 __attribute__((ext_vector_type(4)));
typedef unsigned u32x4 __attribute__((ext_vector_type(4)));
constexpr int BM = 256, BK = 64, HALF = 128, HTB = HALF * BK * 2  , STAGE_BYTES = 8 * HTB, NXCD = 8, WGM = 8;

__host__ __device__ __forceinline__ int lds_byte(int r, int c) { const int st = (r >> 4) * 2 + (c >> 5), rr = r & 15, cc = c & 31, ob = rr * 64 + cc * 2; return st * 1024 + (ob ^ (((ob >> 9) & 1) << 5)); }
__host__ __device__ __forceinline__ void stage_rc(int b, int& R, int& C) { const int st = b / 1024, sb = b % 1024, swz = sb ^ (((sb >> 9) & 1) << 5); R = (st >> 1) * 16 + swz / 64; C = (st & 1) * 32 + (swz % 64) / 2; }
__host__ __device__ __forceinline__ int perm32(int rho) { const int n = rho >> 4, i = rho & 15; return 8 * (i >> 2) + 4 * n + (i & 3); }

struct Unit { int pm, pn; };
struct Gemm { const bf16_t* A; const bf16_t* Bt; int M, N, K; };

struct StaticOrder {
    int nM, nN, nwg, G, c;
    __host__ __device__ void init(int M, int N, int G_, int c_) { nM = M / BM; nN = N / BM; nwg = nM * nN; G = G_; c = c_; }
    __host__ __device__ bool next(int i, Unit& u) const {
        const long L = (long)i * G + c; if (L >= nwg) return false;
        int wgid = (int)L; { const int q = nwg / NXCD, r = nwg % NXCD, xcd = wgid % NXCD, off = wgid / NXCD; wgid = (xcd < r ? xcd * (q + 1) : r * (q + 1) + (xcd - r) * q) + off; }
        const int nig = WGM * nN, gid = wgid / nig, fm = gid * WGM, gsz = (nM - fm) < WGM ? (nM - fm) : WGM;
        u.pm = fm + ((wgid % nig) % gsz); u.pn = (wgid % nig) / gsz; return true;
    }
    __device__ __forceinline__ void a_ready(const Unit&) const {}
    __device__ __forceinline__ void done(const Unit&) const {}
};
template <class Epi, class Sched, bool STAMP = false>
__device__ __forceinline__ void gemm_phase(PG8_LAS unsigned char* lds, const Gemm g, const Sched& S, const Epi& E, unsigned long long* stamps) {
    int tid_l = threadIdx.x; asm volatile("" : "+v"(tid_l)); const int tid = tid_l, wid = __builtin_amdgcn_readfirstlane(tid >> 6), lane = tid & 63, wr = wid >> 2, wc = wid & 3, fr = lane & 15, fq = lane >> 4;
    const int K = g.K, nt = K / BK;
    int ts_lo = 0, ts_hi = 0, nts = 0; const unsigned long long rt_entry = STAMP ? (unsigned long long)wall_clock64() : 0ull;
#define PG8_STAMP() do { if (STAMP && wid == 0 && nts < 64) { const unsigned long long _c = (unsigned long long)clock64(); \
        ts_lo = (lane == nts) ? (int)(unsigned)_c : ts_lo; ts_hi = (lane == nts) ? (int)(unsigned)(_c >> 32) : ts_hi; ++nts; } } while (0)
    PG8_STAMP();
    unsigned voffA[2], voffB[2];
#pragma unroll
    for (int i = 0; i < 2; ++i) { int R, C; stage_rc(tid * 16 + i * 8192, R, C); const int Rb = Epi::PERM ? ((R & ~31) + perm32(R & 31)) : R;
        voffA[i] = (unsigned)(R * K + C) * 2u; voffB[i] = (unsigned)(Rb * K + C) * 2u; }
    const size_t kstep = (size_t)(BK * 2);
    const size_t hstep = (size_t)HALF * K * 2;
    const size_t tstep = 2 * hstep;
    const unsigned ldsw = (unsigned)wid * 1024u;
    const int aoff = lds_byte(wr * 64 + fr, fq * 8), boff = lds_byte(wc * 32 + fr, fq * 8);
#define PG8_SA(b, h) (((b) * 2 + (h)) * HTB)
#define PG8_SB(b, h) ((4 + (b) * 2 + (h)) * HTB)
#define PG8_STAGE(bufoff, gbase, voff) do { _Pragma("unroll") for (int _i = 0; _i < 2; ++_i) \
        __builtin_amdgcn_global_load_lds((const unsigned*)((const char*)(gbase) + (voff)[_i]), (PG8_LAS unsigned*)(lds + (bufoff) + ldsw + _i * 8192), 16, 0, 0); } while (0)
#define PG8_LDA(dst, b, h) do { _Pragma("unroll") for (int m = 0; m < 4; ++m) _Pragma("unroll") for (int k = 0; k < 2; ++k) dst[m][k] = *(const PG8_LAS bf16x8*)(lds + PG8_SA(b, h) + aoff + m * 2048 + k * 1024); } while (0)
#define PG8_LDB(dst, b, h) do { _Pragma("unroll") for (int n = 0; n < 2; ++n) _Pragma("unroll") for (int k = 0; k < 2; ++k) dst[n][k] = *(const PG8_LAS bf16x8*)(lds + PG8_SB(b, h) + boff + n * 2048 + k * 1024); } while (0)
#define PG8_MMA(ai, bj, At, Bt) do { __builtin_amdgcn_s_setprio(1); _Pragma("unroll") for (int m = 0; m < 4; ++m) _Pragma("unroll") for (int n = 0; n < 2; ++n) _Pragma("unroll") for (int k = 0; k < 2; ++k) \
        acc[ai][bj][m][n] = __builtin_amdgcn_mfma_f32_16x16x32_bf16(Bt[n][k], At[m][k], acc[ai][bj][m][n], 0, 0, 0); __builtin_amdgcn_s_setprio(0); } while (0)
#define PG8_WAIT_V(n) asm volatile("s_waitcnt vmcnt(" #n ")" ::: "memory")
#define PG8_WAIT_L(n) asm volatile("s_waitcnt lgkmcnt(" #n ")" ::: "memory")
#define PG8_BAR __builtin_amdgcn_s_barrier()
#define PG8_SCHED __builtin_amdgcn_sched_barrier(0)
    Unit cur, nxt; int ui = 0;
    if (!S.next(0, cur)) return;
    f32x4 acc[2][2][4][2];
#pragma unroll
    for (int a = 0; a < 2; ++a)
#pragma unroll
        for (int b = 0; b < 2; ++b)
#pragma unroll
            for (int m = 0; m < 4; ++m)
#pragma unroll
                for (int n = 0; n < 2; ++n) acc[a][b][m][n] = (f32x4){0.f, 0.f, 0.f, 0.f};
    bf16x8 At[4][2], B0[2][2], B1[2][2];
    const char* cA = (const char*)g.A + (size_t)cur.pm * tstep; const char* cB = (const char*)g.Bt + (size_t)cur.pn * tstep;
    S.a_ready(cur);
    PG8_STAGE(PG8_SB(0, 0), cB, voffB); PG8_STAGE(PG8_SA(0, 0), cA, voffA); PG8_STAGE(PG8_SB(0, 1), cB + hstep, voffB); PG8_STAGE(PG8_SA(0, 1), cA + hstep, voffA);
    if (wr == 1) PG8_BAR;
    PG8_WAIT_V(4); PG8_BAR;
    PG8_STAGE(PG8_SB(1, 0), cB + kstep, voffB); PG8_STAGE(PG8_SA(1, 0), cA + kstep, voffA); PG8_STAGE(PG8_SB(1, 1), cB + hstep + kstep, voffB);
    PG8_WAIT_V(6); PG8_BAR;
    PG8_STAMP();
    for (;;) {
        const bool has_next = S.next(ui + 1, nxt);
        const char* nA = has_next ? (const char*)g.A + (size_t)nxt.pm * tstep : cA; const char* nB = has_next ? (const char*)g.Bt + (size_t)nxt.pn * tstep : cB;
        for (int t = 0; t < nt; t += 2) {
            const bool last = (t == nt - 2);
            const char* a1 = cA + (size_t)(t + 1) * kstep;
            const char* a2 = last ? nA : cA + (size_t)(t + 2) * kstep; const char* b2 = last ? nB : cB + (size_t)(t + 2) * kstep;
            const char* a3 = a2 + kstep; const char* b3 = b2 + kstep;
            if (last && has_next) S.a_ready(nxt);
            PG8_LDB(B0, 0, 0); PG8_SCHED; PG8_LDA(At, 0, 0); PG8_STAGE(PG8_SA(1, 1), a1 + hstep, voffA);
            PG8_WAIT_L(8); PG8_BAR; PG8_WAIT_L(0); PG8_MMA(0, 0, At, B0); PG8_BAR; PG8_SCHED;
            PG8_LDB(B1, 0, 1); PG8_STAGE(PG8_SB(0, 0), b2, voffB);
            PG8_BAR; PG8_WAIT_L(0); PG8_MMA(0, 1, At, B1); PG8_BAR;
            PG8_LDA(At, 0, 1); PG8_STAGE(PG8_SA(0, 0), a2, voffA);
            PG8_BAR; PG8_WAIT_L(0); PG8_MMA(1, 0, At, B0); PG8_BAR; PG8_SCHED;
            PG8_STAGE(PG8_SB(0, 1), b2 + hstep, voffB);
            PG8_WAIT_V(6); PG8_BAR; PG8_MMA(1, 1, At, B1); PG8_BAR;
            PG8_LDB(B0, 1, 0); PG8_SCHED; PG8_LDA(At, 1, 0); PG8_STAGE(PG8_SA(0, 1), a2 + hstep, voffA);
            PG8_WAIT_L(8); PG8_BAR; PG8_WAIT_L(0); PG8_MMA(0, 0, At, B0); PG8_BAR; PG8_SCHED;
            PG8_LDB(B1, 1, 1); PG8_STAGE(PG8_SB(1, 0), b3, voffB);
            PG8_BAR; PG8_WAIT_L(0); PG8_MMA(0, 1, At, B1); PG8_BAR;
            PG8_LDA(At, 1, 1); PG8_STAGE(PG8_SA(1, 0), a3, voffA);
            PG8_BAR; PG8_WAIT_L(0); PG8_MMA(1, 0, At, B0); PG8_BAR; PG8_SCHED;
            PG8_STAGE(PG8_SB(1, 1), b3 + hstep, voffB);
            PG8_WAIT_V(6); PG8_BAR; PG8_MMA(1, 1, At, B1); PG8_BAR;
        }
        PG8_STAMP();
        if constexpr (!Epi::AFTER_DRAIN) { E(acc, cur, wr, wc, fr, fq); S.done(cur); }
        PG8_STAMP();
        if (!has_next) break;
#pragma unroll
        for (int a = 0; a < 2; ++a)
#pragma unroll
            for (int b = 0; b < 2; ++b)
#pragma unroll
                for (int m = 0; m < 4; ++m)
#pragma unroll
                    for (int n = 0; n < 2; ++n) acc[a][b][m][n] = (f32x4){0.f, 0.f, 0.f, 0.f};
        cur = nxt; cA = nA; cB = nB; ++ui;
    }
    PG8_WAIT_V(0);
    if (wr == 0) PG8_BAR;
    PG8_BAR;
    if constexpr (Epi::AFTER_DRAIN) { E.fused(acc, cur, wr, wc, fr, fq, lds, wid, lane); S.done(cur); }
    PG8_STAMP();
    if (STAMP && wid == 0) { stamps[lane] = lane < nts ? (((unsigned long long)(unsigned)ts_hi << 32) | (unsigned)ts_lo) : 0ull;
        if (lane == 62) stamps[62] = rt_entry; if (lane == 63) stamps[63] = (unsigned long long)wall_clock64(); }
#undef PG8_STAMP
#undef PG8_SA
#undef PG8_SB
#undef PG8_STAGE
#undef PG8_LDA
#undef PG8_LDB
#undef PG8_MMA
#undef PG8_WAIT_V
#undef PG8_WAIT_L
#undef PG8_BAR
#undef PG8_SCHED
}
}
using pg8::bf16_t; using pg8::bf16x8; using pg8::f32x4; using pg8::Unit; using pg8::Gemm;
typedef short s16x4 __attribute__((ext_vector_type(4)));
typedef float f32x2 __attribute__((ext_vector_type(2)));

constexpr int NB = 4, SEQ = 4096, TT = NB * SEQ, DM = 2048, DFF = 8192;
constexpr int NWIN = 9216;
constexpr int LDPR = 3360;
constexpr int NIN = 29;
constexpr float SC_LOG2E = 0.08838834764831845f * 1.4426950408889634f;

constexpr size_t al4k(size_t x) { return (x + 4095) & ~(size_t)4095; }
constexpr size_t OFF_CTL  = 0;
constexpr size_t OFF_MISC = 65536;
constexpr size_t OFF_ROPE = 1u << 20;
constexpr size_t OFF_WIN  = OFF_ROPE + (size_t)TT * 16 * 8;
constexpr size_t OFF_W1T  = OFF_WIN + (size_t)NWIN * 2048 * 2;
constexpr size_t OFF_W2T  = OFF_W1T + (size_t)512 * 4096 * 2;
constexpr size_t OFF_LORA = OFF_W2T + (size_t)256 * 256 * 2;
constexpr size_t OFF_U    = al4k(OFF_LORA + (size_t)3072 * 384 * 2);
constexpr size_t OFF_QK   = OFF_U + (size_t)TT * 2048 * 2;
constexpr size_t OFF_VT   = OFF_QK + (size_t)TT * 4096 * 2;
constexpr size_t OFF_G    = OFF_VT + (size_t)NB * 1536 * SEQ * 2;
constexpr size_t OFF_PR   = OFF_G + (size_t)TT * 32 * 4;
constexpr size_t OFF_D    = al4k(OFF_PR + (size_t)TT * LDPR * 2);
constexpr size_t DSZ      = (size_t)TT * 1024 * 2;
constexpr size_t OFF_AL   = OFF_D + 6 * DSZ;
constexpr size_t OFF_BON  = OFF_AL + (size_t)TT * 384 * 2;
constexpr size_t OFF_CMPA = OFF_BON + (size_t)TT * 16 * 4;
constexpr size_t OFF_H    = OFF_CMPA + (size_t)4096 * 4096 * 2;
constexpr size_t OFF_KC   = OFF_H + (size_t)4096 * 256 * 2;
constexpr size_t OFF_VCT  = OFF_KC + (size_t)NB * 2 * 256 * 128 * 2;
constexpr size_t OFF_YRAW = OFF_VCT + (size_t)NB * 2 * 128 * 256 * 2;
constexpr size_t WS_END   = OFF_YRAW + (size_t)TT * 1024 * 4;
constexpr size_t OFF_WG   = OFF_QK;
constexpr size_t OFF_WB   = OFF_WG + (size_t)6144 * 2048 * 2;
constexpr size_t OFF_WO   = OFF_WB + (size_t)6144 * 1024 * 2;
constexpr size_t OFF_WUP  = OFF_WO + (size_t)2048 * 2048 * 2;
constexpr size_t OFF_WDN  = OFF_WUP + (size_t)8192 * 2048 * 2;
static_assert(OFF_WDN + (size_t)2048 * 8192 * 2 <= OFF_VT, "W2 must fit in the QK region");
constexpr size_t OFF_Z    = OFF_D;
constexpr size_t OFF_T1A  = OFF_D;
constexpr size_t OFF_HID  = OFF_D;
static_assert(OFF_HID + (size_t)TT * 8192 * 2 <= WS_END, "h must fit");
constexpr size_t OFF_T1B  = OFF_VT;
static_assert(OFF_T1B + (size_t)TT * 2048 * 4 <= OFF_D, "t1b must fit before D");
constexpr size_t OFF_MRG  = OFF_YRAW;
constexpr size_t OFF_SCR  = OFF_PR;
static_assert(OFF_SCR + (size_t)256 * 256 * 256 * 4 <= OFF_D, "scratch must fit");
constexpr int LDS_CTLW = 156672;
constexpr int LDS_BYTES = LDS_CTLW + 1024;

struct Params { const void* in[NIN]; float* out; unsigned char* ws; int stage; int pad; };

DI bf16_t f2bf(float f) { unsigned u = __float_as_uint(f); u += 0x7fffu + ((u >> 16) & 1u); return (bf16_t)(u >> 16); }
DI float bf2f(bf16_t b) { return __uint_as_float(((unsigned)b) << 16); }
typedef __bf16 bf16v2 __attribute__((ext_vector_type(2)));
DI unsigned pack2(float lo, float hi) { const f32x2 v = {lo, hi}; return __builtin_bit_cast(unsigned, __builtin_convertvector(v, bf16v2)); }
DI float sigmoidf_(float x) { return __builtin_amdgcn_rcpf(1.f + __expf(-x)); }
DI float wave_sum(float v) {
#pragma unroll
    for (int o = 32; o > 0; o >>= 1) v += __shfl_xor(v, o);
    return v;
}
DI void unpack8(const uint4& u, float (&f)[8]) {
    f[0] = __uint_as_float(u.x << 16); f[1] = __uint_as_float(u.x & 0xffff0000u);
    f[2] = __uint_as_float(u.y << 16); f[3] = __uint_as_float(u.y & 0xffff0000u);
    f[4] = __uint_as_float(u.z << 16); f[5] = __uint_as_float(u.z & 0xffff0000u);
    f[6] = __uint_as_float(u.w << 16); f[7] = __uint_as_float(u.w & 0xffff0000u);
}
DI uint4 pack8(const float (&f)[8]) { uint4 u; u.x = pack2(f[0], f[1]); u.y = pack2(f[2], f[3]); u.z = pack2(f[4], f[5]); u.w = pack2(f[6], f[7]); return u; }

struct ListOrder {
    int n, G, c, mode;
    DI bool next(int i, Unit& u) const {
        if (mode == 2) {
            const int j = i / 3, b = i - 3 * j, tile = j * G + c; if (tile >= 512) return false;
            u.pm = tile >> 3; u.pn = b * 8 + (tile & 7); return true;
        }
        const int L = i * G + c; if (L >= n) return false;
        if (mode == 0) { u.pm = L; u.pn = L >> 3; }
        else if (mode == 1) { u.pm = L; u.pn = 0; }
        else { const int b = L >> 9, tile = L & 511; u.pm = b * 64 + (tile >> 3); u.pn = b * 8 + (tile & 7); }
        return true;
    }
    DI void a_ready(const Unit&) const {}
    DI void done(const Unit&) const {}
};
struct EpiWin {
    static constexpr bool PERM = true, AFTER_DRAIN = false;
    bf16_t* QK; bf16_t* VT; float* G; bf16_t* PR; const float2* rope;
    DI void operator()(const f32x4 (&acc)[2][2][4][2], const Unit& u, int wr, int wc, int fr, int fq) const {
        const int pn = u.pn;
        const int row0 = u.pm * 256 + wr * 64 + fr;
        const bool isV = (pn == 7) || (pn == 9) || (pn >= 18 && pn <= 21);
        if (isV) {
            const int vbase = (pn == 7) ? 0 : (pn == 9) ? 256 : 512 + (pn - 18) * 256;
#pragma unroll
            for (int ai = 0; ai < 2; ++ai)
#pragma unroll
                for (int m = 0; m < 4; ++m) {
                    const int row = row0 + ai * 128 + m * 16; const int b = row >> 12, s = row & 4095;
#pragma unroll
                    for (int bj = 0; bj < 2; ++bj) {
                        const int cu = bj * 128 + wc * 32 + fq * 8;
                        bf16_t* dst = VT + ((size_t)(b * 1536 + vbase + cu) * SEQ + s);
#pragma unroll
                        for (int n = 0; n < 2; ++n)
#pragma unroll
                            for (int e = 0; e < 4; ++e) dst[(size_t)(n * 4 + e) * SEQ] = f2bf(acc[ai][bj][m][n][e]);
                    }
                }
        } else if (pn >= 22) {
#pragma unroll
            for (int ai = 0; ai < 2; ++ai)
#pragma unroll
                for (int m = 0; m < 4; ++m) {
                    const int row = row0 + ai * 128 + m * 16;
#pragma unroll
                    for (int bj = 0; bj < 2; ++bj) {
                        const int cu = bj * 128 + wc * 32 + fq * 8;
                        const f32x4 v0 = acc[ai][bj][m][0], v1 = acc[ai][bj][m][1];
                        if (pn < 35 || cu < 32) {
                            const int col = (pn - 22) * 256 + cu;
                            uint4 o; o.x = pack2(v0[0], v0[1]); o.y = pack2(v0[2], v0[3]); o.z = pack2(v1[0], v1[1]); o.w = pack2(v1[2], v1[3]);
                            *(uint4*)(PR + (size_t)row * LDPR + col) = o;
                        } else if (cu < 56) {
                            *(f32x4*)(G + (size_t)row * 32 + (cu - 32)) = v0; *(f32x4*)(G + (size_t)row * 32 + (cu - 32) + 4) = v1;
                        }
                    }
                }
        } else {
            const int qoff = (pn <= 6) ? 0 : (pn == 8) ? -256 : -512;
            const bool dorope = (wc == 0) && (pn != 4) && (pn != 5);
            const bool lowhalf = fq < 2;
#pragma unroll
            for (int ai = 0; ai < 2; ++ai)
#pragma unroll
                for (int m = 0; m < 4; ++m) {
                    const int row = row0 + ai * 128 + m * 16;
#pragma unroll
                    for (int bj = 0; bj < 2; ++bj) {
                        f32x4 v0 = acc[ai][bj][m][0], v1 = acc[ai][bj][m][1];
                        if (dorope) {
                            const float2* rp = rope + (size_t)row * 16 + (fq & 1) * 8;
#pragma unroll
                            for (int e = 0; e < 4; ++e) {
                                const float2 c0 = rp[e], c1 = rp[4 + e];
                                const float p0 = __shfl_xor(v0[e], 32), p1 = __shfl_xor(v1[e], 32);
                                v0[e] = lowhalf ? (v0[e] * c0.x - p0 * c0.y) : (v0[e] * c0.x + p0 * c0.y);
                                v1[e] = lowhalf ? (v1[e] * c1.x - p1 * c1.y) : (v1[e] * c1.x + p1 * c1.y);
                            }
                        }
                        const int col = pn * 256 + qoff + bj * 128 + wc * 32 + fq * 8;
                        uint4 o; o.x = pack2(v0[0], v0[1]); o.y = pack2(v0[2], v0[3]); o.z = pack2(v1[0], v1[1]); o.w = pack2(v1[2], v1[3]);
                        *(uint4*)(QK + (size_t)row * 4096 + col) = o;
                    }
                }
        }
    }
};

typedef _Float16 f16x4 __attribute__((ext_vector_type(4)));
DI float gelu_tanh(float x) { const float t = 0.7978845608028654f * (x + 0.044715f * x * x * x); const float e = __expf(2.f * t); const float th = 1.f - 2.f / (e + 1.f); return 0.5f * x * (1.f + th); }

template <int ACT  > struct EpiBf {
    static constexpr bool PERM = true, AFTER_DRAIN = false;
    bf16_t* O; int ldc; int pm_mod, pn_mod; size_t grp_stride;
    DI void operator()(const f32x4 (&acc)[2][2][4][2], const Unit& u, int wr, int wc, int fr, int fq) const {
        int pm = u.pm, pn = u.pn; bf16_t* base = O;
        if (pm_mod) { base += (size_t)(pm / pm_mod) * grp_stride; pm %= pm_mod; pn %= pn_mod; }
        const int row0 = pm * 256 + wr * 64 + fr, col0 = pn * 256 + wc * 32 + fq * 8;
#pragma unroll
        for (int ai = 0; ai < 2; ++ai)
#pragma unroll
            for (int m = 0; m < 4; ++m) {
                bf16_t* rowp = base + (size_t)(row0 + ai * 128 + m * 16) * ldc + col0;
#pragma unroll
                for (int bj = 0; bj < 2; ++bj) {
                    float f[8];
#pragma unroll
                    for (int e = 0; e < 4; ++e) { f[e] = acc[ai][bj][m][0][e]; f[4 + e] = acc[ai][bj][m][1][e]; }
#pragma unroll
                    for (int e = 0; e < 8; ++e) { if (ACT == 1) f[e] = gelu_tanh(f[e]); else if (ACT == 2) { const float r = fmaxf(f[e], 0.f); f[e] = r * r; } }
                    *(uint4*)(rowp + bj * 128) = pack8(f);
                }
            }
    }
};

template <int KV> struct EpiCmp2 {
    static constexpr bool PERM = false, AFTER_DRAIN = false;
    bf16_t* KC; bf16_t* VCT; const float2* rope;
    DI void operator()(const f32x4 (&acc)[2][2][4][2], const Unit& u, int wr, int wc, int fr, int fq) const {
        constexpr int kv = KV;
        const int row0 = (u.pm & 7) * 256 + wr * 64 + fr;
        if (kv == 0) {
#pragma unroll
            for (int ai = 0; ai < 2; ++ai)
#pragma unroll
                for (int m = 0; m < 4; ++m) {
                    int rr = row0 + ai * 128 + m * 16; asm volatile("" : "+v"(rr)); __builtin_amdgcn_sched_barrier(0); const int b = rr >> 9, c = (rr & 511) >> 1, g = rr & 1;
                    f32x4 v0 = acc[ai][0][m][0], v1 = acc[ai][0][m][1];
                    if (wc == 0) {
                        const int tok = b * SEQ + (c < 255 ? 16 * c + 31 : 0);
                        const float2* rp = rope + (size_t)tok * 16 + fq * 4;
#pragma unroll
                        for (int e = 0; e < 4; ++e) { const float2 cs = rp[e]; const float a = v0[e], b2 = v1[e]; v0[e] = a * cs.x - b2 * cs.y; v1[e] = b2 * cs.x + a * cs.y; }
                    }
                    bf16_t* dst = KC + ((size_t)((b * 2 + g) * 256 + c) * 128 + wc * 32 + fq * 4);
                    uint2 o; o.x = pack2(v0[0], v0[1]); o.y = pack2(v0[2], v0[3]); *(uint2*)dst = o;
                    o.x = pack2(v1[0], v1[1]); o.y = pack2(v1[2], v1[3]); *(uint2*)(dst + 16) = o;
                }
        } else {
#pragma unroll
            for (int ai = 0; ai < 2; ++ai)
#pragma unroll
                for (int m = 0; m < 4; ++m) {
                    int rr = row0 + ai * 128 + m * 16; asm volatile("" : "+v"(rr)); __builtin_amdgcn_sched_barrier(0); const int b = rr >> 9, c = (rr & 511) >> 1, g = rr & 1;
                    bf16_t* dst = VCT + (size_t)((b * 2 + g) * 128 + wc * 32 + fq * 4) * 256 + c;
#pragma unroll
                    for (int n = 0; n < 2; ++n)
#pragma unroll
                        for (int e = 0; e < 4; ++e) dst[(n * 16 + e) * 256] = f2bf(acc[ai][1][m][n][e]);
                }
        }
    }
};

struct EpiMerge {
    static constexpr bool PERM = true, AFTER_DRAIN = false;
    const bf16_t* Z; const float* bias; float* scr; bf16_t* M;
    template <int MODE> DI void run(const f32x4 (&acc)[2][2][4][2], const bf16_t* zp, const float* bp, float* sp, bf16_t* mp) const {
        typedef unsigned u32x2 __attribute__((ext_vector_type(2)));
        GAS float* s = (GAS float*)sp;
#pragma unroll
        for (int bj = 0; bj < 2; ++bj)
#pragma unroll
            for (int n = 0; n < 2; ++n) {
                const f32x4 bv = *(const f32x4*)(bp + bj * 128 + n * 4);
#pragma unroll
                for (int ai = 0; ai < 2; ++ai) {
                    GAS const bf16_t* zr = (GAS const bf16_t*)(zp + (size_t)(ai * 128) * 2048 + bj * 128 + n * 4);
                    GAS bf16_t* mr = (GAS bf16_t*)(mp + (size_t)(ai * 128) * 2048 + bj * 128 + n * 4);
                    asm volatile("" : "+v"(zr), "+v"(mr), "+v"(s));
                    u32x2 zz[4]; f32x4 pv[4];
#pragma unroll
                    for (int m = 0; m < 4; ++m) { zz[m] = *(GAS const u32x2*)(zr + (size_t)m * 16 * 2048); if (MODE > 0) pv[m] = *(GAS const f32x4*)(s + m * 2048); }
#pragma unroll
                    for (int m = 0; m < 4; ++m) {
                        f32x4 v;
                        v[0] = sigmoidf_(acc[ai][bj][m][n][0] + bv[0]) * __uint_as_float(zz[m].x << 16);
                        v[1] = sigmoidf_(acc[ai][bj][m][n][1] + bv[1]) * __uint_as_float(zz[m].x & 0xffff0000u);
                        v[2] = sigmoidf_(acc[ai][bj][m][n][2] + bv[2]) * __uint_as_float(zz[m].y << 16);
                        v[3] = sigmoidf_(acc[ai][bj][m][n][3] + bv[3]) * __uint_as_float(zz[m].y & 0xffff0000u);
                        if (MODE > 0) v += pv[m];
                        if (MODE < 2) *(GAS f32x4*)(s + m * 2048) = v;
                        else { u32x2 o; o.x = pack2(v[0], v[1]); o.y = pack2(v[2], v[3]); *(GAS u32x2*)(mr + (size_t)m * 16 * 2048) = o; }
                    }
                    s += 4 * 2048;
                }
            }
    }
    DI void operator()(const f32x4 (&acc)[2][2][4][2], const Unit& u, int wr, int wc, int fr, int fq) const {
        const int b = u.pn >> 3, pn = u.pn & 7;
        const int row0 = u.pm * 256 + wr * 64 + fr, col0 = pn * 256 + wc * 32 + fq * 8;
        float* sp = scr + (size_t)blockIdx.x * 65536 + threadIdx.x * 4;
        const bf16_t* zp = Z + ((size_t)b * TT + row0) * 2048 + col0;
        bf16_t* mp = M + (size_t)row0 * 2048 + col0;
        const float* bp = bias + b * 2048 + col0;
        if (b == 0) run<0>(acc, zp, bp, sp, mp); else if (b == 1) run<1>(acc, zp, bp, sp, mp); else run<2>(acc, zp, bp, sp, mp);
    }
};
struct EpiF32 {
    static constexpr bool PERM = false, AFTER_DRAIN = false;
    float* C; int ldc;
    DI void operator()(const f32x4 (&acc)[2][2][4][2], const Unit& u, int wr, int wc, int fr, int fq) const {
        const int row0 = u.pm * 256 + wr * 64 + fr, col0 = u.pn * 256 + wc * 32 + 4 * fq;
#pragma unroll
        for (int ai = 0; ai < 2; ++ai)
#pragma unroll
            for (int m = 0; m < 4; ++m) { float* rowp = C + (size_t)(row0 + ai * 128 + m * 16) * ldc + col0;
#pragma unroll
                for (int bj = 0; bj < 2; ++bj)
#pragma unroll
                    for (int n = 0; n < 2; ++n) *(f32x4*)(rowp + bj * 128 + n * 16) = acc[ai][bj][m][n]; }
    }
};

template <class CM> DI void cvt_transpose(float* tile, const float* src, size_t ld_src, int K, int Ndst, bf16_t* dst, CM cm, int bid, int nblk) {
    int tid_l = threadIdx.x; asm volatile("" : "+v"(tid_l)); const int tid = tid_l, nkt = K >> 6, ntile = nkt * (Ndst >> 6);
    const int j = tid & 63, kb = tid >> 6;
    float cur[8];
    auto ld = [&](int t) { const int k0 = (t % nkt) << 6, n0 = (t / nkt) << 6; const int sc = cm(n0 + j);
#pragma unroll
        for (int i = 0; i < 8; ++i) cur[i] = (sc >= 0) ? __builtin_nontemporal_load(&src[(size_t)(k0 + kb + 8 * i) * ld_src + sc]) : 0.f; };
    int t = bid;
    if (t < ntile) ld(t);
    for (; t < ntile; t += nblk) {
        const int k0 = (t % nkt) << 6, n0 = (t / nkt) << 6;
        __syncthreads();
#pragma unroll
        for (int i = 0; i < 8; ++i) tile[(kb + 8 * i) * 65 + j] = cur[i];
        __syncthreads();
        if (t + nblk < ntile) ld(t + nblk);
        { const int kk = (tid & 7) * 8, nb = tid >> 3;
          float v[8];
#pragma unroll
          for (int i = 0; i < 8; ++i) v[i] = tile[(kk + i) * 65 + nb];
          *(uint4*)(dst + (size_t)(n0 + nb) * K + k0 + kk) = pack8(v); }
    }
}

DI void row_pass(const float* xin, const bf16_t* t1, const float* g1, float* xout, const float* g2, bf16_t* nout, int bid, int nblk) {
    int tid_l = threadIdx.x; asm volatile("" : "+v"(tid_l)); const int lane = tid_l & 63, w = tid_l >> 6;
    for (int row = bid * 8 + w; row < TT; row += nblk * 8) {
        f32x4 xv[8], tv[8]; float ss = 0.f;
#pragma unroll
        for (int i = 0; i < 8; ++i) { { const uint2 tb = *(const uint2*)(t1 + (size_t)row * DM + i * 256 + lane * 4); tv[i] = (f32x4){__uint_as_float(tb.x << 16), __uint_as_float(tb.x & 0xffff0000u), __uint_as_float(tb.y << 16), __uint_as_float(tb.y & 0xffff0000u)}; } xv[i] = *(const f32x4*)(xin + (size_t)row * DM + i * 256 + lane * 4);
            ss += tv[i][0] * tv[i][0] + tv[i][1] * tv[i][1] + tv[i][2] * tv[i][2] + tv[i][3] * tv[i][3]; }
        ss = wave_sum(ss); const float rs = rsqrtf(ss * (1.f / DM) + 1e-6f);
        float s2 = 0.f;
#pragma unroll
        for (int i = 0; i < 8; ++i) { const f32x4 gg = *(const f32x4*)(g1 + i * 256 + lane * 4); xv[i] += tv[i] * rs * gg; *(f32x4*)(xout + (size_t)row * DM + i * 256 + lane * 4) = xv[i];
            s2 += xv[i][0] * xv[i][0] + xv[i][1] * xv[i][1] + xv[i][2] * xv[i][2] + xv[i][3] * xv[i][3]; }
        if (nout) {
            s2 = wave_sum(s2); const float r2 = rsqrtf(s2 * (1.f / DM) + 1e-6f);
#pragma unroll
            for (int i = 0; i < 8; ++i) { const f32x4 gg = *(const f32x4*)(g2 + i * 256 + lane * 4); const f32x4 v = xv[i] * r2 * gg; uint2 o; o.x = pack2(v[0], v[1]); o.y = pack2(v[2], v[3]);
                *(uint2*)(nout + (size_t)row * DM + i * 256 + lane * 4) = o; }
        }
    }
}
DI void norm_pass(const float* xin, const float* g, bf16_t* nout, int bid, int nblk) {
    int tid_l = threadIdx.x; asm volatile("" : "+v"(tid_l)); const int lane = tid_l & 63, w = tid_l >> 6;
    for (int row = bid * 8 + w; row < TT; row += nblk * 8) {
        f32x4 xv[8]; float ss = 0.f;
#pragma unroll
        for (int i = 0; i < 8; ++i) { xv[i] = *(const f32x4*)(xin + (size_t)row * DM + i * 256 + lane * 4); ss += xv[i][0] * xv[i][0] + xv[i][1] * xv[i][1] + xv[i][2] * xv[i][2] + xv[i][3] * xv[i][3]; }
        ss = wave_sum(ss); const float rs = rsqrtf(ss * (1.f / DM) + 1e-6f);
#pragma unroll
        for (int i = 0; i < 8; ++i) { const f32x4 gg = *(const f32x4*)(g + i * 256 + lane * 4); const f32x4 v = xv[i] * rs * gg; uint2 o; o.x = pack2(v[0], v[1]); o.y = pack2(v[2], v[3]);
            *(uint2*)(nout + (size_t)row * DM + i * 256 + lane * 4) = o; }
    }
}

DI void rwkv_shift(const bf16_t* PR, const float* mu, bf16_t* Dr, bf16_t* Dk, bf16_t* Dv, bf16_t* AL, int gtid, int gthreads) {
    const int NCH = 432;
    for (size_t idx = gtid; idx < (size_t)TT * NCH; idx += gthreads) {
        const int tok = (int)(idx / NCH), ch = (int)(idx % NCH);
        if (ch >= 420) { *(uint4*)(AL + (size_t)tok * 384 + 288 + (ch - 420) * 8) = make_uint4(0, 0, 0, 0); continue; }
        const int j = ch * 8;
        float p[8], q[8], v[8];
        unpack8(*(const uint4*)(PR + (size_t)tok * LDPR + j), p);
        if ((tok & (SEQ - 1)) != 0) unpack8(*(const uint4*)(PR + (size_t)(tok - 1) * LDPR + j), q);
        else {
#pragma unroll
            for (int e = 0; e < 8; ++e) q[e] = 0.f; }
        const f32x4 m0 = *(const f32x4*)(mu + j), m1 = *(const f32x4*)(mu + j + 4);
#pragma unroll
        for (int e = 0; e < 8; ++e) v[e] = p[e] + (q[e] - p[e]) * (e < 4 ? m0[e] : m1[e - 4]);
        bf16_t* dst;
        if (j < 1024) dst = Dr + (size_t)tok * 1024 + j;
        else if (j < 2048) dst = Dk + (size_t)tok * 1024 + (j - 1024);
        else if (j < 3072) dst = Dv + (size_t)tok * 1024 + (j - 2048);
        else {
            dst = AL + (size_t)tok * 384 + (j - 3072);
            if (j < 3136) {
#pragma unroll
                for (int e = 0; e < 8; ++e) { const float ex = __expf(2.f * v[e]); v[e] = 1.f - 2.f / (ex + 1.f); } }
            else if (j >= 3200) {
#pragma unroll
                for (int e = 0; e < 8; ++e) v[e] = sigmoidf_(v[e]); }
        }
        *(uint4*)dst = pack8(v);
    }
}

DI void build_cmpa(const bf16_t* QK, const float* pe, bf16_t* CMPA, int gtid, int gthreads) {
    for (size_t idx = gtid; idx < (size_t)4096 * 512; idx += gthreads) {
        const int R = (int)(idx >> 9), ch = (int)(idx & 511);
        const int kv = R >> 11, rr = R & 2047, b = rr >> 9, c = (rr & 511) >> 1, g = rr & 1;
        const int i = ch >> 4, d = (ch & 15) * 8;
        uint4 o = make_uint4(0, 0, 0, 0);
        if (c < 255) {
            float v[8]; unpack8(*(const uint4*)(QK + (size_t)(b * SEQ + 16 * c + i) * 4096 + 1024 + kv * 256 + g * 128 + d), v);
            const float* pp = pe + (size_t)kv * 4096 + i * 128 + d;
            const f32x4 p0 = *(const f32x4*)pp, p1 = *(const f32x4*)(pp + 4);
#pragma unroll
            for (int e = 0; e < 4; ++e) { v[e] += p0[e]; v[4 + e] += p1[e]; }
            o = pack8(v);
        }
        *(uint4*)(CMPA + (size_t)R * 4096 + ch * 8) = o;
    }
}

DI void rwkv_prep(const bf16_t* Dr, bf16_t* Dk, bf16_t* Dkk, bf16_t* Dka, const float* k_k, const float* k_a, const float* r_k, float* BON, const float* WRAW, const float* w0, const float* a0, _Float16* Dw, int gtid, int gthreads) {
    for (size_t idx = gtid; idx < (size_t)TT * 128; idx += gthreads) {
        const size_t off = idx * 8; const int col = (int)(off & 1023);
        float k[8], a[8], r[8], kk[8], kp[8], ka[8];
        unpack8(*(const uint4*)(Dk + off), k); unpack8(*(const uint4*)(Dka + off), a); unpack8(*(const uint4*)(Dr + off), r);
        { f16x4 h0, h1; const f32x4 wr0 = *(const f32x4*)(WRAW + off), wr1 = *(const f32x4*)(WRAW + off + 4);
#pragma unroll
          for (int e = 0; e < 4; ++e) { h0[e] = (_Float16)(__expf(-0.6065306597126334f * sigmoidf_(wr0[e] + w0[col + e])) - 1.0f); h1[e] = (_Float16)(__expf(-0.6065306597126334f * sigmoidf_(wr1[e] + w0[col + 4 + e])) - 1.0f); }
          *(f16x4*)(Dw + off) = h0; *(f16x4*)(Dw + off + 4) = h1; }
#pragma unroll
        for (int e = 0; e < 8; ++e) a[e] = sigmoidf_(a[e] + a0[col + e]);
        float ss = 0.f, bs = 0.f;
#pragma unroll
        for (int e = 0; e < 8; ++e) { kk[e] = k[e] * k_k[col + e]; ss += kk[e] * kk[e]; kp[e] = k[e] * (1.f + (a[e] - 1.f) * k_a[col + e]); bs += r[e] * kp[e] * r_k[col + e]; }
        ss += __shfl_xor(ss, 1); ss += __shfl_xor(ss, 2); ss += __shfl_xor(ss, 4);
        bs += __shfl_xor(bs, 1); bs += __shfl_xor(bs, 2); bs += __shfl_xor(bs, 4);
        const float inv = 1.f / fmaxf(sqrtf(ss), 1e-12f);
#pragma unroll
        for (int e = 0; e < 8; ++e) { kk[e] *= inv; ka[e] = kk[e] * a[e]; }
        *(uint4*)(Dk + off) = pack8(kp); *(uint4*)(Dkk + off) = pack8(kk); *(uint4*)(Dka + off) = pack8(ka);
        if ((idx & 7) == 0) BON[idx >> 3] = bs;
    }
}

DI void rwkv_final(const float* YRAW, const bf16_t* Dv, const float* BON, const float* lw, const float* lb, bf16_t* Y3R, int gtid, int gthreads) {
    for (size_t idx = gtid; idx < (size_t)TT * 128; idx += gthreads) {
        const size_t off = idx * 8; const int col = (int)(off & 1023);
        const f32x4 y0 = *(const f32x4*)(YRAW + off), y1 = *(const f32x4*)(YRAW + off + 4);
        float y[8] = {y0[0], y0[1], y0[2], y0[3], y1[0], y1[1], y1[2], y1[3]};
        float s = 0.f;
#pragma unroll
        for (int e = 0; e < 8; ++e) s += y[e];
        s += __shfl_xor(s, 1); s += __shfl_xor(s, 2); s += __shfl_xor(s, 4);
        const float mean = s * (1.f / 64.f);
        float vs = 0.f;
#pragma unroll
        for (int e = 0; e < 8; ++e) { y[e] -= mean; vs += y[e] * y[e]; }
        vs += __shfl_xor(vs, 1); vs += __shfl_xor(vs, 2); vs += __shfl_xor(vs, 4);
        const float rs = rsqrtf(vs * (1.f / 64.f) + 64e-5f);
        float v[8], g[8], o[8]; unpack8(*(const uint4*)(Dv + off), v); unpack8(*(const uint4*)(Y3R + off), g);
        const float bon = BON[idx >> 3];
#pragma unroll
        for (int e = 0; e < 8; ++e) o[e] = (y[e] * rs * lw[col + e] + lb[col + e] + bon * v[e]) * g[e];
        *(uint4*)(Y3R + off) = pack8(o);
    }
}

#define MFMA16(a, b, c) __builtin_amdgcn_mfma_f32_16x16x32_bf16((a), (b), (c), 0, 0, 0)
constexpr int KPITCH = 288, VPITCH = 160, KTILE_B = 64 * KPITCH;
constexpr int DSTAGE = 2 * KTILE_B + 256 * VPITCH, NSTAGE = KTILE_B + 128 * VPITCH;

typedef unsigned u32x2_t __attribute__((ext_vector_type(2)));
DI float xrow_max(float x) {
    u32x2_t r = __builtin_amdgcn_permlane16_swap(__float_as_uint(x), __float_as_uint(x), false, false);
    x = fmaxf(__uint_as_float(r[0]), __uint_as_float(r[1]));
    r = __builtin_amdgcn_permlane32_swap(__float_as_uint(x), __float_as_uint(x), false, false);
    return fmaxf(__uint_as_float(r[0]), __uint_as_float(r[1]));
}
DI float xrow_sum(float x) {
    u32x2_t r = __builtin_amdgcn_permlane16_swap(__float_as_uint(x), __float_as_uint(x), false, false);
    x = __uint_as_float(r[0]) + __uint_as_float(r[1]);
    r = __builtin_amdgcn_permlane32_swap(__float_as_uint(x), __float_as_uint(x), false, false);
    return __uint_as_float(r[0]) + __uint_as_float(r[1]);
}
DI void qk_tile(const LAS unsigned char* Kt, const bf16x8 (&qf)[4], f32x4 (&s)[4], int lane) {
    const LAS unsigned char* kp = Kt + (lane & 15) * KPITCH + (lane >> 4) * 16;
    bf16x8 ka[4], kb[4];
#pragma unroll
    for (int ks = 0; ks < 4; ++ks) ka[ks] = *(const LAS bf16x8*)(kp + ks * 64);
#pragma unroll
    for (int sub = 0; sub < 4; ++sub) {
        if (sub < 3) {
#pragma unroll
            for (int ks = 0; ks < 4; ++ks) kb[ks] = *(const LAS bf16x8*)(kp + (sub + 1) * 16 * KPITCH + ks * 64);
        }
        __builtin_amdgcn_sched_barrier(0);
        f32x4 a = {0.f, 0.f, 0.f, 0.f};
#pragma unroll
        for (int ks = 0; ks < 4; ++ks) a = MFMA16(ka[ks], qf[ks], a);
        s[sub] = a;
        __builtin_amdgcn_sched_barrier(0);
        if (sub < 3) {
#pragma unroll
            for (int ks = 0; ks < 4; ++ks) ka[ks] = kb[ks];
        }
    }
}
template <int DVT, bool MASKED, class MaskFn> DI void softmax_pv(const LAS unsigned char* Vt, f32x4 (&s)[4], f32x4 (&o)[DVT], float& m, float& l, MaskFn valid, int lane, bool need_mask = true) {
    const int quad = lane >> 4, dv = lane & 15;
    bf16x8 vpre[4];
    { const LAS unsigned char* vp0 = Vt + dv * VPITCH + quad * 16;
#pragma unroll
      for (int i = 0; i < 4; ++i) vpre[i] = *(const LAS bf16x8*)(vp0 + i * 16 * VPITCH); }
    __builtin_amdgcn_sched_barrier(0);
    if (MASKED && need_mask) {
#pragma unroll
        for (int sub = 0; sub < 4; ++sub)
#pragma unroll
            for (int j = 0; j < 4; ++j) s[sub][j] = valid(sub * 16 + quad * 4 + j) ? s[sub][j] : -INFINITY;
    }
    float mx = fmaxf(fmaxf(s[0][0], s[0][1]), fmaxf(s[0][2], s[0][3]));
#pragma unroll
    for (int sub = 1; sub < 4; ++sub) mx = fmaxf(fmaxf(fmaxf(mx, s[sub][0]), fmaxf(s[sub][1], s[sub][2])), s[sub][3]);
    mx = fmaxf(mx, __shfl_xor(mx, 16)); mx = fmaxf(mx, __shfl_xor(mx, 32));
    const float mn = fmaxf(m, mx * SC_LOG2E);
    if (__any(mx * SC_LOG2E - m > 8.f)) {
        const float alpha = __builtin_amdgcn_exp2f(m - mn);
        m = mn; l *= alpha;
#pragma unroll
        for (int t = 0; t < DVT; ++t) o[t] *= alpha;
    }
    const float nm = -m;
    float ps = 0.f;
#pragma unroll
    for (int sub = 0; sub < 4; ++sub)
#pragma unroll
        for (int j = 0; j < 4; ++j) { const float p = __builtin_amdgcn_exp2f(__builtin_fmaf(s[sub][j], SC_LOG2E, nm)); s[sub][j] = p; ps += p; }
    l += ps;
#pragma unroll
    for (int k2 = 0; k2 < 2; ++k2) {
        union { unsigned u[4]; bf16x8 v; } pb;
        pb.u[0] = pack2(s[2 * k2][0], s[2 * k2][1]); pb.u[1] = pack2(s[2 * k2][2], s[2 * k2][3]);
        pb.u[2] = pack2(s[2 * k2 + 1][0], s[2 * k2 + 1][1]); pb.u[3] = pack2(s[2 * k2 + 1][2], s[2 * k2 + 1][3]);
        const LAS unsigned char* vp = Vt + dv * VPITCH + (k2 * 32 + quad * 8) * 2;
        bf16x8 va[4], vb[4];
#pragma unroll
        for (int i = 0; i < 4; ++i) va[i] = (k2 == 0) ? vpre[i] : *(const LAS bf16x8*)(vp + i * 16 * VPITCH);
#pragma unroll
        for (int g = 0; g < DVT / 4; ++g) {
            if (g + 1 < DVT / 4) {
#pragma unroll
                for (int i = 0; i < 4; ++i) vb[i] = *(const LAS bf16x8*)(vp + ((g + 1) * 4 + i) * 16 * VPITCH);
            }
            __builtin_amdgcn_sched_barrier(0);
#pragma unroll
            for (int i = 0; i < 4; ++i) o[g * 4 + i] = MFMA16(va[i], pb.v, o[g * 4 + i]);
            __builtin_amdgcn_sched_barrier(0);
            if (g + 1 < DVT / 4) {
#pragma unroll
                for (int i = 0; i < 4; ++i) va[i] = vb[i];
            }
        }
    }
}
DI void ldk(uint4 (&r)[2], const bf16_t* src, size_t ld, int tid) {
#pragma unroll
    for (int i = 0; i < 2; ++i) { const int c = tid + 512 * i; r[i] = *(const uint4*)(src + (size_t)(c >> 4) * ld + (c & 15) * 8); }
}
DI void stk(LAS unsigned char* Kt, const uint4 (&r)[2], int tid) {
#pragma unroll
    for (int i = 0; i < 2; ++i) { const int c = tid + 512 * i; *(LAS pg8::u32x4*)(Kt + (c >> 4) * KPITCH + (c & 15) * 16) = (pg8::u32x4){r[i].x, r[i].y, r[i].z, r[i].w}; }
}
template <int NCH> DI void ldv(uint4 (&r)[NCH], const bf16_t* src, size_t ld, int tid) {
#pragma unroll
    for (int i = 0; i < NCH; ++i) { const int c = tid + 512 * i; r[i] = *(const uint4*)(src + (size_t)(c >> 3) * ld + (c & 7) * 8); }
}
template <int NCH> DI void stv(LAS unsigned char* Vt, const uint4 (&r)[NCH], int tid) {
#pragma unroll
    for (int i = 0; i < NCH; ++i) { const int c = tid + 512 * i; const int ch = c & 7, lc = ch & 3;
        LAS unsigned char* p = Vt + (c >> 3) * VPITCH + ((ch >> 2) * 32 + 16 * (lc & 1) + 4 * (lc >> 1)) * 2;
        typedef unsigned u32x2 __attribute__((ext_vector_type(2)));
        *(LAS u32x2*)p = (u32x2){r[i].x, r[i].y}; *(LAS u32x2*)(p + 16) = (u32x2){r[i].z, r[i].w}; }
}


template <class R, class NextFn, class LoadFn, class StoreFn, class ComputeFn>
DI void tile_pipeline(NextFn next, LoadFn load, StoreFn store, ComputeFn compute) {
    R A, B;
    int tA = next(), tB = (tA >= 0) ? next() : -1;
    if (tA >= 0) load(A, tA);
    if (tB >= 0) load(B, tB);
    while (tA >= 0) {
        __syncthreads(); store(A, 0); __syncthreads();
        const int tC = (tB >= 0) ? next() : -1;
        if (tC >= 0) load(A, tC);
        compute(tA, 0);
        if (tB < 0) break;
        __syncthreads(); store(B, 0); __syncthreads();
        const int tD = (tC >= 0) ? next() : -1;
        if (tD >= 0) load(B, tD);
        compute(tB, 0);
        tA = tC; tB = tD;
    }
    __syncthreads();
}
struct RegsKV { uint4 k[2], v[2]; };
struct RegsK { uint4 k[2]; };
struct RegsD { uint4 k0[2], k1[2], v[4]; };

DI void diff_unit(const bf16_t* QK, const bf16_t* VT, const float* subln, float lam_full, float out_scale, bf16_t* Y, int b, int h, int qt, LAS unsigned char* lds) {
    int tid_l = threadIdx.x; asm volatile("" : "+v"(tid_l)); const int tid = tid_l, lane = tid & 63, w = tid >> 6, mm = w >> 2, quad = lane >> 4;
    const int q0 = qt * 64, t = q0 + (w & 3) * 16 + (lane & 15);
    LAS unsigned char* K0 = lds; LAS unsigned char* Vt = lds + 2 * KTILE_B;
    bf16x8 qf[4];
    { const bf16_t* qp = QK + (size_t)(b * SEQ + t) * 4096 + 2048 + (h * 2 + mm) * 128 + quad * 8;
#pragma unroll
      for (int ks = 0; ks < 4; ++ks) qf[ks] = *(const bf16x8*)(qp + ks * 32); }
    f32x4 o[16];
#pragma unroll
    for (int i = 0; i < 16; ++i) o[i] = (f32x4){0.f, 0.f, 0.f, 0.f};
    float m = -1e30f, l = 0.f;
    const bf16_t* kbase = QK + (size_t)b * SEQ * 4096 + 3072 + h * 256;
    const bf16_t* vbase = VT + (size_t)(b * 1536 + 512 + h * 256) * SEQ;
    { int jn = 0;
      tile_pipeline<RegsD>(
        [&]() { return (jn <= qt) ? jn++ : -1; },
        [&](RegsD& R, int j) { const bf16_t* kp = kbase + (size_t)j * 64 * 4096; ldk(R.k0, kp, 4096, tid); ldk(R.k1, kp + 128, 4096, tid); ldv<4>(R.v, vbase + j * 64, SEQ, tid); },
        [&](RegsD& R, int bf) { stk(K0 + bf * DSTAGE, R.k0, tid); stk(K0 + bf * DSTAGE + KTILE_B, R.k1, tid); stv<4>(Vt + bf * DSTAGE, R.v, tid); },
        [&](int j, int bf) { f32x4 s[4]; qk_tile(K0 + bf * DSTAGE + mm * KTILE_B, qf, s, lane); const int kb = j * 64;
                     softmax_pv<16, true>(Vt + bf * DSTAGE, s, o, m, l, [&](int kidx) { return kb + kidx <= t; }, lane, j == qt); }); }
    l += __shfl_xor(l, 16); l += __shfl_xor(l, 32);
    const float inv = 1.f / l;
    __syncthreads();
    float* xb = (float*)lds;
    if (mm == 1) {
#pragma unroll
        for (int i = 0; i < 16; ++i) *(f32x4*)(xb + ((size_t)((w & 3) * 16 + (lane & 15)) * 256 + i * 16 + quad * 4)) = o[i] * (inv * lam_full);
    }
    __syncthreads();
    if (mm == 0) {
        float ss = 0.f;
#pragma unroll
        for (int i = 0; i < 16; ++i) { const f32x4 o1 = *(const f32x4*)(xb + ((size_t)((w & 3) * 16 + (lane & 15)) * 256 + i * 16 + quad * 4));
            o[i] = o[i] * inv - o1; ss += o[i][0] * o[i][0] + o[i][1] * o[i][1] + o[i][2] * o[i][2] + o[i][3] * o[i][3]; }
        ss += __shfl_xor(ss, 16); ss += __shfl_xor(ss, 32);
        const float rs = rsqrtf(ss * (1.f / 256.f) + 1e-5f) * out_scale;
        bf16_t* yp = Y + (size_t)(b * SEQ + t) * 1024 + h * 256 + quad * 4;
#pragma unroll
        for (int i = 0; i < 16; ++i) { const f32x4 g = *(const f32x4*)(subln + i * 16 + quad * 4); const f32x4 v = o[i] * rs * g; uint2 pk; pk.x = pack2(v[0], v[1]); pk.y = pack2(v[2], v[3]); *(uint2*)(yp + i * 16) = pk; }
    }
    __syncthreads();
}

DI void nsa_unit(const bf16_t* QK, const bf16_t* VT, const bf16_t* KC, const bf16_t* VCT, const float* G, bf16_t* Y, int b, int g, int qt, LAS unsigned char* lds) {
    int tid_l = threadIdx.x; asm volatile("" : "+v"(tid_l)); const int tid = tid_l, lane = tid & 63, w = tid >> 6, hh = w >> 1, quad = lane >> 4;
    const int q0 = qt * 32, ql = (w & 1) * 16 + (lane & 15), t = q0 + ql;
    LAS unsigned char* Kt = lds; LAS unsigned char* Vt = lds + KTILE_B;
    float* impA = (float*)(lds + 2 * NSTAGE);
    float* impB = impA + 4 * 32 * 64;
    unsigned long long* selm = (unsigned long long*)(impB + 4 * 32 * 64);
    const size_t tok = (size_t)b * SEQ + t;
    bf16x8 qf[4];
    { const bf16_t* qp = QK + tok * 4096 + (g * 4 + hh) * 128 + quad * 8;
#pragma unroll
      for (int ks = 0; ks < 4; ++ks) qf[ks] = *(const bf16x8*)(qp + ks * 32); }
    const float* gp = G + tok * 32 + (g * 4 + hh) * 3;
    const float g0 = sigmoidf_(gp[0]), g1 = sigmoidf_(gp[1]), g2 = sigmoidf_(gp[2]);
    f32x4 out[8];
#pragma unroll
    for (int i = 0; i < 8; ++i) out[i] = (f32x4){0.f, 0.f, 0.f, 0.f};
    for (int i = tid; i < 2 * 4 * 32 * 64; i += 512) impA[i] = 0.f;
    f32x4 o[8];
    float m, l;
    const int ntc = (q0 >> 10) + 1;
    const bf16_t* kcb = KC + (size_t)(b * 2 + g) * 256 * 128;
    const bf16_t* vcb = VCT + (size_t)(b * 2 + g) * 128 * 256;
#pragma unroll
    for (int i = 0; i < 8; ++i) o[i] = (f32x4){0.f, 0.f, 0.f, 0.f};
    m = -1e30f; l = 0.f;
    { int jn = 0;
      tile_pipeline<RegsKV>(
        [&]() { return (jn < ntc) ? jn++ : -1; },
        [&](RegsKV& R, int j) { ldk(R.k, kcb + (size_t)j * 64 * 128, 128, tid); ldv<2>(R.v, vcb + j * 64, 256, tid); },
        [&](RegsKV& R, int bf) { stk(Kt + bf * NSTAGE, R.k, tid); stv<2>(Vt + bf * NSTAGE, R.v, tid); },
        [&](int j, int bf) { f32x4 s[4]; qk_tile(Kt + bf * NSTAGE, qf, s, lane); const int cb = j * 64;
                     softmax_pv<8, true>(Vt + bf * NSTAGE, s, o, m, l, [&](int kidx) { const int c = cb + kidx; return (c <= 254) && (16 * c + 31 <= t); }, lane); }); }
    l += __shfl_xor(l, 16); l += __shfl_xor(l, 32);
    const float invc = (l > 0.f) ? 1.f / l : 0.f;
#pragma unroll
    for (int i = 0; i < 8; ++i) out[i] += o[i] * (invc * g0);
    { int jn = 0;
      tile_pipeline<RegsK>(
        [&]() { return (jn < ntc) ? jn++ : -1; },
        [&](RegsK& R, int j) { ldk(R.k, kcb + (size_t)j * 64 * 128, 128, tid); },
        [&](RegsK& R, int bf) { stk(Kt + bf * NSTAGE, R.k, tid); },
        [&](int j, int bf) { f32x4 s[4]; qk_tile(Kt + bf * NSTAGE, qf, s, lane);
#pragma unroll
            for (int sub = 0; sub < 4; ++sub) {
                float p[4];
#pragma unroll
                for (int e = 0; e < 4; ++e) { const int c = j * 64 + sub * 16 + quad * 4 + e; const bool ok = (c <= 254) && (16 * c + 31 <= t);
                    p[e] = ok ? __builtin_amdgcn_exp2f(s[sub][e] * SC_LOG2E - m) * invc : 0.f; }
                const int jb = j * 16 + sub * 4 + quad;
                impA[(hh * 32 + ql) * 64 + jb] = p[0] + p[1] + p[2] + p[3];
                if (jb + 1 < 64) impB[(hh * 32 + ql) * 64 + jb + 1] = p[3];
            } }); }
    __syncthreads();
#pragma unroll 1
    for (int qi = 0; qi < 4; ++qi) {
        const int qq = w * 4 + qi, tq = q0 + qq, blk = tq >> 6;
        float v = 0.f;
#pragma unroll
        for (int h2 = 0; h2 < 4; ++h2) v += impA[(h2 * 32 + qq) * 64 + lane] + impB[(h2 * 32 + qq) * 64 + lane];
        if (lane == 0 || lane == blk || lane == blk - 1) v = 1e9f; else if (lane > blk) v = -INFINITY;
        int rank = 0;
#pragma unroll 2
        for (int jj = 0; jj < 64; ++jj) { const float o2 = __int_as_float(__builtin_amdgcn_readlane(__float_as_int(v), jj)); rank += (o2 > v || (o2 == v && jj < lane)) ? 1 : 0; }
        const unsigned long long msk = __ballot((rank < 16) && (lane <= blk));
        if (lane == 0) selm[qq] = msk;
    }
    __syncthreads();
    unsigned long long un = 0ull;
#pragma unroll 1
    for (int i = 0; i < 32; ++i) un |= selm[i];
    const unsigned long long my = selm[ql];
    {
        const bf16_t* kb = QK + (size_t)b * SEQ * 4096 + 1536 + g * 128;
        const bf16_t* vb = VT + (size_t)(b * 1536 + g * 128) * SEQ;
#pragma unroll
        for (int i = 0; i < 8; ++i) o[i] = (f32x4){0.f, 0.f, 0.f, 0.f};
        m = -1e30f; l = 0.f;
        unsigned long long rem = un;
        tile_pipeline<RegsKV>(
          [&]() { if (!rem) return -1; const int j = __builtin_ctzll(rem); rem &= rem - 1; return j; },
          [&](RegsKV& R, int j) { ldk(R.k, kb + (size_t)j * 64 * 4096, 4096, tid); ldv<2>(R.v, vb + j * 64, SEQ, tid); },
          [&](RegsKV& R, int bf) { stk(Kt + bf * NSTAGE, R.k, tid); stv<2>(Vt + bf * NSTAGE, R.v, tid); },
          [&](int j, int bf) { f32x4 s[4]; qk_tile(Kt + bf * NSTAGE, qf, s, lane); const bool sel = (my >> j) & 1ull; const int kbs = j * 64;
                       softmax_pv<8, true>(Vt + bf * NSTAGE, s, o, m, l, [&](int kidx) { return sel && (kbs + kidx <= t); }, lane, !__all(sel) || (kbs + 63 > q0)); });
        l += __shfl_xor(l, 16); l += __shfl_xor(l, 32);
        const float inv = (l > 0.f) ? 1.f / l : 0.f;
#pragma unroll
        for (int i = 0; i < 8; ++i) out[i] += o[i] * (inv * g1);
    }
    {
        const bf16_t* kb = QK + (size_t)b * SEQ * 4096 + 1792 + g * 128;
        const bf16_t* vb = VT + (size_t)(b * 1536 + 256 + g * 128) * SEQ;
#pragma unroll
        for (int i = 0; i < 8; ++i) o[i] = (f32x4){0.f, 0.f, 0.f, 0.f};
        m = -1e30f; l = 0.f;
        const int jlo = (q0 >= 511) ? ((q0 - 511) >> 6) : 0, jhi = q0 >> 6;
        { int jn = jlo;
          tile_pipeline<RegsKV>(
            [&]() { return (jn <= jhi) ? jn++ : -1; },
            [&](RegsKV& R, int j) { ldk(R.k, kb + (size_t)j * 64 * 4096, 4096, tid); ldv<2>(R.v, vb + j * 64, SEQ, tid); },
            [&](RegsKV& R, int bf) { stk(Kt + bf * NSTAGE, R.k, tid); stv<2>(Vt + bf * NSTAGE, R.v, tid); },
            [&](int j, int bf) { f32x4 s[4]; qk_tile(Kt + bf * NSTAGE, qf, s, lane); const int kbs = j * 64;
                         softmax_pv<8, true>(Vt + bf * NSTAGE, s, o, m, l, [&](int kidx) { return (unsigned)(t - (kbs + kidx)) < 512u; }, lane, (kbs + 63 > q0) || ((q0 + 31) - kbs >= 512)); }); }
        l += __shfl_xor(l, 16); l += __shfl_xor(l, 32);
        const float inv = (l > 0.f) ? 1.f / l : 0.f;
#pragma unroll
        for (int i = 0; i < 8; ++i) out[i] += o[i] * (inv * g2);
    }
    bf16_t* yp = Y + tok * 1024 + (g * 4 + hh) * 128 + quad * 4;
#pragma unroll
    for (int i = 0; i < 8; ++i) { uint2 pk; pk.x = pack2(out[i][0], out[i][1]); pk.y = pack2(out[i][2], out[i][3]); *(uint2*)(yp + i * 16) = pk; }
    __syncthreads();
}
template <int CTRL> DI float dpp_add(float x) { const int y = __builtin_amdgcn_update_dpp(0, __float_as_int(x), CTRL, 0xF, 0xF, true); return x + __int_as_float(y); }
DI float red8(float x) { x = dpp_add<0xB1>(x); x = dpp_add<0x4E>(x); x = dpp_add<0x141>(x); return x; }
DI float pair_add(float x) { return dpp_add<0xB1>(x); }
constexpr int SCH = 32, SBUF_F = 6 * SCH * 64;
DI void scan_unit(const bf16_t* Dr, const bf16_t* Dk, const bf16_t* Dv, const bf16_t* Dkk, const bf16_t* Dka, const _Float16* Dw, float* YRAW, int b, int h, LAS unsigned char* lds) {
    int tid_l = threadIdx.x; asm volatile("" : "+v"(tid_l)); const int tid = tid_l, lane = tid & 63, w = tid >> 6;
    const int rl = w * 8 + (lane >> 3), kq = lane & 7;
    LAS float* buf = (LAS float*)lds;
    const size_t base = (size_t)b * SEQ * 1024 + h * 64;
    const int st_tok = tid >> 4, st_k = (tid & 15) * 4;
    uint2 g_r, g_k, g_kk, g_ka, g_w, g_v;
    auto gload = [&](int ck) {
        const size_t o = base + (size_t)(ck * SCH + st_tok) * 1024 + st_k;
        g_r = *(const uint2*)(Dr + o); g_k = *(const uint2*)(Dk + o); g_kk = *(const uint2*)(Dkk + o); g_ka = *(const uint2*)(Dka + o); g_w = *(const uint2*)(Dw + o); g_v = *(const uint2*)(Dv + o);
    };
    auto cvt4 = [&](const uint2& u) { f32x4 f; f[0] = __uint_as_float(u.x << 16); f[1] = __uint_as_float(u.x & 0xffff0000u); f[2] = __uint_as_float(u.y << 16); f[3] = __uint_as_float(u.y & 0xffff0000u); return f; };
    auto lstore = [&](int bi) {
        LAS float* p = buf + bi * SBUF_F + st_tok * 64 + st_k;
        *(LAS f32x4*)(p) = cvt4(g_r); *(LAS f32x4*)(p + SCH * 64) = cvt4(g_k); *(LAS f32x4*)(p + 2 * SCH * 64) = cvt4(g_kk); *(LAS f32x4*)(p + 3 * SCH * 64) = cvt4(g_ka);
        { union { uint2 u; _Float16 hh[4]; } c; c.u = g_w; f32x4 f; f[0] = 1.f + (float)c.hh[0]; f[1] = 1.f + (float)c.hh[1]; f[2] = 1.f + (float)c.hh[2]; f[3] = 1.f + (float)c.hh[3]; *(LAS f32x4*)(p + 4 * SCH * 64) = f; }
        *(LAS f32x4*)(p + 5 * SCH * 64) = cvt4(g_v);
    };
    f32x4 s0 = {0.f, 0.f, 0.f, 0.f}, s1 = {0.f, 0.f, 0.f, 0.f};
    gload(0);
    __syncthreads();
    lstore(0);
    __syncthreads();
    LAS float* ypart = buf + 2 * SBUF_F;
    float* yflush = YRAW + base;
    for (int ck = 0; ck < SEQ / SCH; ++ck) {
        const int bi = ck & 1;
        if (ck + 1 < SEQ / SCH) gload(ck + 1);
        const LAS float* p = buf + bi * SBUF_F + kq * 8;
        const LAS float* pv = buf + bi * SBUF_F + 5 * SCH * 64 + rl;
        LAS float* yp = ypart + rl * 4 + (kq >> 1);
#pragma unroll 4
        for (int tt = 0; tt < SCH; ++tt) {
            const LAS float* q = p + tt * 64;
            const f32x4 r0 = *(const LAS f32x4*)(q), r1 = *(const LAS f32x4*)(q + 4);
            const f32x4 k0 = *(const LAS f32x4*)(q + SCH * 64), k1 = *(const LAS f32x4*)(q + SCH * 64 + 4);
            const f32x4 kk0 = *(const LAS f32x4*)(q + 2 * SCH * 64), kk1 = *(const LAS f32x4*)(q + 2 * SCH * 64 + 4);
            const f32x4 ka0 = *(const LAS f32x4*)(q + 3 * SCH * 64), ka1 = *(const LAS f32x4*)(q + 3 * SCH * 64 + 4);
            const f32x4 w0 = *(const LAS f32x4*)(q + 4 * SCH * 64), w1 = *(const LAS f32x4*)(q + 4 * SCH * 64 + 4);
            const float vv = pv[tt * 64];
            f32x2 t = (f32x2){s0[0], s0[1]} * (f32x2){kk0[0], kk0[1]};
            t = (f32x2){s0[2], s0[3]} * (f32x2){kk0[2], kk0[3]} + t;
            t = (f32x2){s1[0], s1[1]} * (f32x2){kk1[0], kk1[1]} + t;
            t = (f32x2){s1[2], s1[3]} * (f32x2){kk1[2], kk1[3]} + t;
            const float sa = -red8(t[0] + t[1]);
            s0 = s0 * w0 + ka0 * sa + k0 * vv;
            s1 = s1 * w1 + ka1 * sa + k1 * vv;
            f32x2 y = (f32x2){s0[0], s0[1]} * (f32x2){r0[0], r0[1]};
            y = (f32x2){s0[2], s0[3]} * (f32x2){r0[2], r0[3]} + y;
            y = (f32x2){s1[0], s1[1]} * (f32x2){r1[0], r1[1]} + y;
            y = (f32x2){s1[2], s1[3]} * (f32x2){r1[2], r1[3]} + y;
            yp[tt * 256] = pair_add(y[0] + y[1]);
        }
        if (ck + 1 < SEQ / SCH) lstore(bi ^ 1);
        __syncthreads();
        { const int idx = tid * 4, tt = idx >> 6, r = idx & 63;
          const LAS float* ys = ypart + idx * 4;
          const f32x4 a0 = *(const LAS f32x4*)ys, a1 = *(const LAS f32x4*)(ys + 4), a2 = *(const LAS f32x4*)(ys + 8), a3 = *(const LAS f32x4*)(ys + 12);
          *(f32x4*)(yflush + (size_t)(ck * SCH + tt) * 1024 + r) = (f32x4){(a0[0] + a0[1]) + (a0[2] + a0[3]), (a1[0] + a1[1]) + (a1[2] + a1[3]), (a2[0] + a2[1]) + (a2[2] + a2[3]), (a3[0] + a3[1]) + (a3[2] + a3[3])}; }
        __syncthreads();
    }
}
#define PH_BEGIN const Params* PP = &P; GAS unsigned char* wsg_ = (GAS unsigned char*)P.ws; asm volatile("" : "+s"(wsg_)); unsigned char* ws = (unsigned char*)wsg_; int tid = threadIdx.x; asm volatile("" : "+v"(tid)); int bid = blockIdx.x; asm volatile("" : "+s"(bid)); \
    const int G = gridDim.x; const int gtid = bid * 512 + tid, gthreads = G * 512; (void)gtid; (void)gthreads; (void)ws;
#define WSP(T, off) ((T*)(ws + (off)))
#define INP(i, stride) ((const float*)PP->in[i] + (size_t)L * (stride))
#define XB_TMO      128
#define XB_XCNT(j)  (256  + 64 * (j))
#define XB_XSUB(j)  (1280 + 64 * (j))
#define XB_XGEN(j)  (2304 + 64 * (j))
#define XB_TOP      3328
#define XB_TOPGEN   3392
#define XCD_BAR_WORDS 3456
#define XB_SPIN_CAP (1u << 18)

__device__ __forceinline__ unsigned xb_ld(unsigned* p)              { return __hip_atomic_load(p, __ATOMIC_RELAXED, __HIP_MEMORY_SCOPE_AGENT); }
__device__ __forceinline__ unsigned xb_add(unsigned* p, unsigned v) { return __hip_atomic_fetch_add(p, v, __ATOMIC_RELAXED, __HIP_MEMORY_SCOPE_AGENT); }
__device__ __forceinline__ unsigned xb_xcc_id() { return (unsigned)__builtin_amdgcn_s_getreg((3 << 11) | 20) & 0xFu; }
#define XB_SPIN(cond, bar) do { unsigned _sp = 0; while (cond) { __builtin_amdgcn_s_sleep(1); \
    if ((++_sp & 255u) == 0u) { if (xb_ld(&(bar)[XB_TMO])) break; if (_sp > XB_SPIN_CAP) { atomicAdd(&(bar)[XB_TMO], 1u); break; } } } } while (0)

struct XcdBarrier {
    unsigned* bar; unsigned x;
    volatile LAS unsigned* st;
};

__device__ __forceinline__ XcdBarrier xcd_barrier_post(unsigned* bar, volatile LAS unsigned* st) {
    XcdBarrier b; b.bar = bar; b.x = xb_xcc_id(); b.st = st;
    if (threadIdx.x == 0) (void)xb_add(&bar[XB_XCNT(b.x)], 1u);
    return b;
}
__device__ __forceinline__ void xcd_barrier_complete(unsigned* bar, unsigned x, unsigned& nloc, unsigned& nx) {
    const unsigned G = gridDim.x * gridDim.y * gridDim.z;
    unsigned sum, cnt, mine, sp = 0u;
    for (;;) {
        sum = 0u; cnt = 0u; mine = 0u;
#pragma unroll
        for (unsigned j = 0; j < 16; ++j) { const unsigned c = xb_ld(&bar[XB_XCNT(j)]); sum += c; cnt += (c > 0u) ? 1u : 0u; mine = (j == x) ? c : mine; }
        if (sum == G) break;
        __builtin_amdgcn_s_sleep(1);
        if ((++sp & 255u) == 0u) { if (xb_ld(&bar[XB_TMO])) break; if (sp > XB_SPIN_CAP) { atomicAdd(&bar[XB_TMO], 1u); break; } }
    }
    nloc = mine > 0u ? mine : 1u; nx = cnt > 0u ? cnt : 1u;
}

__device__ __forceinline__ void xcd_barrier(const XcdBarrier& b) {
    asm volatile("s_waitcnt vmcnt(0)" ::: "memory");
    __syncthreads();
    if (threadIdx.x == 0) {
        unsigned* bar = b.bar;
        __builtin_amdgcn_s_waitcnt(0);
        unsigned nloc = b.st[0], nx = b.st[1];
        if (nloc == 0u) { xcd_barrier_complete(bar, b.x, nloc, nx); b.st[0] = nloc; b.st[1] = nx; }
        const unsigned old = xb_add(&bar[XB_XSUB(b.x)], 1u);
        const unsigned gen = old / nloc;
        if (old + 1u == (gen + 1u) * nloc) {
            __builtin_amdgcn_fence(__ATOMIC_RELEASE, "agent");
            asm volatile("s_waitcnt vmcnt(0)" ::: "memory");
            const unsigned og = xb_add(&bar[XB_TOP], 1u);
            const unsigned tg = og / nx;
            if (og + 1u == (tg + 1u) * nx) xb_add(&bar[XB_TOPGEN], 1u);
            else XB_SPIN(xb_ld(&bar[XB_TOPGEN]) == tg, bar);
            __builtin_amdgcn_fence(__ATOMIC_ACQUIRE, "agent");
            xb_add(&bar[XB_XGEN(b.x)], 1u);
            asm volatile("s_waitcnt vmcnt(0)" ::: "memory");
        } else {
            XB_SPIN(xb_ld(&bar[XB_XGEN(b.x)]) == gen, bar);
            __builtin_amdgcn_fence(__ATOMIC_ACQUIRE, "agent");
            asm volatile("s_waitcnt vmcnt(0)" ::: "memory");
        }
    }
    __syncthreads();
}


constexpr size_t OFF_BAR = 8192;
#define GSYNC() do { XcdBarrier xb_; xb_.bar = (unsigned*)(P.ws + OFF_BAR); xb_.x = xb_xcc_id(); xb_.st = (volatile LAS unsigned*)(lds + LDS_CTLW + 64); xcd_barrier(xb_); } while (0)
template <int L> DI void layer_body(const Params& P, LAS unsigned char* lds, float* tile) {
        { PH_BEGIN
          const float* cmp_w1 = INP(8, 2 * 4096 * 256); const float* cmp_w2 = INP(9, 2 * 256 * 128);
          cvt_transpose(tile, INP(6, 2048 * 9016), 9016, 2048, NWIN, WSP(bf16_t, OFF_WIN), [](int n) { return n < 2560 ? n : (n < 8992 ? n + 24 : (n < 9016 ? n - 8992 + 2560 : -1)); }, bid, G);
          cvt_transpose(tile, cmp_w1, 256, 4096, 256, WSP(bf16_t, OFF_W1T), [](int n) { return n; }, bid, G);
          cvt_transpose(tile, cmp_w1 + (size_t)4096 * 256, 256, 4096, 256, WSP(bf16_t, OFF_W1T) + (size_t)256 * 4096, [](int n) { return n; }, bid, G);
          bf16_t* W2T = WSP(bf16_t, OFF_W2T);
          for (int i = gtid; i < 256 * 256; i += gthreads) { const int n = i >> 8, k = i & 255; W2T[i] = f2bf(cmp_w2[(size_t)(n >> 7) * 256 * 128 + (size_t)k * 128 + (n & 127)]); }
          const float* w_up_l = INP(14, 64 * 1024); const float* a_up = INP(16, 64 * 1024); const float* g_up = INP(17, 160 * 1024); bf16_t* LORA = WSP(bf16_t, OFF_LORA);
          for (int i = gtid; i < 3072 * 384; i += gthreads) {
            const int n = i / 384, k = i - n * 384, kind = n >> 10, c = n & 1023; float v = 0.f;
            if (kind == 0) { if (k < 64) v = w_up_l[(size_t)k * 1024 + c]; }
            else if (kind == 1) { if (k >= 64 && k < 128) v = a_up[(size_t)(k - 64) * 1024 + c]; }
            else { if (k >= 128 && k < 288) v = g_up[(size_t)(k - 128) * 1024 + c]; }
            LORA[i] = f2bf(v);
          }
          if (gtid == 0) { const float* dlam = INP(10, 512); const float lam_init = 0.8f - 0.6f * expf(-0.3f * (float)L);
            float s01 = 0.f, s23 = 0.f; for (int i = 0; i < 128; ++i) { s01 += dlam[i] * dlam[128 + i]; s23 += dlam[256 + i] * dlam[384 + i]; } WSP(float, OFF_MISC)[L] = expf(s01) - expf(s23) + lam_init; } }
        if (L == 0) cg::this_grid().sync(); else GSYNC();

        { PH_BEGIN
          pg8::StaticOrder S; S.init(TT, NWIN, G, bid); EpiWin E{WSP(bf16_t, OFF_QK), WSP(bf16_t, OFF_VT), WSP(float, OFF_G), WSP(bf16_t, OFF_PR), WSP(const float2, OFF_ROPE)};
          pg8::gemm_phase<EpiWin, pg8::StaticOrder>(lds, Gemm{WSP(bf16_t, OFF_U), WSP(bf16_t, OFF_WIN), TT, NWIN, 2048}, S, E, nullptr); }
        GSYNC();

        { PH_BEGIN
          bf16_t* Dr = WSP(bf16_t, OFF_D);
          rwkv_shift(WSP(bf16_t, OFF_PR), INP(12, 3360), Dr, Dr + (size_t)TT * 1024, Dr + (size_t)2 * TT * 1024, WSP(bf16_t, OFF_AL), gtid, gthreads);
          build_cmpa(WSP(bf16_t, OFF_QK), INP(7, 2 * 32 * 128), WSP(bf16_t, OFF_CMPA), gtid, gthreads); }
        GSYNC();

        { PH_BEGIN
          ListOrder S{16, G, G - 1 - bid, 0}; EpiBf<1> E{WSP(bf16_t, OFF_H), 256, 16, 1, 0};
          pg8::gemm_phase<EpiBf<1>, ListOrder>(lds, Gemm{WSP(bf16_t, OFF_CMPA), WSP(bf16_t, OFF_W1T), 4096, 512, 4096}, S, E, nullptr); }
        { PH_BEGIN
          int K384 = 384; asm volatile("" : "+s"(K384));
          if (bid < G - 16) {
          pg8::StaticOrder S; S.init(TT, 1024, G - 16, bid); EpiF32 E{WSP(float, OFF_YRAW), 1024};
          pg8::gemm_phase<EpiF32, pg8::StaticOrder>(lds, Gemm{WSP(bf16_t, OFF_AL), WSP(bf16_t, OFF_LORA), TT, 1024, K384}, S, E, nullptr); } }
        { PH_BEGIN
          int K384 = 384; asm volatile("" : "+s"(K384));
          if (bid < G - 16) {
          pg8::StaticOrder S; S.init(TT, 1024, G - 16, bid); EpiBf<0> E{WSP(bf16_t, OFF_D) + (size_t)4 * TT * 1024, 1024, 64, 4, 0};
          pg8::gemm_phase<EpiBf<0>, pg8::StaticOrder>(lds, Gemm{WSP(bf16_t, OFF_AL), WSP(bf16_t, OFF_LORA) + (size_t)1024 * 384, TT, 1024, K384}, S, E, nullptr); } }
        { PH_BEGIN
          int K384 = 384; asm volatile("" : "+s"(K384));
          if (bid < G - 16) {
          pg8::StaticOrder S; S.init(TT, 1024, G - 16, bid); EpiBf<0> E{WSP(bf16_t, OFF_PR) + (size_t)2 * TT * 1024, 1024, 64, 4, 0};
          pg8::gemm_phase<EpiBf<0>, pg8::StaticOrder>(lds, Gemm{WSP(bf16_t, OFF_AL), WSP(bf16_t, OFF_LORA) + (size_t)2048 * 384, TT, 1024, K384}, S, E, nullptr); } }
        GSYNC();

        { PH_BEGIN
          ListOrder S{8, G, bid, 1}; EpiCmp2<0> E{WSP(bf16_t, OFF_KC), WSP(bf16_t, OFF_VCT), WSP(const float2, OFF_ROPE)};
          pg8::gemm_phase<EpiCmp2<0>, ListOrder>(lds, Gemm{WSP(bf16_t, OFF_H), WSP(bf16_t, OFF_W2T), 2048, 256, 256}, S, E, nullptr); }
        { PH_BEGIN
          ListOrder S{8, G, G - 1 - bid, 1}; EpiCmp2<1> E{WSP(bf16_t, OFF_KC), WSP(bf16_t, OFF_VCT), WSP(const float2, OFF_ROPE)};
          pg8::gemm_phase<EpiCmp2<1>, ListOrder>(lds, Gemm{WSP(bf16_t, OFF_H) + (size_t)2048 * 256, WSP(bf16_t, OFF_W2T), 2048, 256, 256}, S, E, nullptr); }
        { PH_BEGIN
          bf16_t* Dr = WSP(bf16_t, OFF_D);
          rwkv_prep(Dr, Dr + (size_t)TT * 1024, Dr + (size_t)3 * TT * 1024, Dr + (size_t)4 * TT * 1024, INP(18, 1024), INP(19, 1024), INP(20, 1024), WSP(float, OFF_BON), WSP(float, OFF_YRAW), INP(13, 1024), INP(15, 1024), (_Float16*)(Dr + (size_t)5 * TT * 1024), gtid, gthreads); }
        GSYNC();

        {
            LAS int* qslot = (LAS int*)(lds + LDS_CTLW);
#ifndef DUP_F
#define DUP_F 1
#endif
            for (int rep = 0; rep < DUP_F; ++rep) { if (rep) GSYNC();
            const int myx = (int)(xb_xcc_id() & 7u);
#pragma unroll 1
            for (int qq = 0; qq < 8; ++qq) {
            const int xq = (myx + qq) & 7;
            for (;;) {
                PH_BEGIN
                __syncthreads();
                if (tid == 0) *qslot = (int)atomicAdd(WSP(unsigned, OFF_CTL) + 64 * L + 16 * rep + xq, 1u);
                __syncthreads();
                const int v = *qslot;
                if (v >= 8 + 256) break;
                bf16_t* Dr = WSP(bf16_t, OFF_D); bf16_t* Y3 = WSP(bf16_t, OFF_PR);
                if (v < 8) { const int u = xq * 8 + v;
                    scan_unit(Dr, Dr + (size_t)TT * 1024, Dr + (size_t)2 * TT * 1024, Dr + (size_t)3 * TT * 1024, Dr + (size_t)4 * TT * 1024, (const _Float16*)(Dr + (size_t)5 * TT * 1024), WSP(float, OFF_YRAW), u >> 4, u & 15, lds); }
                else {
                    const int w = v - 8, r = w >> 2, k = w & 3;
                    if (k < 2) { const float lam_init = 0.8f - 0.6f * expf(-0.3f * (float)L); const int idx = 2 * xq + k;
                        diff_unit(WSP(bf16_t, OFF_QK), WSP(bf16_t, OFF_VT), INP(11, 256), WSP(float, OFF_MISC)[L], 1.f - lam_init, Y3 + (size_t)TT * 1024, idx >> 2, idx & 3, 63 - r, lds); }
                    else nsa_unit(WSP(bf16_t, OFF_QK), WSP(bf16_t, OFF_VT), WSP(bf16_t, OFF_KC), WSP(bf16_t, OFF_VCT), WSP(float, OFF_G), Y3, xq >> 1, xq & 1, 127 - 2 * r - (k - 2), lds);
                }
            }
            }
            }
        }
        GSYNC();

        { PH_BEGIN
          const float* w_gate = INP(23, 3 * 2048 * 2048); const float* w_branch = INP(25, 3 * 1024 * 2048);
#pragma unroll 1
          for (int b3 = 0; b3 < 3; ++b3) {
            cvt_transpose(tile, w_gate + (size_t)b3 * 2048 * 2048, 2048, 2048, 2048, WSP(bf16_t, OFF_WG) + (size_t)b3 * 2048 * 2048, [](int n) { return n; }, bid, G);
            cvt_transpose(tile, w_branch + (size_t)b3 * 1024 * 2048, 2048, 1024, 2048, WSP(bf16_t, OFF_WB) + (size_t)b3 * 2048 * 1024, [](int n) { return n; }, bid, G);
          }
          cvt_transpose(tile, INP(26, 2048 * 2048), 2048, 2048, 2048, WSP(bf16_t, OFF_WO), [](int n) { return n; }, bid, G);
          cvt_transpose(tile, INP(27, 2048 * 8192), 8192, 2048, 8192, WSP(bf16_t, OFF_WUP), [](int n) { return n; }, bid, G);
          cvt_transpose(tile, INP(28, 8192 * 2048), 2048, 8192, 2048, WSP(bf16_t, OFF_WDN), [](int n) { return n; }, bid, G);
          rwkv_final(WSP(float, OFF_YRAW), WSP(bf16_t, OFF_D) + (size_t)2 * TT * 1024, WSP(float, OFF_BON), INP(21, 1024), INP(22, 1024), WSP(bf16_t, OFF_PR) + (size_t)2 * TT * 1024, gtid, gthreads); }
        GSYNC();

        { PH_BEGIN
          ListOrder S{1536, G, bid, 3}; EpiBf<0> E{WSP(bf16_t, OFF_Z), 2048, 64, 8, (size_t)TT * 2048};
          pg8::gemm_phase<EpiBf<0>, ListOrder>(lds, Gemm{WSP(bf16_t, OFF_PR), WSP(bf16_t, OFF_WB), 3 * TT, 6144, 1024}, S, E, nullptr); }
        GSYNC();
        { PH_BEGIN
          ListOrder S{0, G, bid, 2}; EpiMerge E{WSP(bf16_t, OFF_Z), INP(24, 3 * 2048), WSP(float, OFF_SCR), WSP(bf16_t, OFF_MRG)};
          pg8::gemm_phase<EpiMerge, ListOrder>(lds, Gemm{WSP(bf16_t, OFF_U), WSP(bf16_t, OFF_WG), TT, 6144, 2048}, S, E, nullptr); }
        GSYNC();
        { PH_BEGIN
          pg8::StaticOrder S; S.init(TT, 2048, G, bid); EpiBf<0> E{WSP(bf16_t, OFF_T1A), 2048, 0, 0, 0};
          pg8::gemm_phase<EpiBf<0>, pg8::StaticOrder>(lds, Gemm{WSP(bf16_t, OFF_MRG), WSP(bf16_t, OFF_WO), TT, 2048, 2048}, S, E, nullptr); }
        GSYNC();
        { PH_BEGIN
          row_pass(L == 0 ? (const float*)PP->in[0] : PP->out, WSP(bf16_t, OFF_T1A), INP(3, 2048), PP->out, INP(4, 2048), WSP(bf16_t, OFF_U), bid, G); }
        GSYNC();
        { PH_BEGIN
          pg8::StaticOrder S; S.init(TT, DFF, G, bid); EpiBf<2> E{WSP(bf16_t, OFF_HID), DFF, 0, 0, 0};
          pg8::gemm_phase<EpiBf<2>, pg8::StaticOrder>(lds, Gemm{WSP(bf16_t, OFF_U), WSP(bf16_t, OFF_WUP), TT, DFF, 2048}, S, E, nullptr); }
        GSYNC();
        { PH_BEGIN
          pg8::StaticOrder S; S.init(TT, 2048, G, bid); EpiBf<0> E{WSP(bf16_t, OFF_T1B), 2048, 0, 0, 0};
          pg8::gemm_phase<EpiBf<0>, pg8::StaticOrder>(lds, Gemm{WSP(bf16_t, OFF_HID), WSP(bf16_t, OFF_WDN), TT, 2048, DFF}, S, E, nullptr); }
        GSYNC();
        { PH_BEGIN
          row_pass(PP->out, WSP(bf16_t, OFF_T1B), INP(5, 2048), PP->out, (const float*)PP->in[2] + 2048, (L == 0) ? WSP(bf16_t, OFF_U) : (bf16_t*)nullptr, bid, G); }
        GSYNC();

}

__global__ void __launch_bounds__(512, 2) fwd_megakernel(Params P) {
    extern __shared__ __attribute__((aligned(16))) unsigned char lds_raw[];
    LAS unsigned char* lds = (LAS unsigned char*)lds_raw;
    float* tile = (float*)lds_raw;
    if (threadIdx.x < 2) ((volatile LAS unsigned*)(lds + LDS_CTLW + 64))[threadIdx.x] = 0u;
    __syncthreads();
    (void)xcd_barrier_post((unsigned*)(P.ws + OFF_BAR), (volatile LAS unsigned*)(lds + LDS_CTLW + 64));
    { PH_BEGIN {
      const int* positions = (const int*)PP->in[1]; float2* ROPE = WSP(float2, OFF_ROPE);
      for (int i = gtid; i < TT * 16; i += gthreads) {
        const int tok = i >> 4, f = i & 15;
        const float inv = (float)pow(500000.0, -(double)f / 16.0);
        const float ang = (float)positions[tok] * inv;
        const double a = (double)ang; const double k = rint(a * 0.15915494309189535); const float r = (float)(a - k * 6.283185307179586);
        ROPE[i] = make_float2(__cosf(r), __sinf(r));
      }
      norm_pass((const float*)PP->in[0], (const float*)PP->in[2], WSP(bf16_t, OFF_U), bid, G); } }

    layer_body<0>(P, lds, tile);
    layer_body<1>(P, lds, tile);
}

extern "C" void kernel_launch(void* const* d_in, const int* in_sizes, int n_in, void* d_out, int out_size, void* d_ws, size_t ws_size, hipStream_t stream) {
    static int grid_blocks = 0;
    if (!grid_blocks) {
        int dev = 0, cus = 0, per_cu = 0;
        (void)hipGetDevice(&dev);
        (void)hipDeviceGetAttribute(&cus, hipDeviceAttributeMultiprocessorCount, dev);
        (void)hipFuncSetAttribute((const void*)fwd_megakernel, hipFuncAttributeMaxDynamicSharedMemorySize, LDS_BYTES);
        (void)hipOccupancyMaxActiveBlocksPerMultiprocessor(&per_cu, (const void*)fwd_megakernel, 512, LDS_BYTES);
        if (per_cu < 1) per_cu = 1;
        grid_blocks = cus * per_cu;
        if (ws_size < WS_END) fprintf(stderr, "kernel_launch: workspace too small: %zu < %zu\n", ws_size, (size_t)WS_END);
    }
    (void)hipMemsetAsync((char*)d_ws + OFF_CTL, 0, 32768, stream);
    Params p{};
    for (int k = 0; k < NIN; ++k) p.in[k] = d_in[k];
    p.out = (float*)d_out; p.ws = (unsigned char*)d_ws; p.stage = 0; p.pad = 0;
    void* args[] = {&p};
    hipError_t e = hipLaunchCooperativeKernel((const void*)fwd_megakernel, dim3(grid_blocks), dim3(512), args, LDS_BYTES, stream);
    if (e != hipSuccess) fprintf(stderr, "cooperative launch failed: %s (grid %d)\n", hipGetErrorString(e), grid_blocks);
}
```
